# Optimizing an MI355X kernel written in HIP

```python
import math
import jax, jax.numpy as jnp
from jax import lax
import numpy as np

D_MODEL = 1024
BATCH = 8
SEQ = 4096
DEPTH = 2

HEAD_DIM = 64
A_Q_HEADS = 8
A_KV_HEADS = 2
A_GROUP = A_Q_HEADS // A_KV_HEADS
WINDOW = 128
BLOCK = 128
NUM_BUCKETS = 32
MAX_DISTANCE = 128
B_HEADS = 8
A_WIDTH = A_Q_HEADS * HEAD_DIM
A_KV_WIDTH = A_KV_HEADS * HEAD_DIM
B_WIDTH = B_HEADS * HEAD_DIM
DECAY_LORA = 64
AAA_LORA = 64
GATE_LORA = 128
B_IN_WIDTH = 3 * B_WIDTH + DECAY_LORA + AAA_LORA + GATE_LORA
EVEN_IN_WIDTH = A_WIDTH + 2 * A_KV_WIDTH + B_IN_WIDTH
MIX_WIDTH = A_WIDTH + B_WIDTH
CONV_WIDTH = 3
CONV_DIM = D_MODEL
D_FF_DENSE = 2816
N_EXPERTS = 8
TOP_K = 2
D_FF_EXPERT = 3584
N_EVEN = (DEPTH + 1) // 2
N_ODD = DEPTH // 2
ALPHA = (2.0 * DEPTH) ** 0.25
BETA = (8.0 * DEPTH) ** -0.25
LN_EPS = 1e-5
GN_EPS = 64e-5
NEG_INF = -1e30
ATTN_SCALE = HEAD_DIM ** -0.5

kernel_name = "hybrid_swa_rwkv7_shortconv_moe_deepnorm"


def layer_norm(x, g, b):
    xf = x.astype(jnp.float32)
    mu = xf.mean(-1, keepdims=True)
    var = jnp.square(xf - mu).mean(-1, keepdims=True)
    y = (xf - mu) * lax.rsqrt(var + LN_EPS) * g.astype(jnp.float32) + b.astype(jnp.float32)
    return y.astype(x.dtype)


def token_shift(z):
    return jnp.pad(z, ((0, 0), (1, 0), (0, 0)))[:, :-1]


def t5_causal_bucket(dist):
    n = jnp.maximum(dist, 0)
    max_exact = NUM_BUCKETS // 2
    log_ratio = jnp.log(jnp.maximum(n, 1).astype(jnp.float32) / max_exact) / math.log(MAX_DISTANCE / max_exact)
    large = max_exact + (log_ratio * (NUM_BUCKETS - max_exact)).astype(jnp.int32)
    large = jnp.minimum(large, NUM_BUCKETS - 1)
    return jnp.where(n < max_exact, n, large)


def sliding_window_sink_attention(q, k, v, sinks, rel_bias_table):
    bsz, seq, _ = q.shape
    nb = seq // BLOCK
    qb = q.reshape(bsz, nb, BLOCK, A_KV_HEADS, A_GROUP, HEAD_DIM)
    kb = k.reshape(bsz, nb, BLOCK, A_KV_HEADS, HEAD_DIM)
    vb = v.reshape(bsz, nb, BLOCK, A_KV_HEADS, HEAD_DIM)
    pad = ((0, 0), (1, 0), (0, 0), (0, 0), (0, 0))
    kcat = jnp.concatenate([jnp.pad(kb, pad)[:, :-1], kb], axis=2)
    vcat = jnp.concatenate([jnp.pad(vb, pad)[:, :-1], vb], axis=2)
    qi = jnp.arange(BLOCK)[:, None]
    ki = jnp.arange(2 * BLOCK)[None, :]
    dist = qi + BLOCK - ki
    s_abs = jnp.arange(nb)[:, None, None] * BLOCK - BLOCK + ki[None]
    valid = (dist >= 0) & (dist < WINDOW) & (s_abs >= 0)
    bias = rel_bias_table[t5_causal_bucket(dist)].astype(jnp.float32)
    bias = jnp.transpose(bias, (2, 0, 1)).reshape(A_KV_HEADS, A_GROUP, BLOCK, 2 * BLOCK)
    scores = jnp.einsum('bnqhgd,bnshd->bnhgqs', qb, kcat).astype(jnp.float32) * ATTN_SCALE + bias
    scores = jnp.where(valid[None, :, None, None], scores, NEG_INF)
    sink = sinks.astype(jnp.float32).reshape(A_KV_HEADS, A_GROUP)[None, None, :, :, None]
    m = jnp.maximum(scores.max(-1), sink)
    p = jnp.exp(scores - m[..., None])
    denom = p.sum(-1) + jnp.exp(sink - m)
    p = p / denom[..., None]
    out = jnp.einsum('bnhgqs,bnshd->bnqhgd', p.astype(v.dtype), vcat)
    return out.reshape(bsz, seq, A_WIDTH)


def rwkv7_scan(r, w, k, v, a, b):
    bsz, _, nh, hd = r.shape
    xs = tuple(jnp.moveaxis(t, 1, 0) for t in (r, w, k, v, a, b))

    def step(state, inp):
        r_t, w_t, k_t, v_t, a_t, b_t = inp
        sa = jnp.einsum('bhij,bhj->bhi', state, a_t)
        state = state * w_t[:, :, None, :] + sa[..., None] * b_t[:, :, None, :] + v_t[..., None] * k_t[:, :, None, :]
        y = jnp.einsum('bhij,bhj->bhi', state, r_t)
        return state, y

    state0 = jnp.zeros((bsz, nh, hd, hd), jnp.float32)
    _, ys = lax.scan(step, state0, xs)
    return jnp.moveaxis(ys, 0, 1)


def rwkv7_time_mix(zb, mu, w0, w_up, a0, a_up, g_up, k_k, k_a, r_k, gn_g, gn_b):
    bsz, seq, _ = zb.shape
    f32 = jnp.float32
    zb = zb + (token_shift(zb) - zb) * mu
    splits = [B_WIDTH, 2 * B_WIDTH, 3 * B_WIDTH, 3 * B_WIDTH + DECAY_LORA, 3 * B_WIDTH + DECAY_LORA + AAA_LORA]
    zr, zk, zv, zwd, zad, zgd = jnp.split(zb, splits, axis=-1)
    w = -jax.nn.softplus(-(w0 + jnp.tanh(zwd) @ w_up).astype(f32)) - 0.5
    decay = jnp.exp(-jnp.exp(w))
    a = jax.nn.sigmoid((a0 + zad @ a_up).astype(f32))
    g = jax.nn.sigmoid(zgd) @ g_up

    def heads(t):
        return t.reshape(bsz, seq, B_HEADS, HEAD_DIM)

    zkf = zk.astype(f32)
    kk = heads(zkf * k_k.astype(f32))
    kk = kk / jnp.maximum(jnp.sqrt(jnp.sum(kk * kk, axis=-1, keepdims=True)), 1e-12)
    k = heads(zkf * (1.0 + (a - 1.0) * k_a.astype(f32)))
    r = heads(zr.astype(f32))
    v = heads(zv.astype(f32))
    a_h = heads(a)
    y = rwkv7_scan(r, heads(decay), k, v, -kk, kk * a_h)
    mean = y.mean(-1, keepdims=True)
    var = jnp.square(y - mean).mean(-1, keepdims=True)
    yn = ((y - mean) * lax.rsqrt(var + GN_EPS)).reshape(bsz, seq, B_WIDTH) * gn_g.astype(f32) + gn_b.astype(f32)
    bonus = (jnp.sum(r * k * r_k.astype(f32), axis=-1, keepdims=True) * v).reshape(bsz, seq, B_WIDTH)
    out = (yn + bonus) * g.astype(f32)
    return out.astype(zb.dtype)


def attention_rwkv_mixer(x, w_in, sinks, rel_bias_table, mu, w0, w_up, a0, a_up, g_up, k_k, k_a, r_k, gn_g, gn_b, w_out):
    z = x @ w_in
    q, k, v, zb = jnp.split(z, [A_WIDTH, A_WIDTH + A_KV_WIDTH, A_WIDTH + 2 * A_KV_WIDTH], axis=-1)
    ya = sliding_window_sink_attention(q, k, v, sinks, rel_bias_table)
    yb = rwkv7_time_mix(zb, mu, w0, w_up, a0, a_up, g_up, k_k, k_a, r_k, gn_g, gn_b)
    return jnp.concatenate([ya.astype(x.dtype), yb.astype(x.dtype)], axis=-1) @ w_out


def short_conv_mixer(x, w_in, conv_w, w_out):
    seq = x.shape[1]
    gb, gc, u = jnp.split(x @ w_in, 3, axis=-1)
    u = gc * u
    up = jnp.pad(u, ((0, 0), (CONV_WIDTH - 1, 0), (0, 0)))
    conv = up[:, 0:seq] * conv_w[0]
    for j in range(1, CONV_WIDTH):
        conv = conv + up[:, j:j + seq] * conv_w[j]
    return (gb * conv) @ w_out


def swiglu(x, w_gate, w_up, w_down):
    return (jax.nn.silu(x @ w_gate) * (x @ w_up)) @ w_down


def moe_swiglu(x, router_w, w_gate, w_up, w_down):
    bsz, seq, d = x.shape
    xt = x.reshape(-1, d)
    logits = (xt @ router_w).astype(jnp.float32)
    top_vals, top_idx = lax.top_k(logits, TOP_K)
    top_p = jax.nn.softmax(top_vals, axis=-1)
    combine = jnp.einsum('tk,tke->te', top_p, jax.nn.one_hot(top_idx, N_EXPERTS, dtype=jnp.float32))
    out = jnp.zeros_like(xt)
    for e in range(N_EXPERTS):
        y_e = swiglu(xt, w_gate[e], w_up[e], w_down[e])
        out = out + combine[:, e:e + 1].astype(x.dtype) * y_e
    return out.reshape(bsz, seq, d)


def setup_inputs(seed: int = 0) -> dict:
    key = jax.random.key(seed)
    ks = iter(jax.random.split(key, 48))

    def nrm(shape, scale):
        return jax.random.normal(next(ks), shape, jnp.float32) * scale

    def gain(shape):
        return 1.0 + nrm(shape, 0.05)

    def unif(shape, lo, hi):
        return jax.random.uniform(next(ks), shape, jnp.float32, lo, hi)

    D = D_MODEL
    return {
        "x": nrm((BATCH, SEQ, D), 1.0),
        "rel_bias_table": nrm((NUM_BUCKETS, A_Q_HEADS), 0.5),
        "even_w_in": nrm((N_EVEN, D, EVEN_IN_WIDTH), D ** -0.5),
        "even_sinks": nrm((N_EVEN, A_Q_HEADS), 0.5),
        "rwkv_mu": unif((N_EVEN, B_IN_WIDTH), 0.0, 1.0),
        "rwkv_w0": unif((N_EVEN, B_WIDTH), -6.0, 1.0),
        "rwkv_w_up": nrm((N_EVEN, DECAY_LORA, B_WIDTH), 0.5 * DECAY_LORA ** -0.5),
        "rwkv_a0": nrm((N_EVEN, B_WIDTH), 0.5),
        "rwkv_a_up": nrm((N_EVEN, AAA_LORA, B_WIDTH), 0.5 * AAA_LORA ** -0.5),
        "rwkv_g_up": nrm((N_EVEN, GATE_LORA, B_WIDTH), GATE_LORA ** -0.5),
        "rwkv_k_k": 0.85 + nrm((N_EVEN, B_WIDTH), 0.05),
        "rwkv_k_a": 1.0 + nrm((N_EVEN, B_WIDTH), 0.05),
        "rwkv_r_k": nrm((N_EVEN, B_HEADS, HEAD_DIM), 0.1),
        "rwkv_gn_g": gain((N_EVEN, B_WIDTH)),
        "rwkv_gn_b": nrm((N_EVEN, B_WIDTH), 0.02),
        "even_w_out": nrm((N_EVEN, MIX_WIDTH, D), BETA * MIX_WIDTH ** -0.5),
        "even_ln_mix_g": gain((N_EVEN, D)),
        "even_ln_mix_b": nrm((N_EVEN, D), 0.02),
        "dense_w_gate": nrm((N_EVEN, D, D_FF_DENSE), D ** -0.5),
        "dense_w_up": nrm((N_EVEN, D, D_FF_DENSE), D ** -0.5),
        "dense_w_down": nrm((N_EVEN, D_FF_DENSE, D), BETA * D_FF_DENSE ** -0.5),
        "even_ln_ffn_g": gain((N_EVEN, D)),
        "even_ln_ffn_b": nrm((N_EVEN, D), 0.02),
        "odd_w_in": nrm((N_ODD, D, 3 * CONV_DIM), D ** -0.5),
        "odd_conv_w": nrm((N_ODD, CONV_WIDTH, CONV_DIM), CONV_WIDTH ** -0.5),
        "odd_w_out": nrm((N_ODD, CONV_DIM, D), BETA * CONV_DIM ** -0.5),
        "odd_ln_mix_g": gain((N_ODD, D)),
        "odd_ln_mix_b": nrm((N_ODD, D), 0.02),
        "router_w": nrm((N_ODD, D, N_EXPERTS), D ** -0.5),
        "moe_w_gate": nrm((N_ODD, N_EXPERTS, D, D_FF_EXPERT), D ** -0.5),
        "moe_w_up": nrm((N_ODD, N_EXPERTS, D, D_FF_EXPERT), D ** -0.5),
        "moe_w_down": nrm((N_ODD, N_EXPERTS, D_FF_EXPERT, D), BETA * D_FF_EXPERT ** -0.5),
        "odd_ln_ffn_g": gain((N_ODD, D)),
        "odd_ln_ffn_b": nrm((N_ODD, D), 0.02),
    }


def reference(x, rel_bias_table, even_w_in, even_sinks, rwkv_mu, rwkv_w0, rwkv_w_up, rwkv_a0, rwkv_a_up, rwkv_g_up, rwkv_k_k, rwkv_k_a, rwkv_r_k, rwkv_gn_g, rwkv_gn_b, even_w_out, even_ln_mix_g, even_ln_mix_b, dense_w_gate, dense_w_up, dense_w_down, even_ln_ffn_g, even_ln_ffn_b, odd_w_in, odd_conv_w, odd_w_out, odd_ln_mix_g, odd_ln_mix_b, router_w, moe_w_gate, moe_w_up, moe_w_down, odd_ln_ffn_g, odd_ln_ffn_b):
    h = x
    for layer in range(DEPTH):
        i = layer // 2
        if layer % 2 == 0:
            mix = attention_rwkv_mixer(h, even_w_in[i], even_sinks[i], rel_bias_table, rwkv_mu[i], rwkv_w0[i], rwkv_w_up[i], rwkv_a0[i], rwkv_a_up[i], rwkv_g_up[i], rwkv_k_k[i], rwkv_k_a[i], rwkv_r_k[i], rwkv_gn_g[i], rwkv_gn_b[i], even_w_out[i])
            h = layer_norm(ALPHA * h + mix, even_ln_mix_g[i], even_ln_mix_b[i])
            ffn = swiglu(h, dense_w_gate[i], dense_w_up[i], dense_w_down[i])
            h = layer_norm(ALPHA * h + ffn, even_ln_ffn_g[i], even_ln_ffn_b[i])
        else:
            mix = short_conv_mixer(h, odd_w_in[i], odd_conv_w[i], odd_w_out[i])
            h = layer_norm(ALPHA * h + mix, odd_ln_mix_g[i], odd_ln_mix_b[i])
            ffn = moe_swiglu(h, router_w[i], moe_w_gate[i], moe_w_up[i], moe_w_down[i])
            h = layer_norm(ALPHA * h + ffn, odd_ln_ffn_g[i], odd_ln_ffn_b[i])
    return h
```

```cpp
#include <hip/hip_runtime.h>
#include <stdio.h>

#ifndef MK_N_LAUNCHES
#define MK_N_LAUNCHES 1
#endif

#define GAS __attribute__((address_space(1)))
#define LAS __attribute__((address_space(3)))
typedef unsigned short bf16;
typedef unsigned v4u __attribute__((ext_vector_type(4)));
typedef unsigned v2u __attribute__((ext_vector_type(2)));
typedef float f32x2 __attribute__((ext_vector_type(2)));
typedef float f32x4 __attribute__((ext_vector_type(4)));
typedef float f32x16 __attribute__((ext_vector_type(16)));
typedef short bf16x8 __attribute__((ext_vector_type(8)));
typedef short s16x4 __attribute__((ext_vector_type(4)));
#define LDS_WAIT() asm volatile("s_waitcnt lgkmcnt(0)" ::: "memory")
#define VM_WAIT() asm volatile("s_waitcnt vmcnt(0)" ::: "memory")

constexpr int T_ = 32768, D_ = 1024, SEQ = 4096, NZ = 2560, FF = 2816, FFE = 3584, NEXP = 8;
constexpr int MAXPANEL = 136, PERMLEN = MAXPANEL * 256;
constexpr float ALPHA = 1.41421356237309515f, LN_EPS = 1e-5f, GN_EPS = 64e-5f, LOG2E = 1.44269504088896341f;

constexpr size_t MiB = 1u << 20;
constexpr size_t WS_CTL = 0, CTL_ZERO_BYTES = 1 * MiB;
constexpr size_t WS_TOKE = 1 * MiB, WS_TOKP = 1 * MiB + 128 * 1024, WS_WGCNT = 1 * MiB + 384 * 1024, WS_PTAB = WS_WGCNT + 16 * 1024, WS_PERM = 1 * MiB + 512 * 1024;
constexpr size_t WS_WIN0 = 2 * MiB, WS_WLORA = 7 * MiB, WS_WOUT0 = 8 * MiB, WS_WFGU = 10 * MiB, WS_WFD = 21 * MiB, WS_WIN1 = 27 * MiB, WS_WOUT1 = 33 * MiB, WS_WMGU = 35 * MiB, WS_WMD = 91 * MiB;
constexpr size_t WS_Y2 = 119 * MiB;
constexpr size_t WS_STP1 = 197 * MiB, WS_STP2 = 198 * MiB, WS_LNV = 196 * MiB;
constexpr size_t WS_B0 = 204 * MiB;
constexpr size_t WS_B1 = 268 * MiB;
constexpr size_t WS_ACT = 332 * MiB;
constexpr size_t WS_CV = 396 * MiB;
constexpr size_t WS_AP = 428 * MiB;
constexpr size_t WS_YRAW = 444 * MiB;
constexpr size_t WS_ACTM = 268 * MiB;
constexpr size_t WS_BONUS = 508 * MiB;
constexpr size_t WS_SLOT = 35 * MiB;
constexpr size_t WS_END = 510 * MiB;
static_assert(WS_ACTM + (size_t)2 * PERMLEN * FFE <= WS_END, "ACTM");
static_assert(WS_ACT + (size_t)T_ * FF * 2 <= WS_END, "ACT");
constexpr int CW_TMO = 0, CW_CODE = 1, CW_BAR = 4096;

constexpr int RING_BYTES = 131072, LDSCTL_OFF = 163328, MISC_OFF = LDSCTL_OFF, PTAB_OFF = RING_BYTES, RTAB_OFF = RING_BYTES + 2048;
constexpr int LDS_BYTES = 163840, STAT_OFF = RTAB_OFF, PST_OFF = RTAB_OFF + 8192;

namespace pg8 {
#define PG8_LAS __attribute__((address_space(3)))
typedef unsigned short bf16_t;
constexpr int BM = 256, BK = 64, HALF = 128, HTB = HALF * BK * 2, STAGE_BYTES = 8 * HTB, NXCD = 8, WGM = 8;
__host__ __device__ __forceinline__ int lds_byte(int r, int c) { const int st = (r >> 4) * 2 + (c >> 5), rr = r & 15, cc = c & 31, ob = rr * 64 + cc * 2; return st * 1024 + (ob ^ (((ob >> 9) & 1) << 5)); }
__host__ __device__ __forceinline__ void stage_rc(int b, int& R, int& C) { const int st = b / 1024, sb = b % 1024, swz = sb ^ (((sb >> 9) & 1) << 5); R = (st >> 1) * 16 + swz / 64; C = (st & 1) * 32 + (swz % 64) / 2; }
__host__ __device__ __forceinline__ int perm32(int rho) { const int n = rho >> 4, i = rho & 15; return 8 * (i >> 2) + 4 * n + (i & 3); }
struct Unit { int pm, pn, e, ui; };
__device__ __forceinline__ bool tile_order(int i, int G, int c, int nM, int nN, int& pm, int& pn) {
    const int nwg = nM * nN; const long L = (long)i * G + c; if (L >= nwg) return false;
    int wgid = (int)L; { const int q = nwg / NXCD, r = nwg % NXCD, xcd = wgid % NXCD, off = wgid / NXCD; wgid = (xcd < r ? xcd * (q + 1) : r * (q + 1) + (xcd - r) * q) + off; }
    const int nig = WGM * nN, gid = wgid / nig, fm = gid * WGM, gsz = (nM - fm) < WGM ? (nM - fm) : WGM;
    pm = fm + ((wgid % nig) % gsz); pn = (wgid % nig) / gsz; return true;
}
typedef __bf16 bf16x2_t __attribute__((ext_vector_type(2)));
__device__ __forceinline__ unsigned cvt_pk_bf16(float lo, float hi) { const f32x2 v = {lo, hi}; const bf16x2_t b = __builtin_convertvector(v, bf16x2_t); return __builtin_bit_cast(unsigned, b); }

typedef int i32x8 __attribute__((ext_vector_type(8)));
__device__ __forceinline__ i32x8 cat8(bf16x8 lo, bf16x8 hi) { const v4u a = __builtin_bit_cast(v4u, lo), b = __builtin_bit_cast(v4u, hi); return (i32x8){(int)a.x, (int)a.y, (int)a.z, (int)a.w, (int)b.x, (int)b.y, (int)b.z, (int)b.w}; }
template <class Epi, class Sched, bool F8 = false>
__device__ __forceinline__ void gemm_phase(PG8_LAS unsigned char* lds, const bf16_t* Abase, const int K, const Sched& S, const Epi& E) {
    const int tid = threadIdx.x, wid = __builtin_amdgcn_readfirstlane(tid >> 6), lane = tid & 63, wr = wid >> 2, wc = wid & 3, fr = lane & 15, fq = lane >> 4;
    const int nt = K / BK;
    int Rr[2], Cc[2]; unsigned voffB[2];
#pragma unroll
    for (int i = 0; i < 2; ++i) { stage_rc(tid * 16 + i * 8192, Rr[i], Cc[i]); const int Rb = Epi::PERM ? ((Rr[i] & ~31) + perm32(Rr[i] & 31)) : Rr[i]; voffB[i] = (unsigned)(Rb * K + Cc[i]) * 2u; }
    const size_t kstep = (size_t)(BK * 2);
    const size_t hstep = (size_t)HALF * K * 2;
    const unsigned ldsw = (unsigned)wid * 1024u;
    const int aoff = lds_byte(wr * 64 + fr, fq * 8), boff = lds_byte(wc * 32 + fr, fq * 8);
#define PG8_SA(b, h) (((b) * 2 + (h)) * HTB)
#define PG8_SB(b, h) ((4 + (b) * 2 + (h)) * HTB)
#define PG8_STAGE(bufoff, gbase, voff) do { _Pragma("unroll") for (int _i = 0; _i < 2; ++_i) \
        __builtin_amdgcn_global_load_lds((const unsigned*)((const char*)(gbase) + (voff)[_i]), (PG8_LAS unsigned*)(lds + (bufoff) + ldsw + _i * 8192), 16, 0, 0); } while (0)
#define PG8_LDA(dst, b, h) do { _Pragma("unroll") for (int m = 0; m < 4; ++m) _Pragma("unroll") for (int k = 0; k < 2; ++k) { if constexpr (F8) { const v4u _q = *(const PG8_LAS v4u*)(lds + PG8_SA(b, h) + aoff + m * 2048 + k * 1024); \
        dst##8[m][4 * k] = (int)_q.x; dst##8[m][4 * k + 1] = (int)_q.y; dst##8[m][4 * k + 2] = (int)_q.z; dst##8[m][4 * k + 3] = (int)_q.w; } else dst[m][k] = *(const PG8_LAS bf16x8*)(lds + PG8_SA(b, h) + aoff + m * 2048 + k * 1024); } } while (0)
#define PG8_LDB(dst, b, h) do { _Pragma("unroll") for (int n = 0; n < 2; ++n) _Pragma("unroll") for (int k = 0; k < 2; ++k) { if constexpr (F8) { const v4u _q = *(const PG8_LAS v4u*)(lds + PG8_SB(b, h) + boff + n * 2048 + k * 1024); \
        dst##8[n][4 * k] = (int)_q.x; dst##8[n][4 * k + 1] = (int)_q.y; dst##8[n][4 * k + 2] = (int)_q.z; dst##8[n][4 * k + 3] = (int)_q.w; } else dst[n][k] = *(const PG8_LAS bf16x8*)(lds + PG8_SB(b, h) + boff + n * 2048 + k * 1024); } } while (0)
#define PG8_MMA(ai, bj, At, Bt) do { __builtin_amdgcn_s_setprio(1); if constexpr (F8) { _Pragma("unroll") for (int m = 0; m < 4; ++m) _Pragma("unroll") for (int n = 0; n < 2; ++n) \
        asm volatile("v_mfma_scale_f32_16x16x128_f8f6f4 %0, %1, %2, %0, %3, %4 op_sel_hi:[0,0,0]" : "+v"(acc[ai][bj][m][n]) : "v"(Bt##8[n]), "v"(At##8[m]), "v"(scl_w), "v"(scl_a)); } else { \
        _Pragma("unroll") for (int m = 0; m < 4; ++m) _Pragma("unroll") for (int n = 0; n < 2; ++n) _Pragma("unroll") for (int k = 0; k < 2; ++k) \
        acc[ai][bj][m][n] = __builtin_amdgcn_mfma_f32_16x16x32_bf16(Bt[n][k], At[m][k], acc[ai][bj][m][n], 0, 0, 0); } __builtin_amdgcn_s_setprio(0); } while (0)
#define PG8_WAIT_V(n) asm volatile("s_waitcnt vmcnt(" #n ")" ::: "memory")
#define PG8_WAIT_L(n) asm volatile("s_waitcnt lgkmcnt(" #n ")" ::: "memory")
#define PG8_BAR __builtin_amdgcn_s_barrier()
#define PG8_SCHED __builtin_amdgcn_sched_barrier(0)
#define PG8_AOFF(dst, u) do { _Pragma("unroll") for (int _h = 0; _h < 2; ++_h) _Pragma("unroll") for (int _i = 0; _i < 2; ++_i) dst[_h][_i] = S.a_off(u, _h * HALF + Rr[_i]) + (unsigned)Cc[_i] * 2u; } while (0)
    Unit cur, nxt; int ui = 0;
    if (!S.next(0, cur)) return;
    f32x4 acc[2][2][4][2];
#pragma unroll
    for (int a = 0; a < 2; ++a)
#pragma unroll
        for (int b = 0; b < 2; ++b)
#pragma unroll
            for (int m = 0; m < 4; ++m)
#pragma unroll
                for (int n = 0; n < 2; ++n) acc[a][b][m][n] = (f32x4){0.f, 0.f, 0.f, 0.f};
    bf16x8 At[4][2], B0[2][2], B1[2][2]; i32x8 At8[4], B08[2], B18[2];
    int scl_w = 0x7f7f7f7f, scl_a = 0x7f7f7f7f; if constexpr (F8) { scl_w = (int)Epi::SCALE_W; asm volatile("" : "+v"(scl_w), "+v"(scl_a)); }
    unsigned curA[2][2], nxtA[2][2];
    PG8_AOFF(curA, cur);
    const char* const A0 = (const char*)Abase;
    const char* cB = S.b_ptr(cur);
    PG8_STAGE(PG8_SB(0, 0), cB, voffB); PG8_STAGE(PG8_SB(0, 1), cB + hstep, voffB); PG8_STAGE(PG8_SA(0, 0), A0, curA[0]); PG8_STAGE(PG8_SA(0, 1), A0, curA[1]);
    if (wr == 1) PG8_BAR;
    PG8_WAIT_V(2); PG8_BAR;
    PG8_STAGE(PG8_SB(1, 0), cB + kstep, voffB); PG8_STAGE(PG8_SA(1, 0), A0 + kstep, curA[0]); PG8_STAGE(PG8_SB(1, 1), cB + hstep + kstep, voffB);
    PG8_WAIT_V(6); PG8_BAR;
    for (;;) {
        const bool has_next = S.next(ui + 1, nxt);
        const char* nB = has_next ? S.b_ptr(nxt) : cB;
        if (has_next) { PG8_AOFF(nxtA, nxt); } else {
#pragma unroll
            for (int h = 0; h < 2; ++h)
#pragma unroll
                for (int i = 0; i < 2; ++i) nxtA[h][i] = curA[h][i]; }
        for (int t = 0; t < nt; t += 2) {
            const bool last = (t == nt - 2);
            const char* a1 = A0 + (size_t)(t + 1) * kstep;
            const char* a2 = last ? A0 : A0 + (size_t)(t + 2) * kstep; const char* b2 = last ? nB : cB + (size_t)(t + 2) * kstep;
            const char* a3 = a2 + kstep; const char* b3 = b2 + kstep;
            unsigned o2[2][2];
#pragma unroll
            for (int h = 0; h < 2; ++h)
#pragma unroll
                for (int i = 0; i < 2; ++i) o2[h][i] = last ? nxtA[h][i] : curA[h][i];
            PG8_LDB(B0, 0, 0); PG8_LDB(B1, 0, 1); PG8_SCHED; PG8_LDA(At, 0, 0); PG8_STAGE(PG8_SA(1, 1), a1, curA[1]);
            PG8_WAIT_V(8); PG8_WAIT_L(0); PG8_BAR; PG8_MMA(0, 0, At, B0); PG8_MMA(0, 1, At, B1); PG8_BAR; PG8_SCHED;
            PG8_LDA(At, 0, 1); PG8_STAGE(PG8_SB(0, 0), b2, voffB); PG8_STAGE(PG8_SB(0, 1), b2 + hstep, voffB); PG8_STAGE(PG8_SA(0, 0), a2, o2[0]);
            PG8_WAIT_V(8); PG8_WAIT_L(0); PG8_BAR; PG8_MMA(1, 0, At, B0); PG8_MMA(1, 1, At, B1); PG8_BAR; PG8_SCHED;
            PG8_LDB(B0, 1, 0); PG8_LDB(B1, 1, 1); PG8_SCHED; PG8_LDA(At, 1, 0); PG8_STAGE(PG8_SA(0, 1), a2, o2[1]);
            PG8_WAIT_V(8); PG8_WAIT_L(0); PG8_BAR; PG8_MMA(0, 0, At, B0); PG8_MMA(0, 1, At, B1); PG8_BAR; PG8_SCHED;
            PG8_LDA(At, 1, 1); PG8_STAGE(PG8_SB(1, 0), b3, voffB); PG8_STAGE(PG8_SB(1, 1), b3 + hstep, voffB); PG8_STAGE(PG8_SA(1, 0), a3, o2[0]);
            PG8_WAIT_V(8); PG8_WAIT_L(0); PG8_BAR; PG8_MMA(1, 0, At, B0); PG8_MMA(1, 1, At, B1); PG8_BAR; PG8_SCHED;
        }
        if (wr == 0) PG8_BAR;
        if constexpr (F8) asm volatile("s_nop 15\n\ts_nop 7" ::: "memory");
        E(acc, cur, wr, wc, fr, fq);
        if (!has_next) break;
#pragma unroll
        for (int a = 0; a < 2; ++a)
#pragma unroll
            for (int b = 0; b < 2; ++b)
#pragma unroll
                for (int m = 0; m < 4; ++m)
#pragma unroll
                    for (int n = 0; n < 2; ++n) acc[a][b][m][n] = (f32x4){0.f, 0.f, 0.f, 0.f};
        cur = nxt; cB = nB; ++ui;
#pragma unroll
        for (int h = 0; h < 2; ++h)
#pragma unroll
            for (int i = 0; i < 2; ++i) curA[h][i] = nxtA[h][i];
        if (wr == 1) PG8_BAR;
    }
    PG8_WAIT_V(0);
    PG8_BAR;
#undef PG8_SA
#undef PG8_SB
#undef PG8_STAGE
#undef PG8_LDA
#undef PG8_LDB
#undef PG8_MMA
#undef PG8_WAIT_V
#undef PG8_WAIT_L
#undef PG8_BAR
#undef PG8_SCHED
#undef PG8_AOFF
}

struct DenseSched {
    int nM, nN, G, c, K; const bf16_t* Bt;
    __device__ __forceinline__ bool next(int i, Unit& u) const { u.e = 0; u.ui = i; return tile_order(i, G, c, nM, nN, u.pm, u.pn); }
    __device__ __forceinline__ unsigned a_off(const Unit& u, int rr) const { return (unsigned)((u.pm * BM + rr) * K) * 2u; }
    __device__ __forceinline__ const char* b_ptr(const Unit& u) const { return (const char*)Bt + (size_t)u.pn * BM * K * 2; }
};
struct MoeUpSched {
    int nP, G, c; const unsigned char* Bt; const PG8_LAS int* ptab; const PG8_LAS unsigned short* rtab;
    __device__ __forceinline__ bool next(int i, Unit& u) const { u.ui = i; int pi; if (!tile_order(i, G, c, nP, 28, pi, u.pn)) return false; const int en = ptab[2 + pi]; u.pm = en >> 8; u.e = en & 255; return true; }
    __device__ __forceinline__ unsigned a_off(const Unit& u, int rr) const { return (unsigned)rtab[u.ui * 256 + rr] * 1024u; }
    __device__ __forceinline__ const char* b_ptr(const Unit& u) const { return (const char*)Bt + ((size_t)u.e * 7168 + (size_t)u.pn * BM) * 1024; }
};
struct MoeDownSched {
    int nP, p0, G, c; const unsigned char* Bt; const PG8_LAS int* ptab;
    __device__ __forceinline__ bool next(int i, Unit& u) const { u.ui = i; int pi; if (!tile_order(i, G, c, nP, 4, pi, u.pn)) return false; const int en = ptab[2 + p0 + pi]; u.pm = en >> 8; u.e = en & 255; return true; }
    __device__ __forceinline__ unsigned a_off(const Unit& u, int rr) const { return (unsigned)(u.pm * BM + rr) * (unsigned)FFE; }
    __device__ __forceinline__ const char* b_ptr(const Unit& u) const { return (const char*)Bt + ((size_t)u.e * 1024 + (size_t)u.pn * BM) * FFE; }
};

struct EpiBf16 {
    static constexpr bool PERM = true;
    bf16_t* O; int ldc;
    __device__ __forceinline__ void operator()(const f32x4 (&acc)[2][2][4][2], const Unit& u, int wr, int wc, int fr, int fq) const {
        const int row0 = u.pm * BM + wr * 64 + fr, col0 = u.pn * BM + wc * 32 + 8 * fq;
#pragma unroll
        for (int ai = 0; ai < 2; ++ai)
#pragma unroll
            for (int m = 0; m < 4; ++m) { bf16_t* rowp = O + (size_t)(row0 + ai * HALF + m * 16) * ldc + col0;
#pragma unroll
                for (int bj = 0; bj < 2; ++bj) { const f32x4 v0 = acc[ai][bj][m][0], v1 = acc[ai][bj][m][1];
                    v4u w; w.x = cvt_pk_bf16(v0[0], v0[1]); w.y = cvt_pk_bf16(v0[2], v0[3]); w.z = cvt_pk_bf16(v1[0], v1[1]); w.w = cvt_pk_bf16(v1[2], v1[3]);
                    *(v4u*)(rowp + bj * HALF) = w; } }
    }
};
__device__ __forceinline__ float silu_f(float g) { return g * __builtin_amdgcn_rcpf(1.0f + __expf(-g)); }
struct EpiSwiglu {
    static constexpr bool PERM = true;
    bf16_t* O; int ldc;
    __device__ __forceinline__ void operator()(const f32x4 (&acc)[2][2][4][2], const Unit& u, int wr, int wc, int fr, int fq) const {
        const int row0 = u.pm * BM + wr * 64 + fr, col0 = u.pn * HALF + wc * 32 + 8 * fq;
#pragma unroll
        for (int ai = 0; ai < 2; ++ai)
#pragma unroll
            for (int m = 0; m < 4; ++m) { bf16_t* rowp = O + (size_t)(row0 + ai * HALF + m * 16) * ldc + col0;
                const f32x4 g0 = acc[ai][0][m][0], g1 = acc[ai][0][m][1], u0 = acc[ai][1][m][0], u1 = acc[ai][1][m][1];
                v4u w; w.x = cvt_pk_bf16(silu_f(g0[0]) * u0[0], silu_f(g0[1]) * u0[1]); w.y = cvt_pk_bf16(silu_f(g0[2]) * u0[2], silu_f(g0[3]) * u0[3]);
                w.z = cvt_pk_bf16(silu_f(g1[0]) * u1[0], silu_f(g1[1]) * u1[1]); w.w = cvt_pk_bf16(silu_f(g1[2]) * u1[2], silu_f(g1[3]) * u1[3]);
                *(v4u*)rowp = w; }
    }
};
__device__ __forceinline__ unsigned pk4_fp8(float a, float b, float c, float d) { int p = 0; p = __builtin_amdgcn_cvt_pk_fp8_f32(a, b, p, false); p = __builtin_amdgcn_cvt_pk_fp8_f32(c, d, p, true); return (unsigned)p; }
struct EpiSwiglu8 {
    static constexpr bool PERM = true; static constexpr unsigned SCALE_W = 0x7a7a7a7au;
    unsigned char* O; int ldc;
    __device__ __forceinline__ void operator()(const f32x4 (&acc)[2][2][4][2], const Unit& u, int wr, int wc, int fr, int fq) const {
        const int row0 = u.pm * BM + wr * 64 + fr, col0 = u.pn * HALF + wc * 32 + 8 * fq;
#pragma unroll
        for (int ai = 0; ai < 2; ++ai)
#pragma unroll
            for (int m = 0; m < 4; ++m) { unsigned char* rowp = O + (size_t)(row0 + ai * HALF + m * 16) * ldc + col0;
                const f32x4 g0 = acc[ai][0][m][0], g1 = acc[ai][0][m][1], u0 = acc[ai][1][m][0], u1 = acc[ai][1][m][1];
                v2u w; w.x = pk4_fp8(silu_f(g0[0]) * u0[0], silu_f(g0[1]) * u0[1], silu_f(g0[2]) * u0[2], silu_f(g0[3]) * u0[3]);
                w.y = pk4_fp8(silu_f(g1[0]) * u1[0], silu_f(g1[1]) * u1[1], silu_f(g1[2]) * u1[2], silu_f(g1[3]) * u1[3]);
                *(v2u*)rowp = w; }
    }
};
struct EpiL1in {
    static constexpr bool PERM = true;
    bf16_t* GB; bf16_t* UP;
    __device__ __forceinline__ void operator()(const f32x4 (&acc)[2][2][4][2], const Unit& u, int wr, int wc, int fr, int fq) const {
        const int row0 = u.pm * BM + wr * 64 + fr;
        if (u.pn < 4) {
            const int col0 = u.pn * BM + wc * 32 + 8 * fq;
#pragma unroll
            for (int ai = 0; ai < 2; ++ai)
#pragma unroll
                for (int m = 0; m < 4; ++m) { bf16_t* rowp = GB + (size_t)(row0 + ai * HALF + m * 16) * D_ + col0;
#pragma unroll
                    for (int bj = 0; bj < 2; ++bj) { const f32x4 v0 = acc[ai][bj][m][0], v1 = acc[ai][bj][m][1];
                        v4u w; w.x = cvt_pk_bf16(v0[0], v0[1]); w.y = cvt_pk_bf16(v0[2], v0[3]); w.z = cvt_pk_bf16(v1[0], v1[1]); w.w = cvt_pk_bf16(v1[2], v1[3]);
                        *(v4u*)(rowp + bj * HALF) = w; } }
        } else {
            const int col0 = (u.pn - 4) * HALF + wc * 32 + 8 * fq;
#pragma unroll
            for (int ai = 0; ai < 2; ++ai)
#pragma unroll
                for (int m = 0; m < 4; ++m) { bf16_t* rowp = UP + (size_t)(row0 + ai * HALF + m * 16) * D_ + col0;
                    const f32x4 g0 = acc[ai][0][m][0], g1 = acc[ai][0][m][1], u0 = acc[ai][1][m][0], u1 = acc[ai][1][m][1];
                    v4u w; w.x = cvt_pk_bf16(g0[0] * u0[0], g0[1] * u0[1]); w.y = cvt_pk_bf16(g0[2] * u0[2], g0[3] * u0[3]);
                    w.z = cvt_pk_bf16(g1[0] * u1[0], g1[1] * u1[1]); w.w = cvt_pk_bf16(g1[2] * u1[2], g1[3] * u1[3]);
                    *(v4u*)rowp = w; }
        }
    }
};
struct EpiLora {
    static constexpr bool PERM = false;
    float* WLOG; bf16_t* AB; bf16_t* GBUF; const float* w0; const float* a0;
    __device__ __forceinline__ void operator()(const f32x4 (&acc)[2][2][4][2], const Unit& u, int wr, int wc, int fr, int fq) const {
        const int row0 = u.pm * BM + wr * 64 + fr, sec = u.pn >> 1, chb = (u.pn & 1) * BM + wc * 32 + 4 * fq;
        if (sec == 0) {
#pragma unroll
            for (int bj = 0; bj < 2; ++bj)
#pragma unroll
                for (int n = 0; n < 2; ++n) { const int ch = chb + bj * HALF + n * 16; const f32x4 bias = *(const f32x4*)(w0 + ch);
#pragma unroll
                    for (int ai = 0; ai < 2; ++ai)
#pragma unroll
                        for (int m = 0; m < 4; ++m) { const size_t ro = (size_t)(row0 + ai * HALF + m * 16) * 512 + ch; const f32x4 v = acc[ai][bj][m][n] + bias; f32x4 o;
#pragma unroll
                            for (int j = 0; j < 4; ++j) o[j] = -0.60653065971263342f * __builtin_amdgcn_rcpf(1.0f + __expf(-v[j]));
                            *(f32x4*)(WLOG + ro) = o; } }
        } else if (sec == 1) {
#pragma unroll
            for (int bj = 0; bj < 2; ++bj)
#pragma unroll
                for (int n = 0; n < 2; ++n) { const int ch = chb + bj * HALF + n * 16; const f32x4 bias = *(const f32x4*)(a0 + ch);
#pragma unroll
                    for (int ai = 0; ai < 2; ++ai)
#pragma unroll
                        for (int m = 0; m < 4; ++m) { const size_t ro = (size_t)(row0 + ai * HALF + m * 16) * 512 + ch; const f32x4 v = acc[ai][bj][m][n] + bias; f32x4 o;
#pragma unroll
                            for (int j = 0; j < 4; ++j) o[j] = __builtin_amdgcn_rcpf(1.0f + __expf(-v[j]));
                            v2u w; w.x = cvt_pk_bf16(o[0], o[1]); w.y = cvt_pk_bf16(o[2], o[3]); *(v2u*)(AB + ro) = w; } }
        } else {
#pragma unroll
            for (int bj = 0; bj < 2; ++bj)
#pragma unroll
                for (int n = 0; n < 2; ++n) { const int ch = chb + bj * HALF + n * 16;
#pragma unroll
                    for (int ai = 0; ai < 2; ++ai)
#pragma unroll
                        for (int m = 0; m < 4; ++m) { const size_t ro = (size_t)(row0 + ai * HALF + m * 16) * 512 + ch; const f32x4 v = acc[ai][bj][m][n];
                            v2u w; w.x = cvt_pk_bf16(v[0], v[1]); w.y = cvt_pk_bf16(v[2], v[3]); *(v2u*)(GBUF + ro) = w; } }
        }
    }
};
__device__ __forceinline__ void row_stats(const float* stp, int row, float& mu, float& r) {
    const f32x4 a = *(const f32x4*)(stp + (size_t)row * 8), b = *(const f32x4*)(stp + (size_t)row * 8 + 4);
    const float s = ((a[0] + a[2]) + b[0]) + b[2], q = ((a[1] + a[3]) + b[1]) + b[3];
    mu = s * (1.0f / 1024.0f); r = rsqrtf(fmaxf(q * (1.0f / 1024.0f) - mu * mu, 0.f) + LN_EPS);
}
struct EpiResStats {
    static constexpr bool PERM = false;
    const float* base; float* out; bf16_t* outb; float* stp_out; PG8_LAS float* P; const PG8_LAS float* tbl; const float* stp_in; const float* gin; const float* bin;
    __device__ __forceinline__ void operator()(const f32x4 (&acc)[2][2][4][2], const Unit& u, int wr, int wc, int fr, int fq) const {
        const int row0 = u.pm * BM + wr * 64 + fr, col0 = u.pn * BM + wc * 32 + 4 * fq;
        f32x4 gv[2][2], bv[2][2];
        if (stp_in) {
#pragma unroll
            for (int bj = 0; bj < 2; ++bj)
#pragma unroll
                for (int n = 0; n < 2; ++n) { gv[bj][n] = *(const f32x4*)(gin + col0 + bj * HALF + n * 16); bv[bj][n] = *(const f32x4*)(bin + col0 + bj * HALF + n * 16); } }
#pragma unroll
        for (int ai = 0; ai < 2; ++ai)
#pragma unroll
            for (int m = 0; m < 4; ++m) { const int row = row0 + ai * HALF + m * 16; const size_t off = (size_t)row * D_ + col0;
                float mu = 0.f, rr = 1.f; if (stp_in) { const f32x2 mr = *(const PG8_LAS f32x2*)(tbl + (u.ui * 256 + ai * HALF + wr * 64 + m * 16 + fr) * 2); mu = mr[0]; rr = mr[1]; }
                float s = 0.f, q = 0.f;
#pragma unroll
                for (int bj = 0; bj < 2; ++bj)
#pragma unroll
                    for (int n = 0; n < 2; ++n) { f32x4 h = *(const f32x4*)(base + off + bj * HALF + n * 16);
                        if (stp_in) h = (h - mu) * rr * gv[bj][n] + bv[bj][n];
                        const f32x4 v = h * ALPHA + acc[ai][bj][m][n];
                        *(f32x4*)(out + off + bj * HALF + n * 16) = v;
                        if (outb) { v2u w; w.x = cvt_pk_bf16(v[0], v[1]); w.y = cvt_pk_bf16(v[2], v[3]); *(v2u*)(outb + off + bj * HALF + n * 16) = w; }
                        s += (v[0] + v[1]) + (v[2] + v[3]); q += (v[0] * v[0] + v[1] * v[1]) + (v[2] * v[2] + v[3] * v[3]); }
                if (stp_out) { s += __shfl_xor(s, 16); s += __shfl_xor(s, 32); q += __shfl_xor(q, 16); q += __shfl_xor(q, 32);
                    if (fq == 0) { PG8_LAS float* p = P + ((ai * HALF + wr * 64 + m * 16 + fr) * 4 + wc) * 2; p[0] = s; p[1] = q; } } }
        if (stp_out) {
            asm volatile("s_waitcnt lgkmcnt(0)" ::: "memory"); __builtin_amdgcn_s_barrier(); asm volatile("" ::: "memory");
            const int t = threadIdx.x;
            if (t < 256) { const f32x4 a = *(const PG8_LAS f32x4*)(P + t * 8), b = *(const PG8_LAS f32x4*)(P + t * 8 + 4);
                f32x2 o; o[0] = ((a[0] + a[2]) + b[0]) + b[2]; o[1] = ((a[1] + a[3]) + b[1]) + b[3];
                *(f32x2*)(stp_out + (size_t)(u.pm * BM + t) * 8 + u.pn * 2) = o; } }
    }
};
struct EpiSwigluLN {
    static constexpr bool PERM = true;
    bf16_t* O; int ldc; const PG8_LAS float* tbl; const float* sv; const float* cv;
    __device__ __forceinline__ void operator()(const f32x4 (&acc)[2][2][4][2], const Unit& u, int wr, int wc, int fr, int fq) const {
        const int row0 = u.pm * BM + wr * 64 + fr, col0 = u.pn * HALF + wc * 32 + 8 * fq, n0 = u.pn * BM + wc * 32 + 8 * fq;
        f32x4 sg[2], cg[2], su[2], cu[2];
#pragma unroll
        for (int n = 0; n < 2; ++n) { sg[n] = *(const f32x4*)(sv + n0 + 4 * n); cg[n] = *(const f32x4*)(cv + n0 + 4 * n); su[n] = *(const f32x4*)(sv + n0 + HALF + 4 * n); cu[n] = *(const f32x4*)(cv + n0 + HALF + 4 * n); }
#pragma unroll
        for (int ai = 0; ai < 2; ++ai)
#pragma unroll
            for (int m = 0; m < 4; ++m) { const int row = row0 + ai * HALF + m * 16; bf16_t* rowp = O + (size_t)row * ldc + col0;
                const f32x2 mr = *(const PG8_LAS f32x2*)(tbl + (u.ui * 256 + ai * HALF + wr * 64 + m * 16 + fr) * 2); const float mu = mr[0], rr = mr[1];
                const f32x4 g0 = (acc[ai][0][m][0] - sg[0] * mu) * rr + cg[0], g1 = (acc[ai][0][m][1] - sg[1] * mu) * rr + cg[1];
                const f32x4 u0 = (acc[ai][1][m][0] - su[0] * mu) * rr + cu[0], u1 = (acc[ai][1][m][1] - su[1] * mu) * rr + cu[1];
                v4u w; w.x = cvt_pk_bf16(silu_f(g0[0]) * u0[0], silu_f(g0[1]) * u0[1]); w.y = cvt_pk_bf16(silu_f(g0[2]) * u0[2], silu_f(g0[3]) * u0[3]);
                w.z = cvt_pk_bf16(silu_f(g1[0]) * u1[0], silu_f(g1[1]) * u1[1]); w.w = cvt_pk_bf16(silu_f(g1[2]) * u1[2], silu_f(g1[3]) * u1[3]);
                *(v4u*)rowp = w; }
    }
};
struct EpiL1inLN {
    static constexpr bool PERM = true;
    bf16_t* GB; bf16_t* UP; const PG8_LAS float* tbl; const float* sv; const float* cv;
    __device__ __forceinline__ void operator()(const f32x4 (&acc)[2][2][4][2], const Unit& u, int wr, int wc, int fr, int fq) const {
        const int row0 = u.pm * BM + wr * 64 + fr, n0 = u.pn * BM + wc * 32 + 8 * fq;
        f32x4 s0[2], c0[2], s1[2], c1[2];
#pragma unroll
        for (int n = 0; n < 2; ++n) { s0[n] = *(const f32x4*)(sv + n0 + 4 * n); c0[n] = *(const f32x4*)(cv + n0 + 4 * n); s1[n] = *(const f32x4*)(sv + n0 + HALF + 4 * n); c1[n] = *(const f32x4*)(cv + n0 + HALF + 4 * n); }
#pragma unroll
        for (int ai = 0; ai < 2; ++ai)
#pragma unroll
            for (int m = 0; m < 4; ++m) { const int row = row0 + ai * HALF + m * 16;
                const f32x2 mr = *(const PG8_LAS f32x2*)(tbl + (u.ui * 256 + ai * HALF + wr * 64 + m * 16 + fr) * 2); const float mu = mr[0], rr = mr[1];
                const f32x4 a0 = (acc[ai][0][m][0] - s0[0] * mu) * rr + c0[0], a1 = (acc[ai][0][m][1] - s0[1] * mu) * rr + c0[1];
                const f32x4 b0 = (acc[ai][1][m][0] - s1[0] * mu) * rr + c1[0], b1 = (acc[ai][1][m][1] - s1[1] * mu) * rr + c1[1];
                if (u.pn < 4) { bf16_t* rowp = GB + (size_t)row * D_ + n0;
                    v4u w; w.x = cvt_pk_bf16(a0[0], a0[1]); w.y = cvt_pk_bf16(a0[2], a0[3]); w.z = cvt_pk_bf16(a1[0], a1[1]); w.w = cvt_pk_bf16(a1[2], a1[3]); *(v4u*)rowp = w;
                    v4u x; x.x = cvt_pk_bf16(b0[0], b0[1]); x.y = cvt_pk_bf16(b0[2], b0[3]); x.z = cvt_pk_bf16(b1[0], b1[1]); x.w = cvt_pk_bf16(b1[2], b1[3]); *(v4u*)(rowp + HALF) = x; }
                else { bf16_t* rowp = UP + (size_t)row * D_ + (u.pn - 4) * HALF + wc * 32 + 8 * fq;
                    v4u w; w.x = cvt_pk_bf16(a0[0] * b0[0], a0[1] * b0[1]); w.y = cvt_pk_bf16(a0[2] * b0[2], a0[3] * b0[3]); w.z = cvt_pk_bf16(a1[0] * b1[0], a1[1] * b1[1]); w.w = cvt_pk_bf16(a1[2] * b1[2], a1[3] * b1[3]); *(v4u*)rowp = w; } }
    }
};
struct EpiDbg {
    static constexpr bool PERM = false;
    float* out;
    __device__ __forceinline__ void operator()(const f32x4 (&acc)[2][2][4][2], const Unit& u, int wr, int wc, int fr, int fq) const {
        if (u.pn >= 4) return;
        const int row0 = u.pm * BM + wr * 64 + fr, col0 = u.pn * BM + wc * 32 + 4 * fq;
#pragma unroll
        for (int ai = 0; ai < 2; ++ai)
#pragma unroll
            for (int m = 0; m < 4; ++m) { const size_t off = (size_t)(row0 + ai * HALF + m * 16) * D_ + col0;
#pragma unroll
                for (int bj = 0; bj < 2; ++bj)
#pragma unroll
                    for (int n = 0; n < 2; ++n) *(f32x4*)(out + off + bj * HALF + n * 16) = acc[ai][bj][m][n]; }
    }
};
struct EpiMoeDown {
    static constexpr bool PERM = false; static constexpr unsigned SCALE_W = 0x78787878u;
    float* out; bf16_t* Y2; const int* perm; const float* tokp;
    __device__ __forceinline__ void operator()(const f32x4 (&acc)[2][2][4][2], const Unit& u, int wr, int wc, int fr, int fq) const {
        const int slot0 = u.pm * BM + wr * 64 + fr, col0 = u.pn * BM + wc * 32 + 4 * fq; const int pass = u.pm >= MAXPANEL ? 1 : 0;
#pragma unroll
        for (int ai = 0; ai < 2; ++ai)
#pragma unroll
            for (int m = 0; m < 4; ++m) { const int tok = perm[slot0 + ai * HALF + m * 16];
                if (tok >= 0) { const float p = tokp[2 * tok + pass]; const size_t off = (size_t)tok * D_ + col0;
                    if (pass == 0) {
#pragma unroll
                        for (int bj = 0; bj < 2; ++bj)
#pragma unroll
                            for (int n = 0; n < 2; ++n) { const f32x4 bs = *(const f32x4*)(out + off + bj * HALF + n * 16); *(f32x4*)(out + off + bj * HALF + n * 16) = bs * ALPHA + acc[ai][bj][m][n] * p; }
                    } else {
#pragma unroll
                        for (int bj = 0; bj < 2; ++bj)
#pragma unroll
                            for (int n = 0; n < 2; ++n) { const f32x4 v = acc[ai][bj][m][n] * p; v2u w; w.x = cvt_pk_bf16(v[0], v[1]); w.y = cvt_pk_bf16(v[2], v[3]); *(v2u*)(Y2 + off + bj * HALF + n * 16) = w; }
                    } } }
    }
};
}

#define XB_TMO      128
#define XB_XCNT(j)  (256  + 64 * (j))
#define XB_XSUB(j)  (1280 + 64 * (j))
#define XB_XGEN(j)  (2304 + 64 * (j))
#define XB_TOP      3328
#define XB_TOPGEN   3392
#define XCD_BAR_WORDS 3456
#define XB_SPIN_CAP (1u << 22)
__device__ __forceinline__ unsigned xb_ld(unsigned* p)              { return __hip_atomic_load(p, __ATOMIC_RELAXED, __HIP_MEMORY_SCOPE_AGENT); }
__device__ __forceinline__ unsigned xb_add(unsigned* p, unsigned v) { return __hip_atomic_fetch_add(p, v, __ATOMIC_RELAXED, __HIP_MEMORY_SCOPE_AGENT); }
__device__ __forceinline__ unsigned xb_xcc_id() { return (unsigned)__builtin_amdgcn_s_getreg((3 << 11) | 20) & 0xFu; }
#define XB_SPIN(cond, bar) do { unsigned _sp = 0; while (cond) { __builtin_amdgcn_s_sleep(1); \
    if ((++_sp & 255u) == 0u) { if (xb_ld(&(bar)[XB_TMO])) break; if (_sp > XB_SPIN_CAP) { atomicAdd(&(bar)[XB_TMO], 1u); break; } } } } while (0)
struct XcdBarrier { unsigned* bar; unsigned x; volatile LAS unsigned* st; };
__device__ __forceinline__ XcdBarrier xcd_barrier_post(unsigned* bar, volatile LAS unsigned* st) {
    XcdBarrier b; b.bar = bar; b.x = xb_xcc_id(); b.st = st;
    if (threadIdx.x == 0) (void)xb_add(&bar[XB_XCNT(b.x)], 1u);
    return b;
}
__device__ __forceinline__ void xcd_barrier_complete(unsigned* bar, unsigned x, unsigned& nloc, unsigned& nx) {
    const unsigned G = gridDim.x * gridDim.y * gridDim.z;
    unsigned sum, cnt, mine, sp = 0u;
    for (;;) {
        sum = 0u; cnt = 0u; mine = 0u;
#pragma unroll
        for (unsigned j = 0; j < 16; ++j) { const unsigned c = xb_ld(&bar[XB_XCNT(j)]); sum += c; cnt += (c > 0u) ? 1u : 0u; mine = (j == x) ? c : mine; }
        if (sum == G) break;
        __builtin_amdgcn_s_sleep(1);
        if ((++sp & 255u) == 0u) { if (xb_ld(&bar[XB_TMO])) break; if (sp > XB_SPIN_CAP) { atomicAdd(&bar[XB_TMO], 1u); break; } }
    }
    nloc = mine > 0u ? mine : 1u; nx = cnt > 0u ? cnt : 1u;
}
__device__ __forceinline__ void xcd_barrier(const XcdBarrier& b) {
    asm volatile("s_waitcnt vmcnt(0)" ::: "memory");
    __syncthreads();
    if (threadIdx.x == 0) {
        unsigned* bar = b.bar;
        __builtin_amdgcn_s_waitcnt(0);
        unsigned nloc = b.st[0], nx = b.st[1];
        if (nloc == 0u) { xcd_barrier_complete(bar, b.x, nloc, nx); b.st[0] = nloc; b.st[1] = nx; }
        const unsigned old = xb_add(&bar[XB_XSUB(b.x)], 1u);
        const unsigned gen = old / nloc;
        if (old + 1u == (gen + 1u) * nloc) {
            __builtin_amdgcn_fence(__ATOMIC_RELEASE, "agent");
            asm volatile("s_waitcnt vmcnt(0)" ::: "memory");
            const unsigned og = xb_add(&bar[XB_TOP], 1u);
            const unsigned tg = og / nx;
            if (og + 1u == (tg + 1u) * nx) xb_add(&bar[XB_TOPGEN], 1u);
            else XB_SPIN(xb_ld(&bar[XB_TOPGEN]) == tg, bar);
            __builtin_amdgcn_fence(__ATOMIC_ACQUIRE, "agent");
            xb_add(&bar[XB_XGEN(b.x)], 1u);
            asm volatile("s_waitcnt vmcnt(0)" ::: "memory");
        } else {
            XB_SPIN(xb_ld(&bar[XB_XGEN(b.x)]) == gen, bar);
            __builtin_amdgcn_fence(__ATOMIC_ACQUIRE, "agent");
            asm volatile("s_waitcnt vmcnt(0)" ::: "memory");
        }
    }
    __syncthreads();
}

__device__ __forceinline__ unsigned f2bf(float f) { unsigned u = __builtin_bit_cast(unsigned, f); return (u + 0x7fffu + ((u >> 16) & 1u)) >> 16; }
__device__ __forceinline__ unsigned pk2(float lo, float hi) { return pg8::cvt_pk_bf16(lo, hi); }
__device__ __forceinline__ float bf2f(unsigned short b) { return __builtin_bit_cast(float, ((unsigned)b) << 16); }
__device__ __forceinline__ float bflo(unsigned w) { return __builtin_bit_cast(float, w << 16); }
__device__ __forceinline__ float bfhi(unsigned w) { return __builtin_bit_cast(float, w & 0xffff0000u); }
__device__ __forceinline__ float wave_sum(float v) {
#pragma unroll
    for (int o = 1; o < 64; o <<= 1) v += __shfl_xor(v, o);
    return v;
}
template <int CTRL> __device__ __forceinline__ float dpp_mov(float x) { return __builtin_bit_cast(float, __builtin_amdgcn_update_dpp(0, __builtin_bit_cast(int, x), CTRL, 0xf, 0xf, false)); }
__device__ __forceinline__ float row16_sum(float x) { x += dpp_mov<0x128>(x); x += dpp_mov<0x124>(x); x += dpp_mov<0x122>(x); x += dpp_mov<0x121>(x); return x; }

__device__ __forceinline__ float rl_f(float x, int l) { return __builtin_bit_cast(float, __builtin_amdgcn_readlane(__builtin_bit_cast(int, x), l)); }
template <int CTRL, int RMASK> __device__ __forceinline__ float dpp_add_rm(float x) { return x + __builtin_bit_cast(float, __builtin_amdgcn_update_dpp(0, __builtin_bit_cast(int, x), CTRL, RMASK, 0xf, true)); }
__device__ __forceinline__ float wave_sum_fast(float x) { x = row16_sum(x); x = dpp_add_rm<0x142, 0xA>(x); x = dpp_add_rm<0x143, 0xC>(x); return rl_f(x, 63); }
struct WInfo { int tid, lane, wave, vcu, G, gw, NGW; };

__device__ __forceinline__ void tr_item(const float* __restrict__ W, int Nsrc, int c0, int k0, bf16* WT, int K, int n0, LAS float* scr, int lane, const float* ksc = nullptr) {
#pragma unroll 32
    for (int i = 0; i < 32; ++i) { const int kk = 2 * i + (lane >> 5); const float wv = W[(size_t)(k0 + kk) * Nsrc + c0 + (lane & 31)]; scr[kk * 33 + (lane & 31)] = ksc ? wv * ksc[k0 + kk] : wv; }
    LDS_WAIT(); asm volatile("" ::: "memory");
    const int c = lane & 7;
#pragma unroll
    for (int j = 0; j < 4; ++j) { const int n = (lane >> 3) + 8 * j; const LAS float* s = scr + (8 * c) * 33 + n;
        v4u o; o.x = pk2(s[0 * 33], s[1 * 33]); o.y = pk2(s[2 * 33], s[3 * 33]); o.z = pk2(s[4 * 33], s[5 * 33]); o.w = pk2(s[6 * 33], s[7 * 33]);
        *(v4u*)(WT + (size_t)(n0 + n) * K + k0 + 8 * c) = o; }
    LDS_WAIT(); asm volatile("" ::: "memory");
}
__device__ __forceinline__ void tr_item8(const float* __restrict__ Wsrc, int Nsrc, int c0, int k0, unsigned char* WT, int K, int n0, float scale, LAS float* scr, int lane) {
#pragma unroll 32
    for (int i = 0; i < 32; ++i) { const int kk = 2 * i + (lane >> 5); scr[kk * 33 + (lane & 31)] = Wsrc[(size_t)(k0 + kk) * Nsrc + c0 + (lane & 31)] * scale; }
    LDS_WAIT(); asm volatile("" ::: "memory");
    const int n = lane & 31, kh = lane >> 5; const LAS float* s = scr + (kh * 32) * 33 + n;
    v4u o0, o1;
#pragma unroll
    for (int q = 0; q < 4; ++q) { o0[q] = pg8::pk4_fp8(s[(4 * q) * 33], s[(4 * q + 1) * 33], s[(4 * q + 2) * 33], s[(4 * q + 3) * 33]); o1[q] = pg8::pk4_fp8(s[(16 + 4 * q) * 33], s[(17 + 4 * q) * 33], s[(18 + 4 * q) * 33], s[(19 + 4 * q) * 33]); }
    unsigned char* dst = WT + (size_t)(n0 + n) * K + k0 + kh * 32; *(v4u*)dst = o0; *(v4u*)(dst + 16) = o1;
    LDS_WAIT(); asm volatile("" ::: "memory");
}
constexpr int I_WIN0 = 16 * 80, I_WOUT = 16 * 32, I_FGU = 16 * 176, I_FD = 44 * 32, I_IN1 = 16 * 96, I_MGU1 = 16 * 224, I_MD1 = 56 * 32;
constexpr int NITEMS_MOE = 8 * I_MGU1 + 8 * I_MD1, NITEMS = I_WIN0 + I_WOUT + I_FGU + I_FD + I_IN1 + I_WOUT + NITEMS_MOE;
__device__ __forceinline__ void weight_item(const WInfo& W, LAS unsigned char* lds, const float* const* in, unsigned char* ws, int it) {
    LAS float* scr = (LAS float*)(lds + W.wave * 16384);
    for (int once = 0; once < 1; ++once) {
        int r = it;
        if (r < 8 * I_MGU1) { const int e = r / I_MGU1, r2 = r % I_MGU1, kb = r2 / 224, nb = r2 % 224, n0 = nb * 32, q = n0 >> 8, rr = n0 & 255;
            const float* src = (rr < 128 ? in[29] : in[30]) + (size_t)e * 1024 * FFE;
            tr_item8(src, FFE, q * 128 + (rr & 127), kb * 64, ws + WS_WMGU + (size_t)e * 7168 * 1024, 1024, n0, 32.0f, scr, W.lane); continue; } r -= 8 * I_MGU1;
        if (r < 8 * I_MD1) { const int e = r / I_MD1, r2 = r % I_MD1, kb = r2 / 32, nb = r2 % 32;
            tr_item8(in[31] + (size_t)e * FFE * 1024, 1024, nb * 32, kb * 64, ws + WS_WMD + (size_t)e * 1024 * FFE, FFE, nb * 32, 128.0f, scr, W.lane); continue; } r -= 8 * I_MD1;
        if (r < I_WIN0) { const int kb = r / 80, nb = r % 80; tr_item(in[2], NZ, nb * 32, kb * 64, (bf16*)(ws + WS_WIN0), 1024, nb * 32, scr, W.lane); continue; } r -= I_WIN0;
        if (r < I_WOUT) { const int kb = r / 32, nb = r % 32; tr_item(in[15], 1024, nb * 32, kb * 64, (bf16*)(ws + WS_WOUT0), 1024, nb * 32, scr, W.lane); continue; } r -= I_WOUT;
        if (r < I_FGU) { const int kb = r / 176, nb = r % 176, n0 = nb * 32, q = n0 >> 8, rr = n0 & 255;
            tr_item(rr < 128 ? in[18] : in[19], FF, q * 128 + (rr & 127), kb * 64, (bf16*)(ws + WS_WFGU), 1024, n0, scr, W.lane, in[16]); continue; } r -= I_FGU;
        if (r < I_FD) { const int kb = r / 32, nb = r % 32; tr_item(in[20], 1024, nb * 32, kb * 64, (bf16*)(ws + WS_WFD), FF, nb * 32, scr, W.lane); continue; } r -= I_FD;
        if (r < I_IN1) { const int kb = r / 96, nb = r % 96, n0 = nb * 32; int c0 = n0;
            if (n0 >= 1024) { const int q = (n0 - 1024) >> 8, rr = (n0 - 1024) & 255; c0 = (rr < 128 ? 1024 : 2048) + q * 128 + (rr & 127); }
            tr_item(in[23], 3072, c0, kb * 64, (bf16*)(ws + WS_WIN1), 1024, n0, scr, W.lane, in[21]); continue; } r -= I_IN1;
        { const int kb = r / 32, nb = r % 32; tr_item(in[25], 1024, nb * 32, kb * 64, (bf16*)(ws + WS_WOUT1), 1024, nb * 32, scr, W.lane); }
    }
}
__device__ __forceinline__ void p0_weights(const WInfo& W, LAS unsigned char* lds, const float* const* in, unsigned char* ws, int it_lo, int it_hi) {
    for (int it = it_lo + W.gw; it < it_hi; it += W.NGW) weight_item(W, lds, in, ws, it);
}
__device__ __forceinline__ void lnvec_block(const WInfo& W, LAS unsigned char* lds, const float* const* in, unsigned char* ws, int blk) {
    LAS float* red = (LAS float*)lds;
    float* SV = (float*)(ws + WS_LNV); float* CV = SV + 8704;
    {
        const bool ffn = blk < 88; const int n = (ffn ? blk : blk - 88) * 64 + W.lane;
        const float* src; int Nsrc, col; const float* gk; const float* bk;
        if (ffn) { const int q = n >> 8, rr = n & 255; src = rr < 128 ? in[18] : in[19]; Nsrc = FF; col = q * 128 + (rr & 127); gk = in[16]; bk = in[17]; }
        else { src = in[23]; Nsrc = 3072; col = n; if (n >= 1024) { const int q = (n - 1024) >> 8, rr = (n - 1024) & 255; col = (rr < 128 ? 1024 : 2048) + q * 128 + (rr & 127); } gk = in[21]; bk = in[22]; }
        float s = 0.f, c = 0.f;
#pragma unroll 32
        for (int kk = 0; kk < 128; ++kk) { const int k = W.wave * 128 + kk; const float wv = src[(size_t)k * Nsrc + col]; s += bflo(pk2(wv * gk[k], 0.f)); c += wv * bk[k]; }
        __syncthreads();
        red[(W.wave * 64 + W.lane) * 2] = s; red[(W.wave * 64 + W.lane) * 2 + 1] = c;
        __syncthreads();
        if (W.wave == 0) { float ss = 0.f, cc = 0.f;
#pragma unroll
            for (int w8 = 0; w8 < 8; ++w8) { ss += red[(w8 * 64 + W.lane) * 2]; cc += red[(w8 * 64 + W.lane) * 2 + 1]; }
            const int o = (ffn ? 0 : 5632) + n; SV[o] = ss; CV[o] = cc; }
    }
}
__device__ __forceinline__ void p0_prologue(const WInfo& W, LAS unsigned char* lds, const float* const* in, unsigned char* ws) {
    p0_weights(W, lds, in, ws, NITEMS_MOE, NITEMS_MOE + I_WIN0);
    const size_t gtid = (size_t)W.gw * 64 + W.lane, NT = (size_t)W.NGW * 64;
    { bf16* WL = (bf16*)(ws + WS_WLORA);
      for (size_t i = gtid; i < (size_t)1536 * 256; i += NT) { const int n = (int)(i >> 8), k = (int)(i & 255), s = n >> 9, ch = n & 511; float v = 0.f;
          if (s == 0) { if (k < 64) v = in[6][k * 512 + ch]; } else if (s == 1) { if (k >= 64 && k < 128) v = in[8][(k - 64) * 512 + ch]; } else { if (k >= 128) v = in[9][(k - 128) * 512 + ch]; }
          WL[i] = (bf16)f2bf(v); } }
    { const f32x4* x4 = (const f32x4*)in[0]; v4u* xb = (v4u*)(ws + WS_B0);
      for (size_t i = gtid; i < (size_t)T_ * D_ / 8; i += NT) { const f32x4 a = x4[2 * i], b = x4[2 * i + 1]; v4u o; o.x = pk2(a[0], a[1]); o.y = pk2(a[2], a[3]); o.z = pk2(b[0], b[1]); o.w = pk2(b[2], b[3]); xb[i] = o; } }
    { int* pm = (int*)(ws + WS_PERM); for (size_t i = gtid; i < (size_t)2 * PERMLEN; i += NT) pm[i] = -1; }
}

__device__ __forceinline__ void deferred_work(const WInfo& W, LAS unsigned char* lds, const float* const* in, unsigned char* ws, unsigned* qctr) {
    constexpr int ITEM0 = NITEMS_MOE + I_WIN0, NCH = (NITEMS - ITEM0 + 7) / 8;
    LAS int* qsh = (LAS int*)(lds + RING_BYTES);
    for (;;) {
        __syncthreads();
        if (W.tid == 0) qsh[0] = (int)__hip_atomic_fetch_add(qctr, 1u, __ATOMIC_RELAXED, __HIP_MEMORY_SCOPE_AGENT);
        __syncthreads();
        const int q = qsh[0]; if (q >= 136 + NCH) break;
        if (q < 136) lnvec_block(W, lds, in, ws, q);
        else { const int it = ITEM0 + (q - 136) * 8 + W.wave; if (it < NITEMS) weight_item(W, lds, in, ws, it); }
    }
}
#define MFMA32(a, b, c) __builtin_amdgcn_mfma_f32_32x32x16_bf16((a), (b), (c), 0, 0, 0)
__device__ __forceinline__ void attn_phase(const WInfo& W, LAS unsigned char* lds, const bf16* Z, bf16* MIX, const float* sinks, const float* relb, unsigned* qctr) {
    LAS bf16* Ks = (LAS bf16*)lds;
    LAS bf16* Vt = (LAS bf16*)(lds + 36864);
    LAS float* BT = (LAS float*)(lds + 36864 + 33280);
    const int tid = W.tid, lane = W.lane, w = W.wave, r32 = lane & 31, hh = lane >> 5;
    LAS float* BB = (LAS float*)(lds + 36864 + 33280 + 16 * 388 * 4);
    for (int i = tid; i < 1024; i += 512) { const int hq = i >> 7, dist = i & 127; int bucket = dist;
        if (dist >= 16) { const float lr = logf((float)dist / 16.0f) / 2.0794415416798357f; bucket = 16 + (int)(lr * 16.0f); if (bucket > 31) bucket = 31; }
        BB[i] = relb[bucket * 8 + hq] * LOG2E; }
    int last_kvh = -1;
    LAS int* qsh = (LAS int*)(lds + RING_BYTES);
    if (tid == 0) qsh[0] = (int)__hip_atomic_fetch_add(qctr, 1u, __ATOMIC_RELAXED, __HIP_MEMORY_SCOPE_AGENT);
    for (;;) {
        __syncthreads();
        const int u = qsh[0];
        __syncthreads();
        if (u >= 512) break;
        if (tid == 0) qsh[0] = (int)__hip_atomic_fetch_add(qctr, 1u, __ATOMIC_RELAXED, __HIP_MEMORY_SCOPE_AGENT);
        const int b = u >> 6, kvh = (u >> 5) & 1, nb = u & 31;
        if (kvh != last_kvh) { last_kvh = kvh;
            for (int i = tid; i < 16 * 388; i += 512) { const int k = i / (4 * 388), g = (i / 388) & 3, y = i % 388, x = y + k - 128;
                BT[i] = (x >= 1 && x <= 128) ? BB[(kvh * 4 + g) * 128 + (128 - x)] : 0.f; } }
        { const int key = tid >> 1, half = tid & 1, s = nb * 128 - 128 + key;
          v4u kq[4], vq[4];
          if (s >= 0) { const bf16* zr = Z + (size_t)(b * SEQ + s) * NZ;
#pragma unroll
              for (int j = 0; j < 4; ++j) { kq[j] = *(const v4u*)(zr + 512 + kvh * 64 + half * 32 + 8 * j); vq[j] = *(const v4u*)(zr + 640 + kvh * 64 + half * 32 + 8 * j); } }
          else {
#pragma unroll
              for (int j = 0; j < 4; ++j) { kq[j] = (v4u){0u, 0u, 0u, 0u}; vq[j] = (v4u){0u, 0u, 0u, 0u}; } }
#pragma unroll
          for (int j = 0; j < 4; ++j) { *(LAS v4u*)(Ks + key * 72 + half * 32 + 8 * j) = kq[j];
#pragma unroll
              for (int e = 0; e < 4; ++e) { const unsigned wv = vq[j][e]; const int d = half * 32 + 8 * j + 2 * e; Vt[d * 260 + key] = (bf16)(wv & 0xffffu); Vt[(d + 1) * 260 + key] = (bf16)(wv >> 16); } } }
        __syncthreads();
        const int g = w >> 1, rh = w & 1, habs = kvh * 4 + g;
        bf16x8 qf[2][4]; int qi[2]; size_t mq[2];
#pragma unroll
        for (int qt = 0; qt < 2; ++qt) { qi[qt] = 64 * rh + 32 * qt + r32; mq[qt] = (size_t)(b * SEQ + nb * 128 + qi[qt]);
#pragma unroll
            for (int s = 0; s < 4; ++s) qf[qt][s] = *(const bf16x8*)(Z + mq[qt] * NZ + habs * 64 + 16 * s + 8 * hh); }
        const float sinkl = sinks[habs] * LOG2E;
        float mrun[2] = {sinkl, sinkl}, lsum[2] = {hh == 0 ? 1.f : 0.f, hh == 0 ? 1.f : 0.f};
        f32x16 ot[2][2];
#pragma unroll
        for (int a = 0; a < 2; ++a)
#pragma unroll
            for (int c = 0; c < 2; ++c)
#pragma unroll
                for (int i = 0; i < 16; ++i) ot[a][c][i] = 0.f;
        for (int ks = 2 * rh; ks < 2 * rh + 6; ++ks) {
            bool act[2], full[2];
#pragma unroll
            for (int qt = 0; qt < 2; ++qt) { const int q0 = 64 * rh + 32 * qt, q1 = q0 + 31, k0 = 32 * ks, k1 = k0 + 31;
                act[qt] = (k1 - q0 >= 1) && (k0 - q1 <= 128) && (nb > 0 || k1 >= 128);
                full[qt] = (k0 - q1 >= 1) && (k1 - q0 <= 128) && (nb > 0 || k0 >= 128); }
            if (!act[0] && !act[1]) continue;
            f32x16 sc[2];
#pragma unroll
            for (int qt = 0; qt < 2; ++qt)
#pragma unroll
                for (int i = 0; i < 16; ++i) sc[qt][i] = 0.f;
#pragma unroll
            for (int s = 0; s < 4; ++s) { const bf16x8 kf = *(const LAS bf16x8*)(Ks + (32 * ks + r32) * 72 + 16 * s + 8 * hh);
                if (act[0]) sc[0] = MFMA32(kf, qf[0][s], sc[0]); if (act[1]) sc[1] = MFMA32(kf, qf[1][s], sc[1]); }
            bf16x8 pf[2][2];
#pragma unroll
            for (int qt = 0; qt < 2; ++qt) if (act[qt]) {
                float mx = -1e30f;
#pragma unroll
                for (int c = 0; c < 4; ++c) { const int kbase = 32 * ks + 8 * c + 4 * hh, xbase = kbase - qi[qt], X = xbase + 128, kk = X & 3, y = X - kk;
                    const f32x4 b4 = *(const LAS f32x4*)(BT + (kk * 4 + g) * 388 + y);
                    if (full[qt]) {
#pragma unroll
                        for (int j = 0; j < 4; ++j) { const float t = sc[qt][4 * c + j] * (0.125f * LOG2E) + b4[j]; sc[qt][4 * c + j] = t; mx = fmaxf(mx, t); }
                    } else {
#pragma unroll
                        for (int j = 0; j < 4; ++j) { const int x = xbase + j; const bool valid = (x >= 1) && (x <= 128) && (nb > 0 || kbase + j >= 128);
                            const float t = valid ? (sc[qt][4 * c + j] * (0.125f * LOG2E) + b4[j]) : -1e30f; sc[qt][4 * c + j] = t; mx = fmaxf(mx, t); } } }
                mx = fmaxf(mx, __shfl_xor(mx, 32));
                const float mnew = fmaxf(mrun[qt], mx), corr = __builtin_amdgcn_exp2f(mrun[qt] - mnew); mrun[qt] = mnew;
                float ps = 0.f;
#pragma unroll
                for (int i = 0; i < 16; ++i) { const float p = __builtin_amdgcn_exp2f(sc[qt][i] - mnew); sc[qt][i] = p; ps += p; }
                lsum[qt] = lsum[qt] * corr + ps;
#pragma unroll
                for (int dt = 0; dt < 2; ++dt)
#pragma unroll
                    for (int i = 0; i < 16; ++i) ot[dt][qt][i] *= corr;
#pragma unroll
                for (int s2 = 0; s2 < 2; ++s2) { v4u pk;
#pragma unroll
                    for (int e = 0; e < 4; ++e) pk[e] = pk2(sc[qt][8 * s2 + 2 * e], sc[qt][8 * s2 + 2 * e + 1]);
                    pf[qt][s2] = __builtin_bit_cast(bf16x8, pk); } }
#pragma unroll
            for (int dt = 0; dt < 2; ++dt)
#pragma unroll
                for (int s2 = 0; s2 < 2; ++s2) { const int kb0 = 32 * ks + 16 * s2, d = 32 * dt + r32;
                    const s16x4 lo = *(const LAS s16x4*)(Vt + d * 260 + kb0 + 4 * hh), hi = *(const LAS s16x4*)(Vt + d * 260 + kb0 + 8 + 4 * hh);
                    const bf16x8 vf = __builtin_shufflevector(lo, hi, 0, 1, 2, 3, 4, 5, 6, 7);
                    if (act[0]) ot[dt][0] = MFMA32(vf, pf[0][s2], ot[dt][0]); if (act[1]) ot[dt][1] = MFMA32(vf, pf[1][s2], ot[dt][1]); }
        }
#pragma unroll
        for (int qt = 0; qt < 2; ++qt) { const float lt = lsum[qt] + __shfl_xor(lsum[qt], 32), inv = 1.0f / lt;
#pragma unroll
            for (int dt = 0; dt < 2; ++dt)
#pragma unroll
                for (int c = 0; c < 4; ++c) { const int d0 = 32 * dt + 8 * c + 4 * hh; v2u o; o.x = pk2(ot[dt][qt][4 * c] * inv, ot[dt][qt][4 * c + 1] * inv); o.y = pk2(ot[dt][qt][4 * c + 2] * inv, ot[dt][qt][4 * c + 3] * inv);
                    *(v2u*)(MIX + mq[qt] * D_ + habs * 64 + d0) = o; } }
    }
}

__device__ __forceinline__ void aprime_phase(const WInfo& W, const bf16* Z, bf16* AP, const float* mu) {
    const int c = 4 * W.lane;
    const f32x4 m4 = *(const f32x4*)(mu + 1536 + c);
#pragma unroll 4
    for (int m = W.gw; m < T_; m += W.NGW) {
        const v2u zc = *(const v2u*)(Z + (size_t)m * NZ + 2304 + c);
        v2u zp = (v2u){0u, 0u}; if ((m & (SEQ - 1)) != 0) zp = *(const v2u*)(Z + (size_t)(m - 1) * NZ + 2304 + c);
        float z[4] = {bflo(zc.x), bfhi(zc.x), bflo(zc.y), bfhi(zc.y)}, p[4] = {bflo(zp.x), bfhi(zp.x), bflo(zp.y), bfhi(zp.y)}, o[4];
#pragma unroll
        for (int j = 0; j < 4; ++j) { const float v = z[j] + (p[j] - z[j]) * m4[j]; o[j] = c < 64 ? tanhf(v) : (c < 128 ? v : 1.0f / (1.0f + __expf(-v))); }
        v2u w; w.x = pk2(o[0], o[1]); w.y = pk2(o[2], o[3]); *(v2u*)(AP + (size_t)m * 256 + c) = w;
    }
}

constexpr int SL_W = 0, SL_R = 2048, SL_BKT = 4096, SL_ARBK = 8192, SL_M1 = 9216, SL_PC = 9728, SLOT_BYTES = 10240;
static_assert(WS_SLOT + (size_t)64 * 256 * SLOT_BYTES <= WS_B0, "slots end below the activation buffers");
#define MFMA16(a, b, c) __builtin_amdgcn_mfma_f32_16x16x32_bf16((a), (b), (c), 0, 0, 0)
__device__ __forceinline__ bf16x8 mk8(v2u lo, v2u hi) { v4u q; q.x = lo.x; q.y = lo.y; q.z = hi.x; q.w = hi.y; return __builtin_bit_cast(bf16x8, q); }
struct S1In { unsigned short zr[17], zk[17], av[16]; float wl[16]; };
__device__ __forceinline__ void s1_load(S1In& o, int unit, int lane, const bf16* Z, const float* WLOG, const bf16* AB) {
    const int c = 255 - (unit >> 6), bh = unit & 63, h = bh & 7, b = bh >> 3, chn = h * 64 + lane; const size_t m0 = (size_t)b * SEQ + c * 16;
    const bf16* zp = Z + (m0 - (c > 0 ? 1 : 0)) * NZ + 768 + chn; o.zr[0] = zp[0]; o.zk[0] = zp[512];
#pragma unroll
    for (int t = 0; t < 16; ++t) { const bf16* zc = Z + (m0 + t) * NZ + 768 + chn; o.zr[1 + t] = zc[0]; o.zk[1 + t] = zc[512]; o.wl[t] = WLOG[(m0 + t) * 512 + chn]; o.av[t] = AB[(m0 + t) * 512 + chn]; }
}
__device__ __forceinline__ void scan_prep_phase(const WInfo& W, LAS unsigned char* lds, const bf16* Z, const float* WLOG, const bf16* AB, unsigned char* slots, float* bonus,
                                                const float* mu, const float* k_k, const float* k_a, const float* r_k) {
    LAS unsigned char* sc = lds + W.wave * 16384;
    LAS bf16* RT = (LAS bf16*)sc; LAS bf16* AT = (LAS bf16*)(sc + 2304); LAS bf16* BT = (LAS bf16*)(sc + 4608); LAS bf16* KT = (LAS bf16*)(sc + 6912);
    LAS bf16* ATT = (LAS bf16*)(sc + 9216);
    LAS float* AAB = (LAS float*)(sc + 11264);
    LAS bf16* M1x = (LAS bf16*)(sc + 11264);
    LAS bf16* TT = (LAS bf16*)(sc + 12288);
    LAS bf16* WW = (LAS bf16*)(sc + 12800);
    LAS bf16* ARx = (LAS bf16*)(sc + 15104);
    const int lane = W.lane, fr = lane & 15, g = lane >> 4;
    S1In cur, nxt;
    if (W.gw < 64 * 256) s1_load(nxt, W.gw, lane, Z, WLOG, AB);
    for (int unit = W.gw; unit < 64 * 256; unit += W.NGW) {
        const int c = 255 - (unit >> 6), bh = unit & 63, h = bh & 7, b = bh >> 3;
        const int chn = h * 64 + lane; const size_t m0 = (size_t)b * SEQ + c * 16;
        unsigned char* slot = slots + (size_t)(bh * 256 + c) * SLOT_BYTES;
        const float mu_r = mu[chn], mu_k = mu[512 + chn], kkc = k_k[chn], kac = k_a[chn], rkc = r_k[chn];
        cur = nxt;
        if (unit + W.NGW < 64 * 256) s1_load(nxt, unit + W.NGW, lane, Z, WLOG, AB);
        float pr = (c > 0) ? bf2f(cur.zr[0]) : 0.f, pk = (c > 0) ? bf2f(cur.zk[0]) : 0.f;
        float lw = 0.f, Pprev = 1.f, bsave = 0.f, Pt = 1.f;
        unsigned apk[8], bpk[8], kpk[8]; float ah = 0.f, bh2 = 0.f, kh = 0.f;
#pragma unroll
        for (int t = 0; t < 16; ++t) {
            const float zr = bf2f(cur.zr[1 + t]), zk = bf2f(cur.zk[1 + t]); const float wl = cur.wl[t], av = bf2f(cur.av[t]);
            const float r = zr + (pr - zr) * mu_r, kz = zk + (pk - zk) * mu_k; pr = zr; pk = zk;
            float kk = kz * kkc; const float nrm = sqrtf(wave_sum_fast(kk * kk)); kk = kk * __builtin_amdgcn_rcpf(fmaxf(nrm, 1e-12f));
            const float k2 = kz * (1.0f + (av - 1.0f) * kac);
            const float bo = wave_sum_fast(r * k2 * rkc); if (lane == t) bsave = bo;
            lw += wl; Pt = __expf(lw); const float iP = __expf(-lw);
            const float rt = r * Pt, kt = k2 * iP, at = -kk * Pprev, bt = kk * av * iP; Pprev = Pt;
            { const unsigned ra = pk2(rt, at), bk = pk2(bt, kt); RT[t * 72 + lane] = (bf16)(ra & 0xffffu); AT[t * 72 + lane] = (bf16)(ra >> 16); BT[t * 72 + lane] = (bf16)(bk & 0xffffu); KT[t * 72 + lane] = (bf16)(bk >> 16); }
            if (t & 1) { apk[t >> 1] = pk2(ah, at); bpk[t >> 1] = pk2(bh2, bt); kpk[t >> 1] = pk2(kh, kt); } else { ah = at; bh2 = bt; kh = kt; }
        }
        *(LAS v4u*)(ATT + lane * 16) = (v4u){apk[0], apk[1], apk[2], apk[3]}; *(LAS v4u*)(ATT + lane * 16 + 8) = (v4u){apk[4], apk[5], apk[6], apk[7]};
#pragma unroll
        for (int gg = 0; gg < 4; ++gg) *(v4u*)(slot + SL_BKT + ((lane >> 4) * 64 + gg * 16 + (lane & 15)) * 16) = (v4u){bpk[2 * gg], bpk[2 * gg + 1], kpk[2 * gg], kpk[2 * gg + 1]};
        *(float*)(slot + SL_PC + lane * 4) = Pt;
        if (lane < 16) bonus[(m0 + lane) * 8 + h] = bsave;
        LDS_WAIT(); asm volatile("" ::: "memory");
        f32x4 Aab = (f32x4){0.f, 0.f, 0.f, 0.f}, Aak = Aab, Arb = Aab, Ark = Aab;
#pragma unroll
        for (int s = 0; s < 2; ++s) { const int o = fr * 72 + 32 * s + 8 * g;
            const bf16x8 af = *(const LAS bf16x8*)(AT + o), rf = *(const LAS bf16x8*)(RT + o), bb = *(const LAS bf16x8*)(BT + o), kb = *(const LAS bf16x8*)(KT + o);
            Aab = MFMA16(af, bb, Aab); Aak = MFMA16(af, kb, Aak); Arb = MFMA16(rf, bb, Arb); Ark = MFMA16(rf, kb, Ark); }
#pragma unroll
        for (int rg = 0; rg < 4; ++rg) { const int t = 4 * g + rg; const bool lo = fr < t, le = fr <= t;
            Aab[rg] = lo ? Aab[rg] : 0.f; Aak[rg] = lo ? Aak[rg] : 0.f; Arb[rg] = le ? Arb[rg] : 0.f; Ark[rg] = le ? Ark[rg] : 0.f;
            AAB[t * 16 + fr] = Aab[rg]; { const unsigned rk = pk2(Arb[rg], Ark[rg]); ARx[t * 16 + fr] = (bf16)(rk & 0xffffu); ARx[256 + t * 16 + fr] = (bf16)(rk >> 16); } }
        LDS_WAIT(); asm volatile("" ::: "memory");
        float Tc[16];
#pragma unroll
        for (int t = 0; t < 16; ++t) { float acc = (t == fr) ? 1.f : 0.f;
#pragma unroll
            for (int q4 = 0; q4 < (t + 3) / 4; ++q4) { const f32x4 a4 = *(const LAS f32x4*)(AAB + t * 16 + 4 * q4);
#pragma unroll
                for (int e = 0; e < 4; ++e) if (4 * q4 + e < t) acc += a4[e] * Tc[4 * q4 + e]; }
            Tc[t] = acc; }
#pragma unroll
        for (int t = 0; t < 16; t += 2) { const unsigned tt = pk2(Tc[t], Tc[t + 1]); TT[t * 16 + fr] = (bf16)(tt & 0xffffu); TT[(t + 1) * 16 + fr] = (bf16)(tt >> 16); }
        LDS_WAIT(); asm volatile("" ::: "memory");
        const v2u z2 = (v2u){0u, 0u};
        const bf16x8 Tf = mk8(*(const LAS v2u*)(TT + fr * 16 + 4 * g), z2);
        { v2u ak; ak.x = pk2(Aak[0], Aak[1]); ak.y = pk2(Aak[2], Aak[3]);
          const f32x4 M1 = MFMA16(Tf, mk8(ak, z2), ((f32x4){0.f, 0.f, 0.f, 0.f}));
          f32x4 Wt[4];
#pragma unroll
          for (int jt = 0; jt < 4; ++jt) Wt[jt] = MFMA16(Tf, mk8(*(const LAS v2u*)(ATT + (16 * jt + fr) * 16 + 4 * g), z2), ((f32x4){0.f, 0.f, 0.f, 0.f}));
#pragma unroll
          for (int rg = 0; rg < 4; ++rg) { const int t = 4 * g + rg; const unsigned w01 = pk2(Wt[0][rg], Wt[1][rg]), w23 = pk2(Wt[2][rg], Wt[3][rg]), m1 = pk2(M1[rg], 0.f); M1x[t * 16 + fr] = (bf16)(m1 & 0xffffu);
              WW[t * 72 + fr] = (bf16)(w01 & 0xffffu); WW[t * 72 + 16 + fr] = (bf16)(w01 >> 16); WW[t * 72 + 32 + fr] = (bf16)(w23 & 0xffffu); WW[t * 72 + 48 + fr] = (bf16)(w23 >> 16); } }
        LDS_WAIT(); asm volatile("" ::: "memory");
#pragma unroll
        for (int s = 0; s < 2; ++s) { const int o = fr * 72 + 32 * s + 4 * g;
            const v2u w0 = *(const LAS v2u*)(WW + o), w1 = *(const LAS v2u*)(WW + o + 16), r0 = *(const LAS v2u*)(RT + o), r1 = *(const LAS v2u*)(RT + o + 16);
            *(v4u*)(slot + SL_W + (s * 64 + lane) * 16) = (v4u){w0.x, w0.y, w1.x, w1.y}; *(v4u*)(slot + SL_R + (s * 64 + lane) * 16) = (v4u){r0.x, r0.y, r1.x, r1.y}; }
        { const v2u x0 = *(const LAS v2u*)(ARx + fr * 16 + 4 * g), x1 = *(const LAS v2u*)(ARx + 256 + fr * 16 + 4 * g), m1 = *(const LAS v2u*)(M1x + fr * 16 + 4 * g);
          *(v4u*)(slot + SL_ARBK + lane * 16) = (v4u){x0.x, x0.y, x1.x, x1.y}; *(v2u*)(slot + SL_M1 + lane * 8) = m1; }
        LDS_WAIT(); asm volatile("" ::: "memory");
    }
}
__device__ __forceinline__ void glds16(const void* gsrc, unsigned lds_dst) { unsigned keep;
    asm volatile("s_mov_b32 %0, m0\n\ts_mov_b32 m0, %2\n\ts_nop 0\n\tglobal_load_lds_dwordx4 %1, off\n\ts_mov_b32 m0, %0" : "=&s"(keep) : "v"(gsrc), "s"(lds_dst) : "memory"); }
struct ScanOps { bf16x8 Wf[2], Rf[2], Bk[4], ARBK; v2u M1; f32x4 PC[4]; unsigned vz[5]; unsigned pad; };
constexpr int S2_NS = 12, S2_D = 11, S2_VST = 2048;
__device__ __forceinline__ void scan_lds_load(ScanOps& o, const LAS unsigned char* st, const LAS unsigned char* vs, const LAS unsigned char* vprev, int lane, int g, int icol) {
#pragma unroll
    for (int s = 0; s < 2; ++s) { o.Wf[s] = *(const LAS bf16x8*)(st + SL_W + (s * 64 + lane) * 16); o.Rf[s] = *(const LAS bf16x8*)(st + SL_R + (s * 64 + lane) * 16); }
#pragma unroll
    for (int jt = 0; jt < 4; ++jt) { o.Bk[jt] = *(const LAS bf16x8*)(st + SL_BKT + (jt * 64 + lane) * 16); o.PC[jt] = *(const LAS f32x4*)(st + SL_PC + (16 * jt + 4 * g) * 4); }
    o.ARBK = *(const LAS bf16x8*)(st + SL_ARBK + lane * 16); o.M1 = *(const LAS v2u*)(st + SL_M1 + lane * 8);
    o.vz[0] = (unsigned)*(const LAS unsigned short*)((g == 0 ? vprev + 15 * 128 : vs + (4 * g - 1) * 128) + icol * 2);
#pragma unroll
    for (int j = 0; j < 4; ++j) o.vz[1 + j] = (unsigned)*(const LAS unsigned short*)(vs + (4 * g + j) * 128 + icol * 2);
    o.pad = 0u;
}
__device__ __forceinline__ void scan_issue(int cc, int lw, int lane, const unsigned char* sbase, const bf16* zvh, LAS unsigned char* ring, LAS unsigned char* vring) {
    const unsigned char* slot = sbase + (size_t)cc * SLOT_BYTES; LAS unsigned char* st = ring + (cc % S2_NS) * 10240; LAS unsigned char* vs = vring + (cc % S2_NS) * S2_VST;
#pragma unroll
    for (int k = 0; k < 3; ++k) { const int p = lw + 4 * k; if (p < 10) glds16(slot + p * 1024 + lane * 16, (unsigned)(size_t)(st + p * 1024)); }
    if (lw >= 2) { const int blk = lw - 2; const int r = cc * 16 + blk * 8 + (lane >> 3);
        glds16((const unsigned char*)(zvh + (size_t)r * NZ) + (lane & 7) * 16, (unsigned)(size_t)(vs + blk * 1024)); }
}
__device__ __forceinline__ void scan_seq_phase(const WInfo& W, LAS unsigned char* lds, const bf16* Z, const unsigned char* slots, float* YRAW, const float* mu) {
    const int id = blockIdx.x; if (id >= 64) return;
    const int lane = W.lane, fr = lane & 15, g = lane >> 4, w = W.wave;
    const int b = id >> 3, h = id & 7;
    LAS unsigned char* ring = lds; LAS unsigned char* vring = lds + S2_NS * 10240;
    const unsigned char* sbase = slots + (size_t)id * 256 * SLOT_BYTES;
    const bf16* zvh = Z + (size_t)b * SEQ * NZ + 1792 + h * 64;
    const bool loader = w >= 4; const int lw = w - 4;
    const int i = 16 * (w & 3) + fr;
    float mu_v = mu[1024 + h * 64 + i];
    VM_WAIT(); asm volatile("" : "+v"(mu_v));
    float* yb = YRAW + (size_t)b * SEQ * 512 + h * 64 + i;
#define S2_WAIT_AHEAD() asm volatile("s_waitcnt vmcnt(27)" ::: "memory")
    if (loader) { for (int cc = 0; cc < S2_D; ++cc) scan_issue(cc, lw, lane, sbase, zvh, ring, vring); S2_WAIT_AHEAD(); }
    __builtin_amdgcn_s_barrier();
    f32x4 st[4];
#pragma unroll
    for (int jt = 0; jt < 4; ++jt) st[jt] = (f32x4){0.f, 0.f, 0.f, 0.f};
    if (loader) {
        for (int c = 0; c < 256; ++c) {
            if (c + S2_D < 256) { scan_issue(c + S2_D, lw, lane, sbase, zvh, ring, vring); S2_WAIT_AHEAD(); } else asm volatile("s_waitcnt vmcnt(0)" ::: "memory");
            __builtin_amdgcn_s_barrier();
        }
    } else {
        ScanOps opA, opB;
        scan_lds_load(opA, ring, vring, vring, lane, g, i);
        LAS float* ybuf = (LAS float*)(lds + 147456);
        float* yo = YRAW + (size_t)b * SEQ * 512 + h * 64 + (size_t)(4 * w + g) * 512 + 4 * fr;
#define S2_STEP(c, CUR, NXT) do { \
            if ((c) + 1 < 256) scan_lds_load(NXT, ring + (((c) + 1) % S2_NS) * 10240, vring + (((c) + 1) % S2_NS) * S2_VST, vring + ((c) % S2_NS) * S2_VST, lane, g, i); \
            float vm[4]; const float zprev = ((c) == 0 && g == 0) ? 0.f : bf2f((unsigned short)CUR.vz[0]); \
            _Pragma("unroll") for (int j = 0; j < 4; ++j) { const float zc = bf2f((unsigned short)CUR.vz[1 + j]), zp = (j == 0) ? zprev : bf2f((unsigned short)CUR.vz[j]); vm[j] = zc + (zp - zc) * mu_v; } \
            v2u vb; vb.x = pk2(vm[0], vm[1]); vb.y = pk2(vm[2], vm[3]); const v2u z2 = (v2u){0u, 0u}; bf16x8 Sb[2]; \
            _Pragma("unroll") for (int s = 0; s < 2; ++s) { v2u lo, hi; lo.x = pk2(st[2 * s][0], st[2 * s][1]); lo.y = pk2(st[2 * s][2], st[2 * s][3]); hi.x = pk2(st[2 * s + 1][0], st[2 * s + 1][1]); hi.y = pk2(st[2 * s + 1][2], st[2 * s + 1][3]); Sb[s] = mk8(lo, hi); } \
            f32x4 U = MFMA16(CUR.Wf[0], Sb[0], ((f32x4){0.f, 0.f, 0.f, 0.f})); U = MFMA16(CUR.Wf[1], Sb[1], U); U = MFMA16(mk8(CUR.M1, z2), mk8(vb, z2), U); \
            f32x4 Y = MFMA16(CUR.Rf[0], Sb[0], ((f32x4){0.f, 0.f, 0.f, 0.f})); Y = MFMA16(CUR.Rf[1], Sb[1], Y); \
            v2u ub; ub.x = pk2(U[0], U[1]); ub.y = pk2(U[2], U[3]); const bf16x8 UV = mk8(ub, vb); \
            Y = MFMA16(CUR.ARBK, UV, Y); \
            _Pragma("unroll") for (int jt = 0; jt < 4; ++jt) { const f32x4 a = MFMA16(CUR.Bk[jt], UV, st[jt]); st[jt] = a * CUR.PC[jt]; } \
            if ((c) > 0) { const f32x4 yv = *(const LAS f32x4*)(ybuf + (((c) - 1) & 1) * 1024 + (4 * w + g) * 64 + 4 * fr); *(f32x4*)(yo + (size_t)(((c) - 1) * 16) * 512) = yv; } \
            _Pragma("unroll") for (int rg = 0; rg < 4; ++rg) ybuf[((c) & 1) * 1024 + (4 * g + rg) * 64 + i] = Y[rg]; \
            LDS_WAIT(); \
            __builtin_amdgcn_s_barrier(); } while (0)
        for (int c = 0; c < 256; c += 2) { S2_STEP(c, opA, opB); S2_STEP(c + 1, opB, opA); }
#undef S2_STEP
        { const f32x4 yv = *(const LAS f32x4*)(ybuf + 1024 + (4 * w + g) * 64 + 4 * fr); *(f32x4*)(yo + (size_t)(255 * 16) * 512) = yv; }
    }
    VM_WAIT();
    __builtin_amdgcn_s_barrier();
#undef S2_WAIT_AHEAD
}

__device__ __forceinline__ float sum8(float x) { x += dpp_mov<0xB1>(x); x += dpp_mov<0x4E>(x); x += dpp_mov<0x141>(x); return x; }
__device__ __forceinline__ void post_phase(const WInfo& W, const bf16* Z, const bf16* GBUF, const float* YRAW, const float* bonus, bf16* MIX,
                                           const float* mu, const float* gn_g, const float* gn_b) {
    const int lane = W.lane, c0 = 8 * lane, h = lane >> 3;
    float muv[8], gg[8], gb[8];
#pragma unroll
    for (int j = 0; j < 8; ++j) { muv[j] = mu[1024 + c0 + j]; gg[j] = gn_g[c0 + j]; gb[j] = gn_b[c0 + j]; }
#pragma unroll 2
    for (int m = W.gw; m < T_; m += W.NGW) {
        const bool first = (m & (SEQ - 1)) == 0;
        const v4u zc = *(const v4u*)(Z + (size_t)m * NZ + 1792 + c0);
        v4u zp = (v4u){0u, 0u, 0u, 0u}; if (!first) zp = *(const v4u*)(Z + (size_t)(m - 1) * NZ + 1792 + c0);
        const v4u gq = *(const v4u*)(GBUF + (size_t)m * 512 + c0);
        const f32x4 y0 = *(const f32x4*)(YRAW + (size_t)m * 512 + c0), y1 = *(const f32x4*)(YRAW + (size_t)m * 512 + c0 + 4);
        const float bo = bonus[(size_t)m * 8 + h];
        float y[8] = {y0[0], y0[1], y0[2], y0[3], y1[0], y1[1], y1[2], y1[3]};
        float s = 0.f;
#pragma unroll
        for (int j = 0; j < 8; ++j) s += y[j];
        const float mean = sum8(s) * (1.0f / 64.0f); float q = 0.f;
#pragma unroll
        for (int j = 0; j < 8; ++j) { y[j] -= mean; q += y[j] * y[j]; }
        const float rstd = rsqrtf(sum8(q) * (1.0f / 64.0f) + GN_EPS);
        float o[8];
#pragma unroll
        for (int j = 0; j < 8; ++j) { const unsigned zw = zc[j >> 1], pw = zp[j >> 1], gw2 = gq[j >> 1];
            const float zv = (j & 1) ? bfhi(zw) : bflo(zw), pv = (j & 1) ? bfhi(pw) : bflo(pw), gv = (j & 1) ? bfhi(gw2) : bflo(gw2);
            const float v = zv + (pv - zv) * muv[j];
            o[j] = (y[j] * rstd * gg[j] + gb[j] + bo * v) * gv; }
        v4u ov; ov.x = pk2(o[0], o[1]); ov.y = pk2(o[2], o[3]); ov.z = pk2(o[4], o[5]); ov.w = pk2(o[6], o[7]);
        *(v4u*)(MIX + (size_t)m * D_ + 512 + c0) = ov;
    }
}

__device__ __forceinline__ void ln_compute(f32x4 (&v)[4], const f32x4 (&g)[4], const f32x4 (&bb)[4]) {
    float s = 0.f;
#pragma unroll
    for (int j = 0; j < 4; ++j) s += (v[j][0] + v[j][1]) + (v[j][2] + v[j][3]);
    const float mean = wave_sum_fast(s) * (1.f / D_); float s2 = 0.f;
#pragma unroll
    for (int j = 0; j < 4; ++j) { v[j] = v[j] - mean; s2 += (v[j][0] * v[j][0] + v[j][1] * v[j][1]) + (v[j][2] * v[j][2] + v[j][3] * v[j][3]); }
    const float rstd = rsqrtf(wave_sum_fast(s2) * (1.f / D_) + LN_EPS);
#pragma unroll
    for (int j = 0; j < 4; ++j) v[j] = v[j] * rstd * g[j] + bb[j];
}
__device__ __forceinline__ void ln_phase(const WInfo& W, float* X, bf16* XB, const float* gam, const float* bet, const bf16* ADD = nullptr) {
    f32x4 g[4], bb[4];
#pragma unroll
    for (int j = 0; j < 4; ++j) { g[j] = *(const f32x4*)(gam + 4 * W.lane + 256 * j); bb[j] = *(const f32x4*)(bet + 4 * W.lane + 256 * j); }
    for (int m = W.gw; m < T_; m += W.NGW) {
        f32x4* xr = (f32x4*)(X + (size_t)m * D_) + W.lane; f32x4 v[4];
#pragma unroll
        for (int j = 0; j < 4; ++j) v[j] = xr[64 * j];
        if (ADD) { const v2u* ar = (const v2u*)(ADD + (size_t)m * D_) + W.lane;
#pragma unroll
            for (int j = 0; j < 4; ++j) { const v2u a = ar[64 * j]; v[j][0] += bflo(a.x); v[j][1] += bfhi(a.x); v[j][2] += bflo(a.y); v[j][3] += bfhi(a.y); } }
        ln_compute(v, g, bb);
#pragma unroll
        for (int j = 0; j < 4; ++j) xr[64 * j] = v[j];
        if (XB) { v2u* o8 = (v2u*)(XB + (size_t)m * D_) + W.lane;
#pragma unroll
            for (int j = 0; j < 4; ++j) { v2u o; o.x = pk2(v[j][0], v[j][1]); o.y = pk2(v[j][2], v[j][3]); o8[64 * j] = o; } }
    }
}
__device__ __forceinline__ void ln_router_phase(const WInfo& W, LAS unsigned char* lds, float* X, bf16* XB, const float* gam, const float* bet, const float* rw, int* toke, float* tokp, int* wgcnt) {
    LAS float* RW = (LAS float*)lds;
    LAS int* CNT = (LAS int*)(lds + 32768);
    for (int i = W.tid; i < 8192; i += 512) RW[i] = rw[i];
    if (W.tid < 16) CNT[W.tid] = 0;
    __syncthreads();
    f32x4 g[4], bb[4];
#pragma unroll
    for (int j = 0; j < 4; ++j) { g[j] = *(const f32x4*)(gam + 4 * W.lane + 256 * j); bb[j] = *(const f32x4*)(bet + 4 * W.lane + 256 * j); }
    for (int wg = blockIdx.x; wg < 256; wg += W.G) {
        for (int i = 0; i < 16; ++i) {
            const int m = wg * 128 + W.wave * 16 + i;
            f32x4* xr = (f32x4*)(X + (size_t)m * D_) + W.lane; f32x4 v[4];
#pragma unroll
            for (int j = 0; j < 4; ++j) v[j] = xr[64 * j];
            ln_compute(v, g, bb);
#pragma unroll
            for (int j = 0; j < 4; ++j) xr[64 * j] = v[j];
            { unsigned* o4 = (unsigned*)((unsigned char*)XB + (size_t)m * D_) + W.lane;
#pragma unroll
              for (int j = 0; j < 4; ++j) o4[64 * j] = pg8::pk4_fp8(v[j][0], v[j][1], v[j][2], v[j][3]); }
            float lg[8];
#pragma unroll
            for (int e = 0; e < 8; ++e) lg[e] = 0.f;
#pragma unroll
            for (int j = 0; j < 4; ++j)
#pragma unroll
                for (int jj = 0; jj < 4; ++jj) { const int c = 4 * W.lane + 256 * j + jj; const f32x4 r0 = *(const LAS f32x4*)(RW + c * 8), r1 = *(const LAS f32x4*)(RW + c * 8 + 4); const float x = v[j][jj];
                    lg[0] += x * r0[0]; lg[1] += x * r0[1]; lg[2] += x * r0[2]; lg[3] += x * r0[3]; lg[4] += x * r1[0]; lg[5] += x * r1[1]; lg[6] += x * r1[2]; lg[7] += x * r1[3]; }
#pragma unroll
            for (int e = 0; e < 8; ++e) lg[e] = wave_sum_fast(lg[e]);
            int e1 = 0; float v1 = lg[0];
#pragma unroll
            for (int e = 1; e < 8; ++e) if (lg[e] > v1) { v1 = lg[e]; e1 = e; }
            int e2 = -1; float v2 = -3.0e38f;
#pragma unroll
            for (int e = 0; e < 8; ++e) if (e != e1 && lg[e] > v2) { v2 = lg[e]; e2 = e; }
            const float p2 = 1.0f / (1.0f + __expf(v1 - v2)), p1 = 1.0f - p2;
            if (W.lane == 0) { toke[m] = e1 | (e2 << 8); tokp[2 * m] = p1; tokp[2 * m + 1] = p2; atomicAdd((int*)(CNT + e1), 1); atomicAdd((int*)(CNT + 8 + e2), 1); }
        }
        __syncthreads();
        if (W.tid < 16) { wgcnt[wg * 16 + W.tid] = CNT[W.tid]; CNT[W.tid] = 0; }
        __syncthreads();
    }
}
__device__ __forceinline__ void route_phase(const WInfo& W, LAS unsigned char* lds, const int* toke, const int* wgcnt, int* perm, int* ptab) {
    LAS int* C = (LAS int*)lds;
    LAS int* TOT = (LAS int*)(lds + 16384);
    LAS int* PRE = TOT + 16;
    LAS int* OFF = TOT + 32;
    LAS int* CTR = TOT + 48;
    for (int wg = blockIdx.x; wg < 256; wg += W.G) {
        __syncthreads();
        for (int i = W.tid; i < 4096; i += 512) C[i] = wgcnt[i];
        if (W.tid < 16) CTR[W.tid] = 0;
        __syncthreads();
        if (W.tid < 16) { int tot = 0, pre = 0; for (int k = 0; k < 256; ++k) { const int c = C[k * 16 + W.tid]; tot += c; if (k < wg) pre += c; } TOT[W.tid] = tot; PRE[W.tid] = pre; }
        __syncthreads();
        if (W.tid == 0) { int cnt = 0, npass[2];
            for (int p = 0; p < 2; ++p) { int base = 0, np = 0;
                for (int e = 0; e < 8; ++e) { OFF[p * 8 + e] = p * PERMLEN + base + PRE[p * 8 + e]; const int pn = (TOT[p * 8 + e] + 255) >> 8;
                    if (wg == 0) for (int k = 0; k < pn; ++k) ptab[2 + cnt + k] = ((p * MAXPANEL + np + k) << 8) | e;
                    cnt += pn; np += pn; base += pn * 256; }
                npass[p] = np; }
            if (wg == 0) { ptab[0] = npass[0]; ptab[1] = npass[1]; } }
        __syncthreads();
        if (W.tid < 128) { const int m = wg * 128 + W.tid, te = toke[m], e1 = te & 255, e2 = te >> 8;
            const int s1 = OFF[e1] + atomicAdd((int*)(CTR + e1), 1); perm[s1] = m;
            const int s2 = OFF[8 + e2] + atomicAdd((int*)(CTR + 8 + e2), 1); perm[s2] = m; }
    }
}
__device__ __forceinline__ void conv_phase(const WInfo& W, const bf16* GB, const bf16* UP, bf16* CV, const float* cw) {
    const size_t gtid = (size_t)W.gw * 64 + W.lane, NT = (size_t)W.NGW * 64;
#pragma unroll 4
    for (size_t i = gtid; i < (size_t)T_ * D_ / 8; i += NT) {
        const int m = (int)(i >> 7), c = (int)(i & 127) * 8, t = m & (SEQ - 1);
        const v4u gv = *(const v4u*)(GB + (size_t)m * D_ + c), u2 = *(const v4u*)(UP + (size_t)m * D_ + c);
        v4u u1 = (v4u){0u, 0u, 0u, 0u}, u0 = (v4u){0u, 0u, 0u, 0u};
        if (t >= 1) u1 = *(const v4u*)(UP + (size_t)(m - 1) * D_ + c);
        if (t >= 2) u0 = *(const v4u*)(UP + (size_t)(m - 2) * D_ + c);
        float o[8];
#pragma unroll
        for (int e = 0; e < 4; ++e) {
            const f32x2 w0 = *(const f32x2*)(cw + c + 2 * e), w1 = *(const f32x2*)(cw + 1024 + c + 2 * e), w2 = *(const f32x2*)(cw + 2048 + c + 2 * e);
            o[2 * e] = bflo(gv[e]) * (bflo(u0[e]) * w0[0] + bflo(u1[e]) * w1[0] + bflo(u2[e]) * w2[0]);
            o[2 * e + 1] = bfhi(gv[e]) * (bfhi(u0[e]) * w0[1] + bfhi(u1[e]) * w1[1] + bfhi(u2[e]) * w2[1]); }
        v4u ov; ov.x = pk2(o[0], o[1]); ov.y = pk2(o[2], o[3]); ov.z = pk2(o[4], o[5]); ov.w = pk2(o[6], o[7]);
        *(v4u*)(CV + (size_t)m * D_ + c) = ov;
    }
}

constexpr int NPHASE = 18;
#ifndef PH_STOP
#define PH_STOP NPHASE
#endif
struct Args { const float* in[34]; float* out; unsigned char* ws; int ph_lo, ph_hi; };
__global__ void __launch_bounds__(512, 2) mk_fwd(Args args) {
    extern __shared__ __attribute__((aligned(16))) unsigned char lds_raw[];
    LAS unsigned char* lds = (LAS unsigned char*)lds_raw;
    WInfo W; W.tid = threadIdx.x; W.lane = W.tid & 63; W.wave = __builtin_amdgcn_readfirstlane(W.tid >> 6);
    W.G = gridDim.x; { const int bx = blockIdx.x; W.vcu = (W.G % 8 == 0) ? (bx % 8) * (W.G / 8) + bx / 8 : bx; }
    W.gw = W.vcu * 8 + W.wave; W.NGW = W.G * 8;
    unsigned char* ws = args.ws; float* out = args.out; const float* const* in = args.in;
    unsigned* ctl = (unsigned*)(ws + WS_CTL);
    volatile LAS unsigned* MISC = (volatile LAS unsigned*)(lds + MISC_OFF);
    for (int u = W.tid; u < 128; u += 512) ((LAS unsigned*)(lds + LDSCTL_OFF))[u] = 0u;
    __syncthreads();
    XcdBarrier bar; bar.bar = ctl + CW_BAR; bar.x = 0; bar.st = nullptr;
    if (MK_N_LAUNCHES == 1) bar = xcd_barrier_post(ctl + CW_BAR, MISC + 8);
    const int lo = args.ph_lo, hi = args.ph_hi;
#ifndef PH_MASK
#define PH_MASK 0x3ffff
#endif
#define IN(k) (((PH_MASK >> (k)) & 1) && lo <= (k) && (k) < hi)
#define SEAM(k) do { if (IN(k) && IN((k) + 1)) xcd_barrier(bar); } while (0)
    bf16* const B0 = (bf16*)(ws + WS_B0); bf16* const Zb = (bf16*)(ws + WS_B1); bf16* const ACT = (bf16*)(ws + WS_ACT); bf16* const CV = (bf16*)(ws + WS_CV);
    bf16* const AP = (bf16*)(ws + WS_AP); float* const YRAW = (float*)(ws + WS_YRAW); bf16* const ACTM = (bf16*)(ws + WS_ACTM);
    float* const WLOG = out; bf16* const ABUF = (bf16*)(out + (size_t)T_ * 512); bf16* const GBUF = ABUF + (size_t)T_ * 512;
    int* const toke = (int*)(ws + WS_TOKE); float* const tokp = (float*)(ws + WS_TOKP); int* const wgcnt = (int*)(ws + WS_WGCNT); int* const ptabg = (int*)(ws + WS_PTAB); int* const perm = (int*)(ws + WS_PERM);
    const int cblk = (int)blockIdx.x;

#ifdef DUMP_OFF
    if (lo == 100) { const bf16* s = (const bf16*)(ws + (size_t)(DUMP_OFF) * MiB);
        for (size_t i = (size_t)W.gw * 64 + W.lane; i < (size_t)T_ * D_; i += (size_t)W.NGW * 64) { const size_t m = i >> 10, c = i & 1023; out[i] = (c < DUMP_W) ? bf2f(s[m * DUMP_LD + DUMP_COL + c]) : 0.f; } return; }
#endif
    if (IN(0)) { p0_prologue(W, lds, in, ws); } SEAM(0);
    if (IN(1)) { pg8::DenseSched S{T_ / 256, NZ / 256, W.G, cblk, 1024, (const bf16*)(ws + WS_WIN0)}; pg8::EpiBf16 E{Zb, NZ}; pg8::gemm_phase(lds, B0, 1024, S, E); } SEAM(1);
    if (IN(2)) { aprime_phase(W, Zb, AP, in[4]); } SEAM(2);
    if (IN(3)) { const int KL = 256 + (hi >> 20); pg8::DenseSched S{T_ / 256, 6, W.G, cblk, KL, (const bf16*)(ws + WS_WLORA)}; pg8::EpiLora E{WLOG, ABUF, GBUF, in[5], in[7]}; pg8::gemm_phase(lds, AP, KL, S, E); } SEAM(3);
    if (IN(4)) { scan_prep_phase(W, lds, Zb, WLOG, ABUF, ws + WS_SLOT, (float*)(ws + WS_BONUS), in[4], in[10], in[11], in[12]); } SEAM(4);
    if (IN(5)) { if (blockIdx.x < 64) scan_seq_phase(W, lds, Zb, ws + WS_SLOT, YRAW, in[4]); attn_phase(W, lds, Zb, B0, in[3], in[1], ctl + 2048); deferred_work(W, lds, in, ws, ctl + 2112); } SEAM(5);
    if (IN(6)) { post_phase(W, Zb, GBUF, YRAW, (const float*)(ws + WS_BONUS), B0, in[4], in[13], in[14]); p0_weights(W, lds, in, ws, 0, NITEMS_MOE); } SEAM(6);
    float* const STP1 = (float*)(ws + WS_STP1); float* const STP2 = (float*)(ws + WS_STP2); const float* const SV = (const float*)(ws + WS_LNV); const float* const CVv = SV + 8704;
    LAS float* const PST = (LAS float*)(lds + PST_OFF); LAS float* const TBL = (LAS float*)(lds + STAT_OFF);
#define STAT_TABLE(S, stp) do { __syncthreads(); if (W.tid < 256) { f32x4 _a[11], _b[11]; int _n = 0; \
        _Pragma("unroll") for (int i = 0; i < 11; ++i) { pg8::Unit uu; if ((S).next(i, uu)) { _n = i + 1; const float* _p = (stp) + (size_t)(uu.pm * 256 + W.tid) * 8; _a[i] = *(const f32x4*)_p; _b[i] = *(const f32x4*)(_p + 4); } else { _a[i] = (f32x4){0.f, 0.f, 0.f, 0.f}; _b[i] = _a[i]; } } \
        _Pragma("unroll") for (int i = 0; i < 11; ++i) if (i < _n) { const float s = ((_a[i][0] + _a[i][2]) + _b[i][0]) + _b[i][2], q = ((_a[i][1] + _a[i][3]) + _b[i][1]) + _b[i][3]; const float mu = s * (1.0f / 1024.0f); \
            TBL[(i * 256 + W.tid) * 2] = mu; TBL[(i * 256 + W.tid) * 2 + 1] = rsqrtf(fmaxf(q * (1.0f / 1024.0f) - mu * mu, 0.f) + LN_EPS); } } __syncthreads(); } while (0)
    if (IN(7)) { pg8::DenseSched S{T_ / 256, 4, W.G, cblk, 1024, (const bf16*)(ws + WS_WOUT0)}; pg8::EpiResStats E{in[0], out, Zb, STP1, PST, TBL, nullptr, nullptr, nullptr}; pg8::gemm_phase(lds, B0, 1024, S, E); } SEAM(7);
    if (IN(8)) { pg8::DenseSched S{T_ / 256, 22, W.G, cblk, 1024, (const bf16*)(ws + WS_WFGU)}; STAT_TABLE(S, STP1); pg8::EpiSwigluLN E{ACT, FF, TBL, SV, CVv}; pg8::gemm_phase(lds, Zb, 1024, S, E); } SEAM(8);
    if (IN(9)) { pg8::DenseSched S{T_ / 256, 4, W.G, cblk, FF, (const bf16*)(ws + WS_WFD)}; STAT_TABLE(S, STP1); pg8::EpiResStats E{out, out, B0, STP2, PST, TBL, STP1, in[16], in[17]}; pg8::gemm_phase(lds, ACT, FF, S, E); } SEAM(9);
    if (IN(10)) { pg8::DenseSched S{T_ / 256, 12, W.G, cblk, 1024, (const bf16*)(ws + WS_WIN1)}; STAT_TABLE(S, STP2); pg8::EpiL1inLN E{Zb, ACT, TBL, SV + 5632, CVv + 5632}; pg8::gemm_phase(lds, B0, 1024, S, E); } SEAM(10);
    if (IN(11)) { conv_phase(W, Zb, ACT, CV, in[24]); } SEAM(11);
    if (IN(12)) { pg8::DenseSched S{T_ / 256, 4, W.G, cblk, 1024, (const bf16*)(ws + WS_WOUT1)}; STAT_TABLE(S, STP2); pg8::EpiResStats E{out, out, nullptr, nullptr, PST, TBL, STP2, in[21], in[22]}; pg8::gemm_phase(lds, CV, 1024, S, E); } SEAM(12);
    if (IN(13)) { ln_router_phase(W, lds, out, B0, in[26], in[27], in[28], toke, tokp, wgcnt); } SEAM(13);
    if (IN(14)) { route_phase(W, lds, toke, wgcnt, perm, ptabg); } SEAM(14);
#define MOE_TABLES() do { LAS int* ptl = (LAS int*)(lds + PTAB_OFF); __syncthreads(); if (W.tid < 280) ptl[W.tid] = ptabg[W.tid]; __syncthreads(); } while (0)
    if (IN(15)) { MOE_TABLES(); LAS int* ptl = (LAS int*)(lds + PTAB_OFF); LAS unsigned short* rtl = (LAS unsigned short*)(lds + RTAB_OFF);
        pg8::MoeUpSched S{ptl[0] + ptl[1], W.G, cblk, ws + WS_WMGU, ptl, rtl};
        for (int i = 0; i < 32; ++i) { pg8::Unit uu; if (!S.next(i, uu)) break; if (W.tid < 256) { const int r = perm[uu.pm * 256 + W.tid]; rtl[i * 256 + W.tid] = (unsigned short)(r < 0 ? 0 : r); } }
        __syncthreads(); pg8::EpiSwiglu8 E{(unsigned char*)ACTM, FFE}; pg8::gemm_phase<pg8::EpiSwiglu8, pg8::MoeUpSched, true>(lds, B0, 512 + (hi >> 20), S, E); } SEAM(15);
    if (IN(16)) { MOE_TABLES(); LAS int* ptl = (LAS int*)(lds + PTAB_OFF);
        pg8::MoeDownSched S{ptl[0] + ptl[1], 0, W.G, cblk, ws + WS_WMD, ptl}; pg8::EpiMoeDown E{out, (bf16*)(ws + WS_Y2), perm, tokp}; pg8::gemm_phase<pg8::EpiMoeDown, pg8::MoeDownSched, true>(lds, ACTM, FFE / 2 + (hi >> 20), S, E); } SEAM(16);
    if (IN(17)) { ln_phase(W, out, nullptr, in[32], in[33], (const bf16*)(ws + WS_Y2)); }
#undef IN
#undef SEAM
}

extern "C" void kernel_launch(void* const* d_in, const int* in_sizes, int n_in, void* d_out, int out_size, void* d_ws, size_t ws_size, hipStream_t stream) {
    static int grid = 0;
    if (grid == 0) {
        if (n_in != 34 || out_size != T_ * D_ || ws_size < WS_END) { fprintf(stderr, "kernel_launch: unexpected problem (n_in %d, out %d, ws %zu)\n", n_in, out_size, ws_size); grid = -1; return; }
        int dev = 0, cus = 0, per_cu = 0;
        if (hipGetDevice(&dev) != hipSuccess || hipDeviceGetAttribute(&cus, hipDeviceAttributeMultiprocessorCount, dev) != hipSuccess) { grid = -1; return; }
        if (hipFuncSetAttribute((const void*)mk_fwd, hipFuncAttributeMaxDynamicSharedMemorySize, LDS_BYTES) != hipSuccess) { fprintf(stderr, "kernel_launch: hipFuncSetAttribute failed\n"); grid = -1; return; }
        if (hipOccupancyMaxActiveBlocksPerMultiprocessor(&per_cu, (const void*)mk_fwd, 512, LDS_BYTES) != hipSuccess || per_cu < 1) fprintf(stderr, "kernel_launch: occupancy query reports %d\n", per_cu);
        (void)hipGetLastError();
        grid = cus;
        if (grid != 256) { fprintf(stderr, "kernel_launch: built for 256 CUs, got %d\n", grid); grid = -1; return; }
    }
    if (grid < 0) return;
    (void)hipMemsetAsync((char*)d_ws + WS_CTL, 0, CTL_ZERO_BYTES, stream);
    Args a{};
    for (int i = 0; i < 34; ++i) a.in[i] = (const float*)d_in[i];
    a.out = (float*)d_out; a.ws = (unsigned char*)d_ws;
    if (MK_N_LAUNCHES == 1) { a.ph_lo = 0; a.ph_hi = NPHASE; hipLaunchKernelGGL(mk_fwd, dim3(grid), dim3(512), LDS_BYTES, stream, a); }
    else { for (int p = 0; p < PH_STOP; ++p) { a.ph_lo = p; a.ph_hi = p + 1; hipLaunchKernelGGL(mk_fwd, dim3(grid), dim3(512), LDS_BYTES, stream, a);
#ifdef DUP_PHASE
            if (p == DUP_PHASE) for (int r = 0; r < DUP_N; ++r) hipLaunchKernelGGL(mk_fwd, dim3(grid), dim3(512), LDS_BYTES, stream, a);
#endif
        }
#ifdef DUMP_OFF
        a.ph_lo = 100; a.ph_hi = 101; hipLaunchKernelGGL(mk_fwd, dim3(grid), dim3(512), LDS_BYTES, stream, a);
#endif
    }
}
```

```cpp
#include <hip/hip_runtime.h>
#include <stdio.h>

#ifndef MK_N_LAUNCHES
#define MK_N_LAUNCHES 1
#endif

#define GAS __attribute__((address_space(1)))
#define LAS __attribute__((address_space(3)))
typedef unsigned short bf16;
typedef unsigned v4u __attribute__((ext_vector_type(4)));
typedef unsigned v2u __attribute__((ext_vector_type(2)));
typedef float f32x2 __attribute__((ext_vector_type(2)));
typedef float f32x4 __attribute__((ext_vector_type(4)));
typedef float f32x16 __attribute__((ext_vector_type(16)));
typedef short bf16x8 __attribute__((ext_vector_type(8)));
typedef short s16x4 __attribute__((ext_vector_type(4)));
#define LDS_WAIT() asm volatile("s_waitcnt lgkmcnt(0)" ::: "memory")
#define VM_WAIT() asm volatile("s_waitcnt vmcnt(0)" ::: "memory")

constexpr int T_ = 32768, D_ = 1024, SEQ = 4096, NZ = 2560, FF = 2816, FFE = 3584, NEXP = 8;
constexpr int MAXPANEL = 136, PERMLEN = MAXPANEL * 256;
constexpr float ALPHA = 1.41421356237309515f, LN_EPS = 1e-5f, GN_EPS = 64e-5f, LOG2E = 1.44269504088896341f;

constexpr size_t MiB = 1u << 20;
constexpr size_t WS_CTL = 0, CTL_ZERO_BYTES = 1 * MiB;
constexpr size_t WS_TOKE = 1 * MiB, WS_TOKP = 1 * MiB + 128 * 1024, WS_WGCNT = 1 * MiB + 384 * 1024, WS_PTAB = WS_WGCNT + 16 * 1024, WS_PERM = 1 * MiB + 512 * 1024;
constexpr size_t WS_WIN0 = 2 * MiB, WS_WLORA = 7 * MiB, WS_WOUT0 = 8 * MiB, WS_WFGU = 10 * MiB, WS_WFD = 21 * MiB, WS_WIN1 = 27 * MiB, WS_WOUT1 = 33 * MiB, WS_WMGU = 35 * MiB, WS_WMD = 91 * MiB;
constexpr size_t WS_Y2 = 119 * MiB;
constexpr size_t WS_STP1 = 197 * MiB, WS_STP2 = 198 * MiB, WS_LNV = 196 * MiB;
constexpr size_t WS_B0 = 204 * MiB;
constexpr size_t WS_B1 = 268 * MiB;
constexpr size_t WS_ACT = 332 * MiB;
constexpr size_t WS_CV = 396 * MiB;
constexpr size_t WS_AP = 428 * MiB;
constexpr size_t WS_YRAW = 444 * MiB;
constexpr size_t WS_ACTM = 268 * MiB;
constexpr size_t WS_BONUS = 508 * MiB;
constexpr size_t WS_SLOT = 35 * MiB;
constexpr size_t WS_END = 510 * MiB;
static_assert(WS_ACTM + (size_t)2 * PERMLEN * FFE <= WS_END, "ACTM");
static_assert(WS_ACT + (size_t)T_ * FF * 2 <= WS_END, "ACT");
constexpr int CW_TMO = 0, CW_CODE = 1, CW_BAR = 4096;

constexpr int RING_BYTES = 131072, LDSCTL_OFF = 163328, MISC_OFF = LDSCTL_OFF, PTAB_OFF = RING_BYTES, RTAB_OFF = RING_BYTES + 2048;
constexpr int LDS_BYTES = 163840, STAT_OFF = RTAB_OFF, PST_OFF = RTAB_OFF + 8192;

namespace pg8 {
#define PG8_LAS __attribute__((address_space(3)))
typedef unsigned short bf16_t;
constexpr int BM = 256, BK = 64, HALF = 128, HTB = HALF * BK * 2, STAGE_BYTES = 8 * HTB, NXCD = 8, WGM = 8;
__host__ __device__ __forceinline__ int lds_byte(int r, int c) { const int st = (r >> 4) * 2 + (c >> 5), rr = r & 15, cc = c & 31, ob = rr * 64 + cc * 2; return st * 1024 + (ob ^ (((ob >> 9) & 1) << 5)); }
__host__ __device__ __forceinline__ void stage_rc(int b, int& R, int& C) { const int st = b / 1024, sb = b % 1024, swz = sb ^ (((sb >> 9) & 1) << 5); R = (st >> 1) * 16 + swz / 64; C = (st & 1) * 32 + (swz % 64) / 2; }
__host__ __device__ __forceinline__ int perm32(int rho) { const int n = rho >> 4, i = rho & 15; return 8 * (i >> 2) + 4 * n + (i & 3); }
struct Unit { int pm, pn, e, ui; };
__device__ __forceinline__ bool tile_order(int i, int G, int c, int nM, int nN, int& pm, int& pn) {
    const int nwg = nM * nN; const long L = (long)i * G + c; if (L >= nwg) return false;
    int wgid = (int)L; { const int q = nwg / NXCD, r = nwg % NXCD, xcd = wgid % NXCD, off = wgid / NXCD; wgid = (xcd < r ? xcd * (q + 1) : r * (q + 1) + (xcd - r) * q) + off; }
    const int nig = WGM * nN, gid = wgid / nig, fm = gid * WGM, gsz = (nM - fm) < WGM ? (nM - fm) : WGM;
    pm = fm + ((wgid % nig) % gsz); pn = (wgid % nig) / gsz; return true;
}
typedef __bf16 bf16x2_t __attribute__((ext_vector_type(2)));
__device__ __forceinline__ unsigned cvt_pk_bf16(float lo, float hi) { const f32x2 v = {lo, hi}; const bf16x2_t b = __builtin_convertvector(v, bf16x2_t); return __builtin_bit_cast(unsigned, b); }

typedef int i32x8 __attribute__((ext_vector_type(8)));
__device__ __forceinline__ i32x8 cat8(bf16x8 lo, bf16x8 hi) { const v4u a = __builtin_bit_cast(v4u, lo), b = __builtin_bit_cast(v4u, hi); return (i32x8){(int)a.x, (int)a.y, (int)a.z, (int)a.w, (int)b.x, (int)b.y, (int)b.z, (int)b.w}; }
template <class Epi, class Sched, bool F8 = false>
__device__ __forceinline__ void gemm_phase(PG8_LAS unsigned char* lds, const bf16_t* Abase, const int K, const Sched& S, const Epi& E) {
    const int tid = threadIdx.x, wid = __builtin_amdgcn_readfirstlane(tid >> 6), lane = tid & 63, wr = wid >> 2, wc = wid & 3, fr = lane & 15, fq = lane >> 4;
    const int nt = K / BK;
    int Rr[2], Cc[2]; unsigned voffB[2];
#pragma unroll
    for (int i = 0; i < 2; ++i) { stage_rc(tid * 16 + i * 8192, Rr[i], Cc[i]); const int Rb = Epi::PERM ? ((Rr[i] & ~31) + perm32(Rr[i] & 31)) : Rr[i]; voffB[i] = (unsigned)(Rb * K + Cc[i]) * 2u; }
    const size_t kstep = (size_t)(BK * 2);
    const size_t hstep = (size_t)HALF * K * 2;
    const unsigned ldsw = (unsigned)wid * 1024u;
    const int aoff = lds_byte(wr * 64 + fr, fq * 8), boff = lds_byte(wc * 32 + fr, fq * 8);
#define PG8_SA(b, h) (((b) * 2 + (h)) * HTB)
#define PG8_SB(b, h) ((4 + (b) * 2 + (h)) * HTB)
#define PG8_STAGE(bufoff, gbase, voff) do { _Pragma("unroll") for (int _i = 0; _i < 2; ++_i) \
        __builtin_amdgcn_global_load_lds((const unsigned*)((const char*)(gbase) + (voff)[_i]), (PG8_LAS unsigned*)(lds + (bufoff) + ldsw + _i * 8192), 16, 0, 0); } while (0)
#define PG8_LDA(dst, b, h) do { _Pragma("unroll") for (int m = 0; m < 4; ++m) _Pragma("unroll") for (int k = 0; k < 2; ++k) { if constexpr (F8) { const v4u _q = *(const PG8_LAS v4u*)(lds + PG8_SA(b, h) + aoff + m * 2048 + k * 1024); \
        dst##8[m][4 * k] = (int)_q.x; dst##8[m][4 * k + 1] = (int)_q.y; dst##8[m][4 * k + 2] = (int)_q.z; dst##8[m][4 * k + 3] = (int)_q.w; } else dst[m][k] = *(const PG8_LAS bf16x8*)(lds + PG8_SA(b, h) + aoff + m * 2048 + k * 1024); } } while (0)
#define PG8_LDB(dst, b, h) do { _Pragma("unroll") for (int n = 0; n < 2; ++n) _Pragma("unroll") for (int k = 0; k < 2; ++k) { if constexpr (F8) { const v4u _q = *(const PG8_LAS v4u*)(lds + PG8_SB(b, h) + boff + n * 2048 + k * 1024); \
        dst##8[n][4 * k] = (int)_q.x; dst##8[n][4 * k + 1] = (int)_q.y; dst##8[n][4 * k + 2] = (int)_q.z; dst##8[n][4 * k + 3] = (int)_q.w; } else dst[n][k] = *(const PG8_LAS bf16x8*)(lds + PG8_SB(b, h) + boff + n * 2048 + k * 1024); } } while (0)
#define PG8_MMA(ai, bj, At, Bt) do { __builtin_amdgcn_s_setprio(1); if constexpr (F8) { _Pragma("unroll") for (int m = 0; m < 4; ++m) _Pragma("unroll") for (int n = 0; n < 2; ++n) \
        asm volatile("v_mfma_scale_f32_16x16x128_f8f6f4 %0, %1, %2, %0, %3, %4 op_sel_hi:[0,0,0]" : "+v"(acc[ai][bj][m][n]) : "v"(Bt##8[n]), "v"(At##8[m]), "v"(scl_w), "v"(scl_a)); } else { \
        _Pragma("unroll") for (int m = 0; m < 4; ++m) _Pragma("unroll") for (int n = 0; n < 2; ++n) _Pragma("unroll") for (int k = 0; k < 2; ++k) \
        acc[ai][bj][m][n] = __builtin_amdgcn_mfma_f32_16x16x32_bf16(Bt[n][k], At[m][k], acc[ai][bj][m][n], 0, 0, 0); } __builtin_amdgcn_s_setprio(0); } while (0)
#define PG8_WAIT_V(n) asm volatile("s_waitcnt vmcnt(" #n ")" ::: "memory")
#define PG8_WAIT_L(n) asm volatile("s_waitcnt lgkmcnt(" #n ")" ::: "memory")
#define PG8_BAR __builtin_amdgcn_s_barrier()
#define PG8_SCHED __builtin_amdgcn_sched_barrier(0)
#define PG8_AOFF(dst, u) do { _Pragma("unroll") for (int _h = 0; _h < 2; ++_h) _Pragma("unroll") for (int _i = 0; _i < 2; ++_i) dst[_h][_i] = S.a_off(u, _h * HALF + Rr[_i]) + (unsigned)Cc[_i] * 2u; } while (0)
    Unit cur, nxt; int ui = 0;
    if (!S.next(0, cur)) return;
    f32x4 acc[2][2][4][2];
#pragma unroll
    for (int a = 0; a < 2; ++a)
#pragma unroll
        for (int b = 0; b < 2; ++b)
#pragma unroll
            for (int m = 0; m < 4; ++m)
#pragma unroll
                for (int n = 0; n < 2; ++n) acc[a][b][m][n] = (f32x4){0.f, 0.f, 0.f, 0.f};
    bf16x8 At[4][2], B0[2][2], B1[2][2]; i32x8 At8[4], B08[2], B18[2];
    int scl_w = 0x7f7f7f7f, scl_a = 0x7f7f7f7f; if constexpr (F8) { scl_w = (int)Epi::SCALE_W; asm volatile("" : "+v"(scl_w), "+v"(scl_a)); }
    unsigned curA[2][2], nxtA[2][2];
    PG8_AOFF(curA, cur);
    const char* const A0 = (const char*)Abase;
    const char* cB = S.b_ptr(cur);
    PG8_STAGE(PG8_SB(0, 0), cB, voffB); PG8_STAGE(PG8_SB(0, 1), cB + hstep, voffB); PG8_STAGE(PG8_SA(0, 0), A0, curA[0]); PG8_STAGE(PG8_SA(0, 1), A0, curA[1]);
    if (wr == 1) PG8_BAR;
    PG8_WAIT_V(2); PG8_BAR;
    PG8_STAGE(PG8_SB(1, 0), cB + kstep, voffB); PG8_STAGE(PG8_SA(1, 0), A0 + kstep, curA[0]); PG8_STAGE(PG8_SB(1, 1), cB + hstep + kstep, voffB);
    PG8_WAIT_V(6); PG8_BAR;
    for (;;) {
        const bool has_next = S.next(ui + 1, nxt);
        const char* nB = has_next ? S.b_ptr(nxt) : cB;
        if (has_next) { PG8_AOFF(nxtA, nxt); } else {
#pragma unroll
            for (int h = 0; h < 2; ++h)
#pragma unroll
                for (int i = 0; i < 2; ++i) nxtA[h][i] = curA[h][i]; }
        for (int t = 0; t < nt; t += 2) {
            const bool last = (t == nt - 2);
            const char* a1 = A0 + (size_t)(t + 1) * kstep;
            const char* a2 = last ? A0 : A0 + (size_t)(t + 2) * kstep; const char* b2 = last ? nB : cB + (size_t)(t + 2) * kstep;
            const char* a3 = a2 + kstep; const char* b3 = b2 + kstep;
            unsigned o2[2][2];
#pragma unroll
            for (int h = 0; h < 2; ++h)
#pragma unroll
                for (int i = 0; i < 2; ++i) o2[h][i] = last ? nxtA[h][i] : curA[h][i];
            PG8_LDB(B0, 0, 0); PG8_LDB(B1, 0, 1); PG8_SCHED; PG8_LDA(At, 0, 0); PG8_STAGE(PG8_SA(1, 1), a1, curA[1]);
            PG8_WAIT_V(8); PG8_WAIT_L(0); PG8_BAR; PG8_MMA(0, 0, At, B0); PG8_MMA(0, 1, At, B1); PG8_BAR; PG8_SCHED;
            PG8_LDA(At, 0, 1); PG8_STAGE(PG8_SB(0, 0), b2, voffB); PG8_STAGE(PG8_SB(0, 1), b2 + hstep, voffB); PG8_STAGE(PG8_SA(0, 0), a2, o2[0]);
            PG8_WAIT_V(8); PG8_WAIT_L(0); PG8_BAR; PG8_MMA(1, 0, At, B0); PG8_MMA(1, 1, At, B1); PG8_BAR; PG8_SCHED;
            PG8_LDB(B0, 1, 0); PG8_LDB(B1, 1, 1); PG8_SCHED; PG8_LDA(At, 1, 0); PG8_STAGE(PG8_SA(0, 1), a2, o2[1]);
            PG8_WAIT_V(8); PG8_WAIT_L(0); PG8_BAR; PG8_MMA(0, 0, At, B0); PG8_MMA(0, 1, At, B1); PG8_BAR; PG8_SCHED;
            PG8_LDA(At, 1, 1); PG8_STAGE(PG8_SB(1, 0), b3, voffB); PG8_STAGE(PG8_SB(1, 1), b3 + hstep, voffB); PG8_STAGE(PG8_SA(1, 0), a3, o2[0]);
            PG8_WAIT_V(8); PG8_WAIT_L(0); PG8_BAR; PG8_MMA(1, 0, At, B0); PG8_MMA(1, 1, At, B1); PG8_BAR; PG8_SCHED;
        }
        if (wr == 0) PG8_BAR;
        if constexpr (F8) asm volatile("s_nop 15\n\ts_nop 7" ::: "memory");
        E(acc, cur, wr, wc, fr, fq);
        if (!has_next) break;
#pragma unroll
        for (int a = 0; a < 2; ++a)
#pragma unroll
            for (int b = 0; b < 2; ++b)
#pragma unroll
                for (int m = 0; m < 4; ++m)
#pragma unroll
                    for (int n = 0; n < 2; ++n) acc[a][b][m][n] = (f32x4){0.f, 0.f, 0.f, 0.f};
        cur = nxt; cB = nB; ++ui;
#pragma unroll
        for (int h = 0; h < 2; ++h)
#pragma unroll
            for (int i = 0; i < 2; ++i) curA[h][i] = nxtA[h][i];
        if (wr == 1) PG8_BAR;
    }
    PG8_WAIT_V(0);
    PG8_BAR;
#undef PG8_SA
#undef PG8_SB
#undef PG8_STAGE
#undef PG8_LDA
#undef PG8_LDB
#undef PG8_MMA
#undef PG8_WAIT_V
#undef PG8_WAIT_L
#undef PG8_BAR
#undef PG8_SCHED
#undef PG8_AOFF
}

struct DenseSched {
    int nM, nN, G, c, K; const bf16_t* Bt;
    __device__ __forceinline__ bool next(int i, Unit& u) const { u.e = 0; u.ui = i; return tile_order(i, G, c, nM, nN, u.pm, u.pn); }
    __device__ __forceinline__ unsigned a_off(const Unit& u, int rr) const { return (unsigned)((u.pm * BM + rr) * K) * 2u; }
    __device__ __forceinline__ const char* b_ptr(const Unit& u) const { return (const char*)Bt + (size_t)u.pn * BM * K * 2; }
};
struct MoeUpSched {
    int nP, G, c; const unsigned char* Bt; const PG8_LAS int* ptab; const PG8_LAS unsigned short* rtab;
    __device__ __forceinline__ bool next(int i, Unit& u) const { u.ui = i; int pi; if (!tile_order(i, G, c, nP, 28, pi, u.pn)) return false; const int en = ptab[2 + pi]; u.pm = en >> 8; u.e = en & 255; return true; }
    __device__ __forceinline__ unsigned a_off(const Unit& u, int rr) const { return (unsigned)rtab[u.ui * 256 + rr] * 1024u; }
    __device__ __forceinline__ const char* b_ptr(const Unit& u) const { return (const char*)Bt + ((size_t)u.e * 7168 + (size_t)u.pn * BM) * 1024; }
};
struct MoeDownSched {
    int nP, p0, G, c; const unsigned char* Bt; const PG8_LAS int* ptab;
    __device__ __forceinline__ bool next(int i, Unit& u) const { u.ui = i; int pi; if (!tile_order(i, G, c, nP, 4, pi, u.pn)) return false; const int en = ptab[2 + p0 + pi]; u.pm = en >> 8; u.e = en & 255; return true; }
    __device__ __forceinline__ unsigned a_off(const Unit& u, int rr) const { return (unsigned)(u.pm * BM + rr) * (unsigned)FFE; }
    __device__ __forceinline__ const char* b_ptr(const Unit& u) const { return (const char*)Bt + ((size_t)u.e * 1024 + (size_t)u.pn * BM) * FFE; }
};

struct EpiBf16 {
    static constexpr bool PERM = true;
    bf16_t* O; int ldc;
    __device__ __forceinline__ void operator()(const f32x4 (&acc)[2][2][4][2], const Unit& u, int wr, int wc, int fr, int fq) const {
        const int row0 = u.pm * BM + wr * 64 + fr, col0 = u.pn * BM + wc * 32 + 8 * fq;
#pragma unroll
        for (int ai = 0; ai < 2; ++ai)
#pragma unroll
            for (int m = 0; m < 4; ++m) { bf16_t* rowp = O + (size_t)(row0 + ai * HALF + m * 16) * ldc + col0;
#pragma unroll
                for (int bj = 0; bj < 2; ++bj) { const f32x4 v0 = acc[ai][bj][m][0], v1 = acc[ai][bj][m][1];
                    v4u w; w.x = cvt_pk_bf16(v0[0], v0[1]); w.y = cvt_pk_bf16(v0[2], v0[3]); w.z = cvt_pk_bf16(v1[0], v1[1]); w.w = cvt_pk_bf16(v1[2], v1[3]);
                    *(v4u*)(rowp + bj * HALF) = w; } }
    }
};
__device__ __forceinline__ float silu_f(float g) { return g * __builtin_amdgcn_rcpf(1.0f + __expf(-g)); }
struct EpiSwiglu {
    static constexpr bool PERM = true;
    bf16_t* O; int ldc;
    __device__ __forceinline__ void operator()(const f32x4 (&acc)[2][2][4][2], const Unit& u, int wr, int wc, int fr, int fq) const {
        const int row0 = u.pm * BM + wr * 64 + fr, col0 = u.pn * HALF + wc * 32 + 8 * fq;
#pragma unroll
        for (int ai = 0; ai < 2; ++ai)
#pragma unroll
            for (int m = 0; m < 4; ++m) { bf16_t* rowp = O + (size_t)(row0 + ai * HALF + m * 16) * ldc + col0;
                const f32x4 g0 = acc[ai][0][m][0], g1 = acc[ai][0][m][1], u0 = acc[ai][1][m][0], u1 = acc[ai][1][m][1];
                v4u w; w.x = cvt_pk_bf16(silu_f(g0[0]) * u0[0], silu_f(g0[1]) * u0[1]); w.y = cvt_pk_bf16(silu_f(g0[2]) * u0[2], silu_f(g0[3]) * u0[3]);
                w.z = cvt_pk_bf16(silu_f(g1[0]) * u1[0], silu_f(g1[1]) * u1[1]); w.w = cvt_pk_bf16(silu_f(g1[2]) * u1[2], silu_f(g1[3]) * u1[3]);
                *(v4u*)rowp = w; }
    }
};
__device__ __forceinline__ unsigned pk4_fp8(float a, float b, float c, float d) { int p = 0; p = __builtin_amdgcn_cvt_pk_fp8_f32(a, b, p, false); p = __builtin_amdgcn_cvt_pk_fp8_f32(c, d, p, true); return (unsigned)p; }
__device__ __forceinline__ float sat8(float x) { return __builtin_amdgcn_fmed3f(x, -448.0f, 448.0f); }
struct EpiSwiglu8 {
    static constexpr bool PERM = true; static constexpr unsigned SCALE_W = 0x7a7a7a7au;
    unsigned char* O; int ldc;
    __device__ __forceinline__ void operator()(const f32x4 (&acc)[2][2][4][2], const Unit& u, int wr, int wc, int fr, int fq) const {
        const int row0 = u.pm * BM + wr * 64 + fr, col0 = u.pn * HALF + wc * 32 + 8 * fq;
#pragma unroll
        for (int ai = 0; ai < 2; ++ai)
#pragma unroll
            for (int m = 0; m < 4; ++m) { unsigned char* rowp = O + (size_t)(row0 + ai * HALF + m * 16) * ldc + col0;
                const f32x4 g0 = acc[ai][0][m][0], g1 = acc[ai][0][m][1], u0 = acc[ai][1][m][0], u1 = acc[ai][1][m][1];
                v2u w; w.x = pk4_fp8(sat8(silu_f(g0[0]) * u0[0]), sat8(silu_f(g0[1]) * u0[1]), sat8(silu_f(g0[2]) * u0[2]), sat8(silu_f(g0[3]) * u0[3]));
                w.y = pk4_fp8(sat8(silu_f(g1[0]) * u1[0]), sat8(silu_f(g1[1]) * u1[1]), sat8(silu_f(g1[2]) * u1[2]), sat8(silu_f(g1[3]) * u1[3]));
                *(v2u*)rowp = w; }
    }
};
struct EpiL1in {
    static constexpr bool PERM = true;
    bf16_t* GB; bf16_t* UP;
    __device__ __forceinline__ void operator()(const f32x4 (&acc)[2][2][4][2], const Unit& u, int wr, int wc, int fr, int fq) const {
        const int row0 = u.pm * BM + wr * 64 + fr;
        if (u.pn < 4) {
            const int col0 = u.pn * BM + wc * 32 + 8 * fq;
#pragma unroll
            for (int ai = 0; ai < 2; ++ai)
#pragma unroll
                for (int m = 0; m < 4; ++m) { bf16_t* rowp = GB + (size_t)(row0 + ai * HALF + m * 16) * D_ + col0;
#pragma unroll
                    for (int bj = 0; bj < 2; ++bj) { const f32x4 v0 = acc[ai][bj][m][0], v1 = acc[ai][bj][m][1];
                        v4u w; w.x = cvt_pk_bf16(v0[0], v0[1]); w.y = cvt_pk_bf16(v0[2], v0[3]); w.z = cvt_pk_bf16(v1[0], v1[1]); w.w = cvt_pk_bf16(v1[2], v1[3]);
                        *(v4u*)(rowp + bj * HALF) = w; } }
        } else {
            const int col0 = (u.pn - 4) * HALF + wc * 32 + 8 * fq;
#pragma unroll
            for (int ai = 0; ai < 2; ++ai)
#pragma unroll
                for (int m = 0; m < 4; ++m) { bf16_t* rowp = UP + (size_t)(row0 + ai * HALF + m * 16) * D_ + col0;
                    const f32x4 g0 = acc[ai][0][m][0], g1 = acc[ai][0][m][1], u0 = acc[ai][1][m][0], u1 = acc[ai][1][m][1];
                    v4u w; w.x = cvt_pk_bf16(g0[0] * u0[0], g0[1] * u0[1]); w.y = cvt_pk_bf16(g0[2] * u0[2], g0[3] * u0[3]);
                    w.z = cvt_pk_bf16(g1[0] * u1[0], g1[1] * u1[1]); w.w = cvt_pk_bf16(g1[2] * u1[2], g1[3] * u1[3]);
                    *(v4u*)rowp = w; }
        }
    }
};
struct EpiLora {
    static constexpr bool PERM = false;
    float* WLOG; bf16_t* AB; bf16_t* GBUF; const float* w0; const float* a0;
    __device__ __forceinline__ void operator()(const f32x4 (&acc)[2][2][4][2], const Unit& u, int wr, int wc, int fr, int fq) const {
        const int row0 = u.pm * BM + wr * 64 + fr, sec = u.pn >> 1, chb = (u.pn & 1) * BM + wc * 32 + 4 * fq;
        if (sec == 0) {
#pragma unroll
            for (int bj = 0; bj < 2; ++bj)
#pragma unroll
                for (int n = 0; n < 2; ++n) { const int ch = chb + bj * HALF + n * 16; const f32x4 bias = *(const f32x4*)(w0 + ch);
#pragma unroll
                    for (int ai = 0; ai < 2; ++ai)
#pragma unroll
                        for (int m = 0; m < 4; ++m) { const size_t ro = (size_t)(row0 + ai * HALF + m * 16) * 512 + ch; const f32x4 v = acc[ai][bj][m][n] + bias; f32x4 o;
#pragma unroll
                            for (int j = 0; j < 4; ++j) o[j] = -0.60653065971263342f * __builtin_amdgcn_rcpf(1.0f + __expf(-v[j]));
                            *(f32x4*)(WLOG + ro) = o; } }
        } else if (sec == 1) {
#pragma unroll
            for (int bj = 0; bj < 2; ++bj)
#pragma unroll
                for (int n = 0; n < 2; ++n) { const int ch = chb + bj * HALF + n * 16; const f32x4 bias = *(const f32x4*)(a0 + ch);
#pragma unroll
                    for (int ai = 0; ai < 2; ++ai)
#pragma unroll
                        for (int m = 0; m < 4; ++m) { const size_t ro = (size_t)(row0 + ai * HALF + m * 16) * 512 + ch; const f32x4 v = acc[ai][bj][m][n] + bias; f32x4 o;
#pragma unroll
                            for (int j = 0; j < 4; ++j) o[j] = __builtin_amdgcn_rcpf(1.0f + __expf(-v[j]));
                            v2u w; w.x = cvt_pk_bf16(o[0], o[1]); w.y = cvt_pk_bf16(o[2], o[3]); *(v2u*)(AB + ro) = w; } }
        } else {
#pragma unroll
            for (int bj = 0; bj < 2; ++bj)
#pragma unroll
                for (int n = 0; n < 2; ++n) { const int ch = chb + bj * HALF + n * 16;
#pragma unroll
                    for (int ai = 0; ai < 2; ++ai)
#pragma unroll
                        for (int m = 0; m < 4; ++m) { const size_t ro = (size_t)(row0 + ai * HALF + m * 16) * 512 + ch; const f32x4 v = acc[ai][bj][m][n];
                            v2u w; w.x = cvt_pk_bf16(v[0], v[1]); w.y = cvt_pk_bf16(v[2], v[3]); *(v2u*)(GBUF + ro) = w; } }
        }
    }
};
__device__ __forceinline__ void row_stats(const float* stp, int row, float& mu, float& r) {
    const f32x4 a = *(const f32x4*)(stp + (size_t)row * 8), b = *(const f32x4*)(stp + (size_t)row * 8 + 4);
    const float s = ((a[0] + a[2]) + b[0]) + b[2], q = ((a[1] + a[3]) + b[1]) + b[3];
    mu = s * (1.0f / 1024.0f); r = rsqrtf(fmaxf(q * (1.0f / 1024.0f) - mu * mu, 0.f) + LN_EPS);
}
struct EpiResStats {
    static constexpr bool PERM = false;
    const float* base; float* out; bf16_t* outb; float* stp_out; PG8_LAS float* P; const PG8_LAS float* tbl; const float* stp_in; const float* gin; const float* bin;
    __device__ __forceinline__ void operator()(const f32x4 (&acc)[2][2][4][2], const Unit& u, int wr, int wc, int fr, int fq) const {
        const int row0 = u.pm * BM + wr * 64 + fr, col0 = u.pn * BM + wc * 32 + 4 * fq;
        f32x4 gv[2][2], bv[2][2];
        if (stp_in) {
#pragma unroll
            for (int bj = 0; bj < 2; ++bj)
#pragma unroll
                for (int n = 0; n < 2; ++n) { gv[bj][n] = *(const f32x4*)(gin + col0 + bj * HALF + n * 16); bv[bj][n] = *(const f32x4*)(bin + col0 + bj * HALF + n * 16); } }
#pragma unroll
        for (int ai = 0; ai < 2; ++ai)
#pragma unroll
            for (int m = 0; m < 4; ++m) { const int row = row0 + ai * HALF + m * 16; const size_t off = (size_t)row * D_ + col0;
                float mu = 0.f, rr = 1.f; if (stp_in) { const f32x2 mr = *(const PG8_LAS f32x2*)(tbl + (u.ui * 256 + ai * HALF + wr * 64 + m * 16 + fr) * 2); mu = mr[0]; rr = mr[1]; }
                float s = 0.f, q = 0.f;
#pragma unroll
                for (int bj = 0; bj < 2; ++bj)
#pragma unroll
                    for (int n = 0; n < 2; ++n) { f32x4 h = *(const f32x4*)(base + off + bj * HALF + n * 16);
                        if (stp_in) h = (h - mu) * rr * gv[bj][n] + bv[bj][n];
                        const f32x4 v = h * ALPHA + acc[ai][bj][m][n];
                        *(f32x4*)(out + off + bj * HALF + n * 16) = v;
                        if (outb) { v2u w; w.x = cvt_pk_bf16(v[0], v[1]); w.y = cvt_pk_bf16(v[2], v[3]); *(v2u*)(outb + off + bj * HALF + n * 16) = w; }
                        s += (v[0] + v[1]) + (v[2] + v[3]); q += (v[0] * v[0] + v[1] * v[1]) + (v[2] * v[2] + v[3] * v[3]); }
                if (stp_out) { s += __shfl_xor(s, 16); s += __shfl_xor(s, 32); q += __shfl_xor(q, 16); q += __shfl_xor(q, 32);
                    if (fq == 0) { PG8_LAS float* p = P + ((ai * HALF + wr * 64 + m * 16 + fr) * 4 + wc) * 2; p[0] = s; p[1] = q; } } }
        if (stp_out) {
            asm volatile("s_waitcnt lgkmcnt(0)" ::: "memory"); __builtin_amdgcn_s_barrier(); asm volatile("" ::: "memory");
            const int t = threadIdx.x;
            if (t < 256) { const f32x4 a = *(const PG8_LAS f32x4*)(P + t * 8), b = *(const PG8_LAS f32x4*)(P + t * 8 + 4);
                f32x2 o; o[0] = ((a[0] + a[2]) + b[0]) + b[2]; o[1] = ((a[1] + a[3]) + b[1]) + b[3];
                *(f32x2*)(stp_out + (size_t)(u.pm * BM + t) * 8 + u.pn * 2) = o; } }
    }
};
struct EpiSwigluLN {
    static constexpr bool PERM = true;
    bf16_t* O; int ldc; const PG8_LAS float* tbl; const float* sv; const float* cv;
    __device__ __forceinline__ void operator()(const f32x4 (&acc)[2][2][4][2], const Unit& u, int wr, int wc, int fr, int fq) const {
        const int row0 = u.pm * BM + wr * 64 + fr, col0 = u.pn * HALF + wc * 32 + 8 * fq, n0 = u.pn * BM + wc * 32 + 8 * fq;
        f32x4 sg[2], cg[2], su[2], cu[2];
#pragma unroll
        for (int n = 0; n < 2; ++n) { sg[n] = *(const f32x4*)(sv + n0 + 4 * n); cg[n] = *(const f32x4*)(cv + n0 + 4 * n); su[n] = *(const f32x4*)(sv + n0 + HALF + 4 * n); cu[n] = *(const f32x4*)(cv + n0 + HALF + 4 * n); }
#pragma unroll
        for (int ai = 0; ai < 2; ++ai)
#pragma unroll
            for (int m = 0; m < 4; ++m) { const int row = row0 + ai * HALF + m * 16; bf16_t* rowp = O + (size_t)row * ldc + col0;
                const f32x2 mr = *(const PG8_LAS f32x2*)(tbl + (u.ui * 256 + ai * HALF + wr * 64 + m * 16 + fr) * 2); const float mu = mr[0], rr = mr[1];
                const f32x4 g0 = (acc[ai][0][m][0] - sg[0] * mu) * rr + cg[0], g1 = (acc[ai][0][m][1] - sg[1] * mu) * rr + cg[1];
                const f32x4 u0 = (acc[ai][1][m][0] - su[0] * mu) * rr + cu[0], u1 = (acc[ai][1][m][1] - su[1] * mu) * rr + cu[1];
                v4u w; w.x = cvt_pk_bf16(silu_f(g0[0]) * u0[0], silu_f(g0[1]) * u0[1]); w.y = cvt_pk_bf16(silu_f(g0[2]) * u0[2], silu_f(g0[3]) * u0[3]);
                w.z = cvt_pk_bf16(silu_f(g1[0]) * u1[0], silu_f(g1[1]) * u1[1]); w.w = cvt_pk_bf16(silu_f(g1[2]) * u1[2], silu_f(g1[3]) * u1[3]);
                *(v4u*)rowp = w; }
    }
};
struct EpiL1inLN {
    static constexpr bool PERM = true;
    bf16_t* GB; bf16_t* UP; const PG8_LAS float* tbl; const float* sv; const float* cv;
    __device__ __forceinline__ void operator()(const f32x4 (&acc)[2][2][4][2], const Unit& u, int wr, int wc, int fr, int fq) const {
        const int row0 = u.pm * BM + wr * 64 + fr, n0 = u.pn * BM + wc * 32 + 8 * fq;
        f32x4 s0[2], c0[2], s1[2], c1[2];
#pragma unroll
        for (int n = 0; n < 2; ++n) { s0[n] = *(const f32x4*)(sv + n0 + 4 * n); c0[n] = *(const f32x4*)(cv + n0 + 4 * n); s1[n] = *(const f32x4*)(sv + n0 + HALF + 4 * n); c1[n] = *(const f32x4*)(cv + n0 + HALF + 4 * n); }
#pragma unroll
        for (int ai = 0; ai < 2; ++ai)
#pragma unroll
            for (int m = 0; m < 4; ++m) { const int row = row0 + ai * HALF + m * 16;
                const f32x2 mr = *(const PG8_LAS f32x2*)(tbl + (u.ui * 256 + ai * HALF + wr * 64 + m * 16 + fr) * 2); const float mu = mr[0], rr = mr[1];
                const f32x4 a0 = (acc[ai][0][m][0] - s0[0] * mu) * rr + c0[0], a1 = (acc[ai][0][m][1] - s0[1] * mu) * rr + c0[1];
                const f32x4 b0 = (acc[ai][1][m][0] - s1[0] * mu) * rr + c1[0], b1 = (acc[ai][1][m][1] - s1[1] * mu) * rr + c1[1];
                if (u.pn < 4) { bf16_t* rowp = GB + (size_t)row * D_ + n0;
                    v4u w; w.x = cvt_pk_bf16(a0[0], a0[1]); w.y = cvt_pk_bf16(a0[2], a0[3]); w.z = cvt_pk_bf16(a1[0], a1[1]); w.w = cvt_pk_bf16(a1[2], a1[3]); *(v4u*)rowp = w;
                    v4u x; x.x = cvt_pk_bf16(b0[0], b0[1]); x.y = cvt_pk_bf16(b0[2], b0[3]); x.z = cvt_pk_bf16(b1[0], b1[1]); x.w = cvt_pk_bf16(b1[2], b1[3]); *(v4u*)(rowp + HALF) = x; }
                else { bf16_t* rowp = UP + (size_t)row * D_ + (u.pn - 4) * HALF + wc * 32 + 8 * fq;
                    v4u w; w.x = cvt_pk_bf16(a0[0] * b0[0], a0[1] * b0[1]); w.y = cvt_pk_bf16(a0[2] * b0[2], a0[3] * b0[3]); w.z = cvt_pk_bf16(a1[0] * b1[0], a1[1] * b1[1]); w.w = cvt_pk_bf16(a1[2] * b1[2], a1[3] * b1[3]); *(v4u*)rowp = w; } }
    }
};
struct EpiMoeDown {
    static constexpr bool PERM = false; static constexpr unsigned SCALE_W = 0x78787878u;
    float* out; bf16_t* Y2; const int* perm; const float* tokp;
    __device__ __forceinline__ void operator()(const f32x4 (&acc)[2][2][4][2], const Unit& u, int wr, int wc, int fr, int fq) const {
        const int slot0 = u.pm * BM + wr * 64 + fr, col0 = u.pn * BM + wc * 32 + 4 * fq; const int pass = u.pm >= MAXPANEL ? 1 : 0;
#pragma unroll
        for (int ai = 0; ai < 2; ++ai)
#pragma unroll
            for (int m = 0; m < 4; ++m) { const int tok = perm[slot0 + ai * HALF + m * 16];
                if (tok >= 0) { const float p = tokp[2 * tok + pass]; const size_t off = (size_t)tok * D_ + col0;
                    if (pass == 0) {
#pragma unroll
                        for (int bj = 0; bj < 2; ++bj)
#pragma unroll
                            for (int n = 0; n < 2; ++n) { const f32x4 bs = *(const f32x4*)(out + off + bj * HALF + n * 16); *(f32x4*)(out + off + bj * HALF + n * 16) = bs * ALPHA + acc[ai][bj][m][n] * p; }
                    } else {
#pragma unroll
                        for (int bj = 0; bj < 2; ++bj)
#pragma unroll
                            for (int n = 0; n < 2; ++n) { const f32x4 v = acc[ai][bj][m][n] * p; v2u w; w.x = cvt_pk_bf16(v[0], v[1]); w.y = cvt_pk_bf16(v[2], v[3]); *(v2u*)(Y2 + off + bj * HALF + n * 16) = w; }
                    } } }
    }
};
}

#define XB_TMO      128
#define XB_XCNT(j)  (256  + 64 * (j))
#define XB_XSUB(j)  (1280 + 64 * (j))
#define XB_XGEN(j)  (2304 + 64 * (j))
#define XB_TOP      3328
#define XB_TOPGEN   3392
#define XCD_BAR_WORDS 3456
#define XB_SPIN_CAP (1u << 22)
__device__ __forceinline__ unsigned xb_ld(unsigned* p)              { return __hip_atomic_load(p, __ATOMIC_RELAXED, __HIP_MEMORY_SCOPE_AGENT); }
__device__ __forceinline__ unsigned xb_add(unsigned* p, unsigned v) { return __hip_atomic_fetch_add(p, v, __ATOMIC_RELAXED, __HIP_MEMORY_SCOPE_AGENT); }
__device__ __forceinline__ unsigned xb_xcc_id() { return (unsigned)__builtin_amdgcn_s_getreg((3 << 11) | 20) & 0xFu; }
#define XB_SPIN(cond, bar) do { unsigned _sp = 0; while (cond) { __builtin_amdgcn_s_sleep(1); \
    if ((++_sp & 255u) == 0u) { if (xb_ld(&(bar)[XB_TMO])) break; if (_sp > XB_SPIN_CAP) { atomicAdd(&(bar)[XB_TMO], 1u); break; } } } } while (0)
struct XcdBarrier { unsigned* bar; unsigned x; volatile LAS unsigned* st; };
__device__ __forceinline__ XcdBarrier xcd_barrier_post(unsigned* bar, volatile LAS unsigned* st) {
    XcdBarrier b; b.bar = bar; b.x = xb_xcc_id(); b.st = st;
    if (threadIdx.x == 0) (void)xb_add(&bar[XB_XCNT(b.x)], 1u);
    return b;
}
__device__ __forceinline__ void xcd_barrier_complete(unsigned* bar, unsigned x, unsigned& nloc, unsigned& nx) {
    const unsigned G = gridDim.x * gridDim.y * gridDim.z;
    unsigned sum, cnt, mine, sp = 0u;
    for (;;) {
        sum = 0u; cnt = 0u; mine = 0u;
#pragma unroll
        for (unsigned j = 0; j < 16; ++j) { const unsigned c = xb_ld(&bar[XB_XCNT(j)]); sum += c; cnt += (c > 0u) ? 1u : 0u; mine = (j == x) ? c : mine; }
        if (sum == G) break;
        __builtin_amdgcn_s_sleep(1);
        if ((++sp & 255u) == 0u) { if (xb_ld(&bar[XB_TMO])) break; if (sp > XB_SPIN_CAP) { atomicAdd(&bar[XB_TMO], 1u); break; } }
    }
    nloc = mine > 0u ? mine : 1u; nx = cnt > 0u ? cnt : 1u;
}
__device__ __forceinline__ void xcd_barrier(const XcdBarrier& b) {
    asm volatile("s_waitcnt vmcnt(0)" ::: "memory");
    __syncthreads();
    if (threadIdx.x == 0) {
        unsigned* bar = b.bar;
        __builtin_amdgcn_s_waitcnt(0);
        unsigned nloc = b.st[0], nx = b.st[1];
        if (nloc == 0u) { xcd_barrier_complete(bar, b.x, nloc, nx); b.st[0] = nloc; b.st[1] = nx; }
        const unsigned old = xb_add(&bar[XB_XSUB(b.x)], 1u);
        const unsigned gen = old / nloc;
        if (old + 1u == (gen + 1u) * nloc) {
            __builtin_amdgcn_fence(__ATOMIC_RELEASE, "agent");
            asm volatile("s_waitcnt vmcnt(0)" ::: "memory");
            const unsigned og = xb_add(&bar[XB_TOP], 1u);
            const unsigned tg = og / nx;
            if (og + 1u == (tg + 1u) * nx) xb_add(&bar[XB_TOPGEN], 1u);
            else XB_SPIN(xb_ld(&bar[XB_TOPGEN]) == tg, bar);
            __builtin_amdgcn_fence(__ATOMIC_ACQUIRE, "agent");
            xb_add(&bar[XB_XGEN(b.x)], 1u);
            asm volatile("s_waitcnt vmcnt(0)" ::: "memory");
        } else {
            XB_SPIN(xb_ld(&bar[XB_XGEN(b.x)]) == gen, bar);
            __builtin_amdgcn_fence(__ATOMIC_ACQUIRE, "agent");
            asm volatile("s_waitcnt vmcnt(0)" ::: "memory");
        }
    }
    __syncthreads();
}

__device__ __forceinline__ unsigned f2bf(float f) { unsigned u = __builtin_bit_cast(unsigned, f); return (u + 0x7fffu + ((u >> 16) & 1u)) >> 16; }
__device__ __forceinline__ unsigned pk2(float lo, float hi) { return pg8::cvt_pk_bf16(lo, hi); }
__device__ __forceinline__ float bf2f(unsigned short b) { return __builtin_bit_cast(float, ((unsigned)b) << 16); }
__device__ __forceinline__ float bflo(unsigned w) { return __builtin_bit_cast(float, w << 16); }
__device__ __forceinline__ float bfhi(unsigned w) { return __builtin_bit_cast(float, w & 0xffff0000u); }
__device__ __forceinline__ float wave_sum(float v) {
#pragma unroll
    for (int o = 1; o < 64; o <<= 1) v += __shfl_xor(v, o);
    return v;
}
template <int CTRL> __device__ __forceinline__ float dpp_mov(float x) { return __builtin_bit_cast(float, __builtin_amdgcn_update_dpp(0, __builtin_bit_cast(int, x), CTRL, 0xf, 0xf, false)); }
__device__ __forceinline__ float row16_sum(float x) { x += dpp_mov<0x128>(x); x += dpp_mov<0x124>(x); x += dpp_mov<0x122>(x); x += dpp_mov<0x121>(x); return x; }

__device__ __forceinline__ float rl_f(float x, int l) { return __builtin_bit_cast(float, __builtin_amdgcn_readlane(__builtin_bit_cast(int, x), l)); }
template <int CTRL, int RMASK> __device__ __forceinline__ float dpp_add_rm(float x) { return x + __builtin_bit_cast(float, __builtin_amdgcn_update_dpp(0, __builtin_bit_cast(int, x), CTRL, RMASK, 0xf, true)); }
__device__ __forceinline__ float wave_sum_fast(float x) { x = row16_sum(x); x = dpp_add_rm<0x142, 0xA>(x); x = dpp_add_rm<0x143, 0xC>(x); return rl_f(x, 63); }
struct WInfo { int tid, lane, wave, vcu, G, gw, NGW; };

__device__ __forceinline__ void tr_item(const float* __restrict__ W, int Nsrc, int c0, int k0, bf16* WT, int K, int n0, LAS float* scr, int lane, const float* ksc = nullptr) {
#pragma unroll 32
    for (int i = 0; i < 32; ++i) { const int kk = 2 * i + (lane >> 5); const float wv = W[(size_t)(k0 + kk) * Nsrc + c0 + (lane & 31)]; scr[kk * 33 + (lane & 31)] = ksc ? wv * ksc[k0 + kk] : wv; }
    LDS_WAIT(); asm volatile("" ::: "memory");
    const int c = lane & 7;
#pragma unroll
    for (int j = 0; j < 4; ++j) { const int n = (lane >> 3) + 8 * j; const LAS float* s = scr + (8 * c) * 33 + n;
        v4u o; o.x = pk2(s[0 * 33], s[1 * 33]); o.y = pk2(s[2 * 33], s[3 * 33]); o.z = pk2(s[4 * 33], s[5 * 33]); o.w = pk2(s[6 * 33], s[7 * 33]);
        *(v4u*)(WT + (size_t)(n0 + n) * K + k0 + 8 * c) = o; }
    LDS_WAIT(); asm volatile("" ::: "memory");
}
__device__ __forceinline__ void tr_item8(const float* __restrict__ Wsrc, int Nsrc, int c0, int k0, unsigned char* WT, int K, int n0, float scale, LAS float* scr, int lane) {
#pragma unroll 32
    for (int i = 0; i < 32; ++i) { const int kk = 2 * i + (lane >> 5); scr[kk * 33 + (lane & 31)] = Wsrc[(size_t)(k0 + kk) * Nsrc + c0 + (lane & 31)] * scale; }
    LDS_WAIT(); asm volatile("" ::: "memory");
    const int n = lane & 31, kh = lane >> 5; const LAS float* s = scr + (kh * 32) * 33 + n;
    v4u o0, o1;
#pragma unroll
    for (int q = 0; q < 4; ++q) { o0[q] = pg8::pk4_fp8(s[(4 * q) * 33], s[(4 * q + 1) * 33], s[(4 * q + 2) * 33], s[(4 * q + 3) * 33]); o1[q] = pg8::pk4_fp8(s[(16 + 4 * q) * 33], s[(17 + 4 * q) * 33], s[(18 + 4 * q) * 33], s[(19 + 4 * q) * 33]); }
    unsigned char* dst = WT + (size_t)(n0 + n) * K + k0 + kh * 32; *(v4u*)dst = o0; *(v4u*)(dst + 16) = o1;
    LDS_WAIT(); asm volatile("" ::: "memory");
}
constexpr int I_WIN0 = 16 * 80, I_WOUT = 16 * 32, I_FGU = 16 * 176, I_FD = 44 * 32, I_IN1 = 16 * 96, I_MGU1 = 16 * 224, I_MD1 = 56 * 32;
constexpr int NITEMS_MOE = 8 * I_MGU1 + 8 * I_MD1, NITEMS = I_WIN0 + I_WOUT + I_FGU + I_FD + I_IN1 + I_WOUT + NITEMS_MOE;
__device__ __forceinline__ void weight_item(const WInfo& W, LAS unsigned char* lds, const float* const* in, unsigned char* ws, int it) {
    LAS float* scr = (LAS float*)(lds + W.wave * 16384);
    for (int once = 0; once < 1; ++once) {
        int r = it;
        if (r < 8 * I_MGU1) { const int e = r / I_MGU1, r2 = r % I_MGU1, kb = r2 / 224, nb = r2 % 224, n0 = nb * 32, q = n0 >> 8, rr = n0 & 255;
            const float* src = (rr < 128 ? in[29] : in[30]) + (size_t)e * 1024 * FFE;
            tr_item8(src, FFE, q * 128 + (rr & 127), kb * 64, ws + WS_WMGU + (size_t)e * 7168 * 1024, 1024, n0, 32.0f, scr, W.lane); continue; } r -= 8 * I_MGU1;
        if (r < 8 * I_MD1) { const int e = r / I_MD1, r2 = r % I_MD1, kb = r2 / 32, nb = r2 % 32;
            tr_item8(in[31] + (size_t)e * FFE * 1024, 1024, nb * 32, kb * 64, ws + WS_WMD + (size_t)e * 1024 * FFE, FFE, nb * 32, 128.0f, scr, W.lane); continue; } r -= 8 * I_MD1;
        if (r < I_WIN0) { const int kb = r / 80, nb = r % 80; tr_item(in[2], NZ, nb * 32, kb * 64, (bf16*)(ws + WS_WIN0), 1024, nb * 32, scr, W.lane); continue; } r -= I_WIN0;
        if (r < I_WOUT) { const int kb = r / 32, nb = r % 32; tr_item(in[15], 1024, nb * 32, kb * 64, (bf16*)(ws + WS_WOUT0), 1024, nb * 32, scr, W.lane); continue; } r -= I_WOUT;
        if (r < I_FGU) { const int kb = r / 176, nb = r % 176, n0 = nb * 32, q = n0 >> 8, rr = n0 & 255;
            tr_item(rr < 128 ? in[18] : in[19], FF, q * 128 + (rr & 127), kb * 64, (bf16*)(ws + WS_WFGU), 1024, n0, scr, W.lane, in[16]); continue; } r -= I_FGU;
        if (r < I_FD) { const int kb = r / 32, nb = r % 32; tr_item(in[20], 1024, nb * 32, kb * 64, (bf16*)(ws + WS_WFD), FF, nb * 32, scr, W.lane); continue; } r -= I_FD;
        if (r < I_IN1) { const int kb = r / 96, nb = r % 96, n0 = nb * 32; int c0 = n0;
            if (n0 >= 1024) { const int q = (n0 - 1024) >> 8, rr = (n0 - 1024) & 255; c0 = (rr < 128 ? 1024 : 2048) + q * 128 + (rr & 127); }
            tr_item(in[23], 3072, c0, kb * 64, (bf16*)(ws + WS_WIN1), 1024, n0, scr, W.lane, in[21]); continue; } r -= I_IN1;
        { const int kb = r / 32, nb = r % 32; tr_item(in[25], 1024, nb * 32, kb * 64, (bf16*)(ws + WS_WOUT1), 1024, nb * 32, scr, W.lane); }
    }
}
__device__ __forceinline__ void p0_weights(const WInfo& W, LAS unsigned char* lds, const float* const* in, unsigned char* ws, int it_lo, int it_hi) {
    for (int it = it_lo + W.gw; it < it_hi; it += W.NGW) weight_item(W, lds, in, ws, it);
}
__device__ __forceinline__ void lnvec_block(const WInfo& W, LAS unsigned char* lds, const float* const* in, unsigned char* ws, int blk) {
    LAS float* red = (LAS float*)lds;
    float* SV = (float*)(ws + WS_LNV); float* CV = SV + 8704;
    {
        const bool ffn = blk < 88; const int n = (ffn ? blk : blk - 88) * 64 + W.lane;
        const float* src; int Nsrc, col; const float* gk; const float* bk;
        if (ffn) { const int q = n >> 8, rr = n & 255; src = rr < 128 ? in[18] : in[19]; Nsrc = FF; col = q * 128 + (rr & 127); gk = in[16]; bk = in[17]; }
        else { src = in[23]; Nsrc = 3072; col = n; if (n >= 1024) { const int q = (n - 1024) >> 8, rr = (n - 1024) & 255; col = (rr < 128 ? 1024 : 2048) + q * 128 + (rr & 127); } gk = in[21]; bk = in[22]; }
        float s = 0.f, c = 0.f;
#pragma unroll 32
        for (int kk = 0; kk < 128; ++kk) { const int k = W.wave * 128 + kk; const float wv = src[(size_t)k * Nsrc + col]; s += bflo(pk2(wv * gk[k], 0.f)); c += wv * bk[k]; }
        __syncthreads();
        red[(W.wave * 64 + W.lane) * 2] = s; red[(W.wave * 64 + W.lane) * 2 + 1] = c;
        __syncthreads();
        if (W.wave == 0) { float ss = 0.f, cc = 0.f;
#pragma unroll
            for (int w8 = 0; w8 < 8; ++w8) { ss += red[(w8 * 64 + W.lane) * 2]; cc += red[(w8 * 64 + W.lane) * 2 + 1]; }
            const int o = (ffn ? 0 : 5632) + n; SV[o] = ss; CV[o] = cc; }
    }
}
__device__ __forceinline__ void p0_prologue(const WInfo& W, LAS unsigned char* lds, const float* const* in, unsigned char* ws) {
    p0_weights(W, lds, in, ws, NITEMS_MOE, NITEMS_MOE + I_WIN0);
    const size_t gtid = (size_t)W.gw * 64 + W.lane, NT = (size_t)W.NGW * 64;
    { bf16* WL = (bf16*)(ws + WS_WLORA);
      for (size_t i = gtid; i < (size_t)1536 * 256; i += NT) { const int n = (int)(i >> 8), k = (int)(i & 255), s = n >> 9, ch = n & 511; float v = 0.f;
          if (s == 0) { if (k < 64) v = in[6][k * 512 + ch]; } else if (s == 1) { if (k >= 64 && k < 128) v = in[8][(k - 64) * 512 + ch]; } else { if (k >= 128) v = in[9][(k - 128) * 512 + ch]; }
          WL[i] = (bf16)f2bf(v); } }
    { const f32x4* x4 = (const f32x4*)in[0]; v4u* xb = (v4u*)(ws + WS_B0);
      for (size_t i = gtid; i < (size_t)T_ * D_ / 8; i += NT) { const f32x4 a = x4[2 * i], b = x4[2 * i + 1]; v4u o; o.x = pk2(a[0], a[1]); o.y = pk2(a[2], a[3]); o.z = pk2(b[0], b[1]); o.w = pk2(b[2], b[3]); xb[i] = o; } }
    { int* pm = (int*)(ws + WS_PERM); for (size_t i = gtid; i < (size_t)2 * PERMLEN; i += NT) pm[i] = -1; }
}

__device__ __forceinline__ void deferred_work(const WInfo& W, LAS unsigned char* lds, const float* const* in, unsigned char* ws, unsigned* qctr) {
    constexpr int ITEM0 = NITEMS_MOE + I_WIN0, NCH = (NITEMS - ITEM0 + 7) / 8;
    LAS int* qsh = (LAS int*)(lds + RING_BYTES);
    for (;;) {
        __syncthreads();
        if (W.tid == 0) qsh[0] = (int)__hip_atomic_fetch_add(qctr, 1u, __ATOMIC_RELAXED, __HIP_MEMORY_SCOPE_AGENT);
        __syncthreads();
        const int q = qsh[0]; if (q >= 136 + NCH) break;
        if (q < 136) lnvec_block(W, lds, in, ws, q);
        else { const int it = ITEM0 + (q - 136) * 8 + W.wave; if (it < NITEMS) weight_item(W, lds, in, ws, it); }
    }
}
#define MFMA32(a, b, c) __builtin_amdgcn_mfma_f32_32x32x16_bf16((a), (b), (c), 0, 0, 0)
__device__ __forceinline__ void attn_phase(const WInfo& W, LAS unsigned char* lds, const bf16* Z, bf16* MIX, const float* sinks, const float* relb, unsigned* qctr) {
    LAS bf16* Ks = (LAS bf16*)lds;
    LAS bf16* Vt = (LAS bf16*)(lds + 36864);
    LAS float* BT = (LAS float*)(lds + 36864 + 33280);
    const int tid = W.tid, lane = W.lane, w = W.wave, r32 = lane & 31, hh = lane >> 5;
    LAS float* BB = (LAS float*)(lds + 36864 + 33280 + 16 * 388 * 4);
    for (int i = tid; i < 1024; i += 512) { const int hq = i >> 7, dist = i & 127; int bucket = dist;
        if (dist >= 16) { const float lr = logf((float)dist / 16.0f) / 2.0794415416798357f; bucket = 16 + (int)(lr * 16.0f); if (bucket > 31) bucket = 31; }
        BB[i] = relb[bucket * 8 + hq] * LOG2E; }
    int last_kvh = -1;
    LAS int* qsh = (LAS int*)(lds + RING_BYTES);
    if (tid == 0) qsh[0] = (int)__hip_atomic_fetch_add(qctr, 1u, __ATOMIC_RELAXED, __HIP_MEMORY_SCOPE_AGENT);
    for (;;) {
        __syncthreads();
        const int u = qsh[0];
        __syncthreads();
        if (u >= 512) break;
        if (tid == 0) qsh[0] = (int)__hip_atomic_fetch_add(qctr, 1u, __ATOMIC_RELAXED, __HIP_MEMORY_SCOPE_AGENT);
        const int b = u >> 6, kvh = (u >> 5) & 1, nb = u & 31;
        if (kvh != last_kvh) { last_kvh = kvh;
            for (int i = tid; i < 16 * 388; i += 512) { const int k = i / (4 * 388), g = (i / 388) & 3, y = i % 388, x = y + k - 128;
                BT[i] = (x >= 1 && x <= 128) ? BB[(kvh * 4 + g) * 128 + (128 - x)] : 0.f; } }
        { const int key = tid >> 1, half = tid & 1, s = nb * 128 - 128 + key;
          v4u kq[4], vq[4];
          if (s >= 0) { const bf16* zr = Z + (size_t)(b * SEQ + s) * NZ;
#pragma unroll
              for (int j = 0; j < 4; ++j) { kq[j] = *(const v4u*)(zr + 512 + kvh * 64 + half * 32 + 8 * j); vq[j] = *(const v4u*)(zr + 640 + kvh * 64 + half * 32 + 8 * j); } }
          else {
#pragma unroll
              for (int j = 0; j < 4; ++j) { kq[j] = (v4u){0u, 0u, 0u, 0u}; vq[j] = (v4u){0u, 0u, 0u, 0u}; } }
#pragma unroll
          for (int j = 0; j < 4; ++j) { *(LAS v4u*)(Ks + key * 72 + half * 32 + 8 * j) = kq[j];
#pragma unroll
              for (int e = 0; e < 4; ++e) { const unsigned wv = vq[j][e]; const int d = half * 32 + 8 * j + 2 * e; Vt[d * 260 + key] = (bf16)(wv & 0xffffu); Vt[(d + 1) * 260 + key] = (bf16)(wv >> 16); } } }
        __syncthreads();
        const int g = w >> 1, rh = w & 1, habs = kvh * 4 + g;
        bf16x8 qf[2][4]; int qi[2]; size_t mq[2];
#pragma unroll
        for (int qt = 0; qt < 2; ++qt) { qi[qt] = 64 * rh + 32 * qt + r32; mq[qt] = (size_t)(b * SEQ + nb * 128 + qi[qt]);
#pragma unroll
            for (int s = 0; s < 4; ++s) qf[qt][s] = *(const bf16x8*)(Z + mq[qt] * NZ + habs * 64 + 16 * s + 8 * hh); }
        const float sinkl = sinks[habs] * LOG2E;
        float mrun[2] = {sinkl, sinkl}, lsum[2] = {hh == 0 ? 1.f : 0.f, hh == 0 ? 1.f : 0.f};
        f32x16 ot[2][2];
#pragma unroll
        for (int a = 0; a < 2; ++a)
#pragma unroll
            for (int c = 0; c < 2; ++c)
#pragma unroll
                for (int i = 0; i < 16; ++i) ot[a][c][i] = 0.f;
        for (int ks = 2 * rh; ks < 2 * rh + 6; ++ks) {
            bool act[2], full[2];
#pragma unroll
            for (int qt = 0; qt < 2; ++qt) { const int q0 = 64 * rh + 32 * qt, q1 = q0 + 31, k0 = 32 * ks, k1 = k0 + 31;
                act[qt] = (k1 - q0 >= 1) && (k0 - q1 <= 128) && (nb > 0 || k1 >= 128);
                full[qt] = (k0 - q1 >= 1) && (k1 - q0 <= 128) && (nb > 0 || k0 >= 128); }
            if (!act[0] && !act[1]) continue;
            f32x16 sc[2];
#pragma unroll
            for (int qt = 0; qt < 2; ++qt)
#pragma unroll
                for (int i = 0; i < 16; ++i) sc[qt][i] = 0.f;
#pragma unroll
            for (int s = 0; s < 4; ++s) { const bf16x8 kf = *(const LAS bf16x8*)(Ks + (32 * ks + r32) * 72 + 16 * s + 8 * hh);
                if (act[0]) sc[0] = MFMA32(kf, qf[0][s], sc[0]); if (act[1]) sc[1] = MFMA32(kf, qf[1][s], sc[1]); }
            bf16x8 pf[2][2];
#pragma unroll
            for (int qt = 0; qt < 2; ++qt) if (act[qt]) {
                float mx = -1e30f;
#pragma unroll
                for (int c = 0; c < 4; ++c) { const int kbase = 32 * ks + 8 * c + 4 * hh, xbase = kbase - qi[qt], X = xbase + 128, kk = X & 3, y = X - kk;
                    const f32x4 b4 = *(const LAS f32x4*)(BT + (kk * 4 + g) * 388 + y);
                    if (full[qt]) {
#pragma unroll
                        for (int j = 0; j < 4; ++j) { const float t = sc[qt][4 * c + j] * (0.125f * LOG2E) + b4[j]; sc[qt][4 * c + j] = t; mx = fmaxf(mx, t); }
                    } else {
#pragma unroll
                        for (int j = 0; j < 4; ++j) { const int x = xbase + j; const bool valid = (x >= 1) && (x <= 128) && (nb > 0 || kbase + j >= 128);
                            const float t = valid ? (sc[qt][4 * c + j] * (0.125f * LOG2E) + b4[j]) : -1e30f; sc[qt][4 * c + j] = t; mx = fmaxf(mx, t); } } }
                mx = fmaxf(mx, __shfl_xor(mx, 32));
                const float mnew = fmaxf(mrun[qt], mx), corr = __builtin_amdgcn_exp2f(mrun[qt] - mnew); mrun[qt] = mnew;
                float ps = 0.f;
#pragma unroll
                for (int i = 0; i < 16; ++i) { const float p = __builtin_amdgcn_exp2f(sc[qt][i] - mnew); sc[qt][i] = p; ps += p; }
                lsum[qt] = lsum[qt] * corr + ps;
#pragma unroll
                for (int dt = 0; dt < 2; ++dt)
#pragma unroll
                    for (int i = 0; i < 16; ++i) ot[dt][qt][i] *= corr;
#pragma unroll
                for (int s2 = 0; s2 < 2; ++s2) { v4u pk;
#pragma unroll
                    for (int e = 0; e < 4; ++e) pk[e] = pk2(sc[qt][8 * s2 + 2 * e], sc[qt][8 * s2 + 2 * e + 1]);
                    pf[qt][s2] = __builtin_bit_cast(bf16x8, pk); } }
#pragma unroll
            for (int dt = 0; dt < 2; ++dt)
#pragma unroll
                for (int s2 = 0; s2 < 2; ++s2) { const int kb0 = 32 * ks + 16 * s2, d = 32 * dt + r32;
                    const s16x4 lo = *(const LAS s16x4*)(Vt + d * 260 + kb0 + 4 * hh), hi = *(const LAS s16x4*)(Vt + d * 260 + kb0 + 8 + 4 * hh);
                    const bf16x8 vf = __builtin_shufflevector(lo, hi, 0, 1, 2, 3, 4, 5, 6, 7);
                    if (act[0]) ot[dt][0] = MFMA32(vf, pf[0][s2], ot[dt][0]); if (act[1]) ot[dt][1] = MFMA32(vf, pf[1][s2], ot[dt][1]); }
        }
#pragma unroll
        for (int qt = 0; qt < 2; ++qt) { const float lt = lsum[qt] + __shfl_xor(lsum[qt], 32), inv = 1.0f / lt;
#pragma unroll
            for (int dt = 0; dt < 2; ++dt)
#pragma unroll
                for (int c = 0; c < 4; ++c) { const int d0 = 32 * dt + 8 * c + 4 * hh; v2u o; o.x = pk2(ot[dt][qt][4 * c] * inv, ot[dt][qt][4 * c + 1] * inv); o.y = pk2(ot[dt][qt][4 * c + 2] * inv, ot[dt][qt][4 * c + 3] * inv);
                    *(v2u*)(MIX + mq[qt] * D_ + habs * 64 + d0) = o; } }
    }
}

__device__ __forceinline__ void aprime_phase(const WInfo& W, const bf16* Z, bf16* AP, const float* mu) {
    const int c = 4 * W.lane;
    const f32x4 m4 = *(const f32x4*)(mu + 1536 + c);
#pragma unroll 4
    for (int m = W.gw; m < T_; m += W.NGW) {
        const v2u zc = *(const v2u*)(Z + (size_t)m * NZ + 2304 + c);
        v2u zp = (v2u){0u, 0u}; if ((m & (SEQ - 1)) != 0) zp = *(const v2u*)(Z + (size_t)(m - 1) * NZ + 2304 + c);
        float z[4] = {bflo(zc.x), bfhi(zc.x), bflo(zc.y), bfhi(zc.y)}, p[4] = {bflo(zp.x), bfhi(zp.x), bflo(zp.y), bfhi(zp.y)}, o[4];
#pragma unroll
        for (int j = 0; j < 4; ++j) { const float v = z[j] + (p[j] - z[j]) * m4[j]; o[j] = c < 64 ? tanhf(v) : (c < 128 ? v : 1.0f / (1.0f + __expf(-v))); }
        v2u w; w.x = pk2(o[0], o[1]); w.y = pk2(o[2], o[3]); *(v2u*)(AP + (size_t)m * 256 + c) = w;
    }
}

constexpr int SL_W = 0, SL_R = 2048, SL_BKT = 4096, SL_ARBK = 8192, SL_M1 = 9216, SL_PC = 9728, SLOT_BYTES = 10240;
static_assert(WS_SLOT + (size_t)64 * 256 * SLOT_BYTES <= WS_B0, "slots end below the activation buffers");
#define MFMA16(a, b, c) __builtin_amdgcn_mfma_f32_16x16x32_bf16((a), (b), (c), 0, 0, 0)
__device__ __forceinline__ bf16x8 mk8(v2u lo, v2u hi) { v4u q; q.x = lo.x; q.y = lo.y; q.z = hi.x; q.w = hi.y; return __builtin_bit_cast(bf16x8, q); }
struct S1In { unsigned short zr[17], zk[17], av[16]; float wl[16]; };
__device__ __forceinline__ void s1_load(S1In& o, int unit, int lane, const bf16* Z, const float* WLOG, const bf16* AB) {
    const int c = 255 - (unit >> 6), bh = unit & 63, h = bh & 7, b = bh >> 3, chn = h * 64 + lane; const size_t m0 = (size_t)b * SEQ + c * 16;
    const bf16* zp = Z + (m0 - (c > 0 ? 1 : 0)) * NZ + 768 + chn; o.zr[0] = zp[0]; o.zk[0] = zp[512];
#pragma unroll
    for (int t = 0; t < 16; ++t) { const bf16* zc = Z + (m0 + t) * NZ + 768 + chn; o.zr[1 + t] = zc[0]; o.zk[1 + t] = zc[512]; o.wl[t] = WLOG[(m0 + t) * 512 + chn]; o.av[t] = AB[(m0 + t) * 512 + chn]; }
}
__device__ __forceinline__ void scan_prep_phase(const WInfo& W, LAS unsigned char* lds, const bf16* Z, const float* WLOG, const bf16* AB, unsigned char* slots, float* bonus,
                                                const float* mu, const float* k_k, const float* k_a, const float* r_k) {
    LAS unsigned char* sc = lds + W.wave * 16384;
    LAS bf16* RT = (LAS bf16*)sc; LAS bf16* AT = (LAS bf16*)(sc + 2304); LAS bf16* BT = (LAS bf16*)(sc + 4608); LAS bf16* KT = (LAS bf16*)(sc + 6912);
    LAS bf16* ATT = (LAS bf16*)(sc + 9216);
    LAS float* AAB = (LAS float*)(sc + 11264);
    LAS bf16* M1x = (LAS bf16*)(sc + 11264);
    LAS bf16* TT = (LAS bf16*)(sc + 12288);
    LAS bf16* WW = (LAS bf16*)(sc + 12800);
    LAS bf16* ARx = (LAS bf16*)(sc + 15104);
    const int lane = W.lane, fr = lane & 15, g = lane >> 4;
    S1In cur, nxt;
    if (W.gw < 64 * 256) s1_load(nxt, W.gw, lane, Z, WLOG, AB);
    for (int unit = W.gw; unit < 64 * 256; unit += W.NGW) {
        const int c = 255 - (unit >> 6), bh = unit & 63, h = bh & 7, b = bh >> 3;
        const int chn = h * 64 + lane; const size_t m0 = (size_t)b * SEQ + c * 16;
        unsigned char* slot = slots + (size_t)(bh * 256 + c) * SLOT_BYTES;
        const float mu_r = mu[chn], mu_k = mu[512 + chn], kkc = k_k[chn], kac = k_a[chn], rkc = r_k[chn];
        cur = nxt;
        if (unit + W.NGW < 64 * 256) s1_load(nxt, unit + W.NGW, lane, Z, WLOG, AB);
        float pr = (c > 0) ? bf2f(cur.zr[0]) : 0.f, pk = (c > 0) ? bf2f(cur.zk[0]) : 0.f;
        float lw = 0.f, Pprev = 1.f, bsave = 0.f, Pt = 1.f;
        unsigned apk[8], bpk[8], kpk[8]; float ah = 0.f, bh2 = 0.f, kh = 0.f;
#pragma unroll
        for (int t = 0; t < 16; ++t) {
            const float zr = bf2f(cur.zr[1 + t]), zk = bf2f(cur.zk[1 + t]); const float wl = cur.wl[t], av = bf2f(cur.av[t]);
            const float r = zr + (pr - zr) * mu_r, kz = zk + (pk - zk) * mu_k; pr = zr; pk = zk;
            float kk = kz * kkc; const float nrm = sqrtf(wave_sum_fast(kk * kk)); kk = kk * __builtin_amdgcn_rcpf(fmaxf(nrm, 1e-12f));
            const float k2 = kz * (1.0f + (av - 1.0f) * kac);
            const float bo = wave_sum_fast(r * k2 * rkc); if (lane == t) bsave = bo;
            lw += wl; Pt = __expf(lw); const float iP = __expf(-lw);
            const float rt = r * Pt, kt = k2 * iP, at = -kk * Pprev, bt = kk * av * iP; Pprev = Pt;
            { const unsigned ra = pk2(rt, at), bk = pk2(bt, kt); RT[t * 72 + lane] = (bf16)(ra & 0xffffu); AT[t * 72 + lane] = (bf16)(ra >> 16); BT[t * 72 + lane] = (bf16)(bk & 0xffffu); KT[t * 72 + lane] = (bf16)(bk >> 16); }
            if (t & 1) { apk[t >> 1] = pk2(ah, at); bpk[t >> 1] = pk2(bh2, bt); kpk[t >> 1] = pk2(kh, kt); } else { ah = at; bh2 = bt; kh = kt; }
        }
        *(LAS v4u*)(ATT + lane * 16) = (v4u){apk[0], apk[1], apk[2], apk[3]}; *(LAS v4u*)(ATT + lane * 16 + 8) = (v4u){apk[4], apk[5], apk[6], apk[7]};
#pragma unroll
        for (int gg = 0; gg < 4; ++gg) *(v4u*)(slot + SL_BKT + ((lane >> 4) * 64 + gg * 16 + (lane & 15)) * 16) = (v4u){bpk[2 * gg], bpk[2 * gg + 1], kpk[2 * gg], kpk[2 * gg + 1]};
        *(float*)(slot + SL_PC + lane * 4) = Pt;
        if (lane < 16) bonus[(m0 + lane) * 8 + h] = bsave;
        LDS_WAIT(); asm volatile("" ::: "memory");
        f32x4 Aab = (f32x4){0.f, 0.f, 0.f, 0.f}, Aak = Aab, Arb = Aab, Ark = Aab;
#pragma unroll
        for (int s = 0; s < 2; ++s) { const int o = fr * 72 + 32 * s + 8 * g;
            const bf16x8 af = *(const LAS bf16x8*)(AT + o), rf = *(const LAS bf16x8*)(RT + o), bb = *(const LAS bf16x8*)(BT + o), kb = *(const LAS bf16x8*)(KT + o);
            Aab = MFMA16(af, bb, Aab); Aak = MFMA16(af, kb, Aak); Arb = MFMA16(rf, bb, Arb); Ark = MFMA16(rf, kb, Ark); }
#pragma unroll
        for (int rg = 0; rg < 4; ++rg) { const int t = 4 * g + rg; const bool lo = fr < t, le = fr <= t;
            Aab[rg] = lo ? Aab[rg] : 0.f; Aak[rg] = lo ? Aak[rg] : 0.f; Arb[rg] = le ? Arb[rg] : 0.f; Ark[rg] = le ? Ark[rg] : 0.f;
            AAB[t * 16 + fr] = Aab[rg]; { const unsigned rk = pk2(Arb[rg], Ark[rg]); ARx[t * 16 + fr] = (bf16)(rk & 0xffffu); ARx[256 + t * 16 + fr] = (bf16)(rk >> 16); } }
        LDS_WAIT(); asm volatile("" ::: "memory");
        float Tc[16];
#pragma unroll
        for (int t = 0; t < 16; ++t) { float acc = (t == fr) ? 1.f : 0.f;
#pragma unroll
            for (int q4 = 0; q4 < (t + 3) / 4; ++q4) { const f32x4 a4 = *(const LAS f32x4*)(AAB + t * 16 + 4 * q4);
#pragma unroll
                for (int e = 0; e < 4; ++e) if (4 * q4 + e < t) acc += a4[e] * Tc[4 * q4 + e]; }
            Tc[t] = acc; }
#pragma unroll
        for (int t = 0; t < 16; t += 2) { const unsigned tt = pk2(Tc[t], Tc[t + 1]); TT[t * 16 + fr] = (bf16)(tt & 0xffffu); TT[(t + 1) * 16 + fr] = (bf16)(tt >> 16); }
        LDS_WAIT(); asm volatile("" ::: "memory");
        const v2u z2 = (v2u){0u, 0u};
        const bf16x8 Tf = mk8(*(const LAS v2u*)(TT + fr * 16 + 4 * g), z2);
        { v2u ak; ak.x = pk2(Aak[0], Aak[1]); ak.y = pk2(Aak[2], Aak[3]);
          const f32x4 M1 = MFMA16(Tf, mk8(ak, z2), ((f32x4){0.f, 0.f, 0.f, 0.f}));
          f32x4 Wt[4];
#pragma unroll
          for (int jt = 0; jt < 4; ++jt) Wt[jt] = MFMA16(Tf, mk8(*(const LAS v2u*)(ATT + (16 * jt + fr) * 16 + 4 * g), z2), ((f32x4){0.f, 0.f, 0.f, 0.f}));
#pragma unroll
          for (int rg = 0; rg < 4; ++rg) { const int t = 4 * g + rg; const unsigned w01 = pk2(Wt[0][rg], Wt[1][rg]), w23 = pk2(Wt[2][rg], Wt[3][rg]), m1 = pk2(M1[rg], 0.f); M1x[t * 16 + fr] = (bf16)(m1 & 0xffffu);
              WW[t * 72 + fr] = (bf16)(w01 & 0xffffu); WW[t * 72 + 16 + fr] = (bf16)(w01 >> 16); WW[t * 72 + 32 + fr] = (bf16)(w23 & 0xffffu); WW[t * 72 + 48 + fr] = (bf16)(w23 >> 16); } }
        LDS_WAIT(); asm volatile("" ::: "memory");
#pragma unroll
        for (int s = 0; s < 2; ++s) { const int o = fr * 72 + 32 * s + 4 * g;
            const v2u w0 = *(const LAS v2u*)(WW + o), w1 = *(const LAS v2u*)(WW + o + 16), r0 = *(const LAS v2u*)(RT + o), r1 = *(const LAS v2u*)(RT + o + 16);
            *(v4u*)(slot + SL_W + (s * 64 + lane) * 16) = (v4u){w0.x, w0.y, w1.x, w1.y}; *(v4u*)(slot + SL_R + (s * 64 + lane) * 16) = (v4u){r0.x, r0.y, r1.x, r1.y}; }
        { const v2u x0 = *(const LAS v2u*)(ARx + fr * 16 + 4 * g), x1 = *(const LAS v2u*)(ARx + 256 + fr * 16 + 4 * g), m1 = *(const LAS v2u*)(M1x + fr * 16 + 4 * g);
          *(v4u*)(slot + SL_ARBK + lane * 16) = (v4u){x0.x, x0.y, x1.x, x1.y}; *(v2u*)(slot + SL_M1 + lane * 8) = m1; }
        LDS_WAIT(); asm volatile("" ::: "memory");
    }
}
__device__ __forceinline__ void glds16(const void* gsrc, unsigned lds_dst) { unsigned keep;
    asm volatile("s_mov_b32 %0, m0\n\ts_mov_b32 m0, %2\n\ts_nop 0\n\tglobal_load_lds_dwordx4 %1, off\n\ts_mov_b32 m0, %0" : "=&s"(keep) : "v"(gsrc), "s"(lds_dst) : "memory"); }
struct ScanOps { bf16x8 Wf[2], Rf[2], Bk[4], ARBK; v2u M1; f32x4 PC[4]; unsigned vz[5]; unsigned pad; };
constexpr int S2_NS = 12, S2_D = 11, S2_VST = 2048;
__device__ __forceinline__ void scan_lds_load(ScanOps& o, const LAS unsigned char* st, const LAS unsigned char* vs, const LAS unsigned char* vprev, int lane, int g, int icol) {
#pragma unroll
    for (int s = 0; s < 2; ++s) { o.Wf[s] = *(const LAS bf16x8*)(st + SL_W + (s * 64 + lane) * 16); o.Rf[s] = *(const LAS bf16x8*)(st + SL_R + (s * 64 + lane) * 16); }
#pragma unroll
    for (int jt = 0; jt < 4; ++jt) { o.Bk[jt] = *(const LAS bf16x8*)(st + SL_BKT + (jt * 64 + lane) * 16); o.PC[jt] = *(const LAS f32x4*)(st + SL_PC + (16 * jt + 4 * g) * 4); }
    o.ARBK = *(const LAS bf16x8*)(st + SL_ARBK + lane * 16); o.M1 = *(const LAS v2u*)(st + SL_M1 + lane * 8);
    o.vz[0] = (unsigned)*(const LAS unsigned short*)((g == 0 ? vprev + 15 * 128 : vs + (4 * g - 1) * 128) + icol * 2);
#pragma unroll
    for (int j = 0; j < 4; ++j) o.vz[1 + j] = (unsigned)*(const LAS unsigned short*)(vs + (4 * g + j) * 128 + icol * 2);
    o.pad = 0u;
}
__device__ __forceinline__ void scan_issue(int cc, int lw, int lane, const unsigned char* sbase, const bf16* zvh, LAS unsigned char* ring, LAS unsigned char* vring) {
    const unsigned char* slot = sbase + (size_t)cc * SLOT_BYTES; LAS unsigned char* st = ring + (cc % S2_NS) * 10240; LAS unsigned char* vs = vring + (cc % S2_NS) * S2_VST;
#pragma unroll
    for (int k = 0; k < 3; ++k) { const int p = lw + 4 * k; if (p < 10) glds16(slot + p * 1024 + lane * 16, (unsigned)(size_t)(st + p * 1024)); }
    if (lw >= 2) { const int blk = lw - 2; const int r = cc * 16 + blk * 8 + (lane >> 3);
        glds16((const unsigned char*)(zvh + (size_t)r * NZ) + (lane & 7) * 16, (unsigned)(size_t)(vs + blk * 1024)); }
}
__device__ __forceinline__ void scan_seq_phase(const WInfo& W, LAS unsigned char* lds, const bf16* Z, const unsigned char* slots, float* YRAW, const float* mu) {
    const int id = blockIdx.x; if (id >= 64) return;
    const int lane = W.lane, fr = lane & 15, g = lane >> 4, w = W.wave;
    const int b = id >> 3, h = id & 7;
    LAS unsigned char* ring = lds; LAS unsigned char* vring = lds + S2_NS * 10240;
    const unsigned char* sbase = slots + (size_t)id * 256 * SLOT_BYTES;
    const bf16* zvh = Z + (size_t)b * SEQ * NZ + 1792 + h * 64;
    const bool loader = w >= 4; const int lw = w - 4;
    const int i = 16 * (w & 3) + fr;
    float mu_v = mu[1024 + h * 64 + i];
    VM_WAIT(); asm volatile("" : "+v"(mu_v));
    float* yb = YRAW + (size_t)b * SEQ * 512 + h * 64 + i;
#define S2_WAIT_AHEAD() asm volatile("s_waitcnt vmcnt(27)" ::: "memory")
    if (loader) { for (int cc = 0; cc < S2_D; ++cc) scan_issue(cc, lw, lane, sbase, zvh, ring, vring); S2_WAIT_AHEAD(); }
    __builtin_amdgcn_s_barrier();
    f32x4 st[4];
#pragma unroll
    for (int jt = 0; jt < 4; ++jt) st[jt] = (f32x4){0.f, 0.f, 0.f, 0.f};
    if (loader) {
        for (int c = 0; c < 256; ++c) {
            if (c + S2_D < 256) { scan_issue(c + S2_D, lw, lane, sbase, zvh, ring, vring); S2_WAIT_AHEAD(); } else asm volatile("s_waitcnt vmcnt(0)" ::: "memory");
            __builtin_amdgcn_s_barrier();
        }
    } else {
        ScanOps opA, opB;
        scan_lds_load(opA, ring, vring, vring, lane, g, i);
        LAS float* ybuf = (LAS float*)(lds + 147456);
        float* yo = YRAW + (size_t)b * SEQ * 512 + h * 64 + (size_t)(4 * w + g) * 512 + 4 * fr;
#define S2_STEP(c, CUR, NXT) do { \
            if ((c) + 1 < 256) scan_lds_load(NXT, ring + (((c) + 1) % S2_NS) * 10240, vring + (((c) + 1) % S2_NS) * S2_VST, vring + ((c) % S2_NS) * S2_VST, lane, g, i); \
            float vm[4]; const float zprev = ((c) == 0 && g == 0) ? 0.f : bf2f((unsigned short)CUR.vz[0]); \
            _Pragma("unroll") for (int j = 0; j < 4; ++j) { const float zc = bf2f((unsigned short)CUR.vz[1 + j]), zp = (j == 0) ? zprev : bf2f((unsigned short)CUR.vz[j]); vm[j] = zc + (zp - zc) * mu_v; } \
            v2u vb; vb.x = pk2(vm[0], vm[1]); vb.y = pk2(vm[2], vm[3]); const v2u z2 = (v2u){0u, 0u}; bf16x8 Sb[2]; \
            _Pragma("unroll") for (int s = 0; s < 2; ++s) { v2u lo, hi; lo.x = pk2(st[2 * s][0], st[2 * s][1]); lo.y = pk2(st[2 * s][2], st[2 * s][3]); hi.x = pk2(st[2 * s + 1][0], st[2 * s + 1][1]); hi.y = pk2(st[2 * s + 1][2], st[2 * s + 1][3]); Sb[s] = mk8(lo, hi); } \
            f32x4 U = MFMA16(CUR.Wf[0], Sb[0], ((f32x4){0.f, 0.f, 0.f, 0.f})); U = MFMA16(CUR.Wf[1], Sb[1], U); U = MFMA16(mk8(CUR.M1, z2), mk8(vb, z2), U); \
            f32x4 Y = MFMA16(CUR.Rf[0], Sb[0], ((f32x4){0.f, 0.f, 0.f, 0.f})); Y = MFMA16(CUR.Rf[1], Sb[1], Y); \
            v2u ub; ub.x = pk2(U[0], U[1]); ub.y = pk2(U[2], U[3]); const bf16x8 UV = mk8(ub, vb); \
            Y = MFMA16(CUR.ARBK, UV, Y); \
            _Pragma("unroll") for (int jt = 0; jt < 4; ++jt) { const f32x4 a = MFMA16(CUR.Bk[jt], UV, st[jt]); st[jt] = a * CUR.PC[jt]; } \
            if ((c) > 0) { const f32x4 yv = *(const LAS f32x4*)(ybuf + (((c) - 1) & 1) * 1024 + (4 * w + g) * 64 + 4 * fr); *(f32x4*)(yo + (size_t)(((c) - 1) * 16) * 512) = yv; } \
            _Pragma("unroll") for (int rg = 0; rg < 4; ++rg) ybuf[((c) & 1) * 1024 + (4 * g + rg) * 64 + i] = Y[rg]; \
            LDS_WAIT(); \
            __builtin_amdgcn_s_barrier(); } while (0)
        for (int c = 0; c < 256; c += 2) { S2_STEP(c, opA, opB); S2_STEP(c + 1, opB, opA); }
#undef S2_STEP
        { const f32x4 yv = *(const LAS f32x4*)(ybuf + 1024 + (4 * w + g) * 64 + 4 * fr); *(f32x4*)(yo + (size_t)(255 * 16) * 512) = yv; }
    }
    VM_WAIT();
    __builtin_amdgcn_s_barrier();
#undef S2_WAIT_AHEAD
}

__device__ __forceinline__ float sum8(float x) { x += dpp_mov<0xB1>(x); x += dpp_mov<0x4E>(x); x += dpp_mov<0x141>(x); return x; }
__device__ __forceinline__ void post_phase(const WInfo& W, const bf16* Z, const bf16* GBUF, const float* YRAW, const float* bonus, bf16* MIX,
                                           const float* mu, const float* gn_g, const float* gn_b) {
    const int lane = W.lane, c0 = 8 * lane, h = lane >> 3;
    float muv[8], gg[8], gb[8];
#pragma unroll
    for (int j = 0; j < 8; ++j) { muv[j] = mu[1024 + c0 + j]; gg[j] = gn_g[c0 + j]; gb[j] = gn_b[c0 + j]; }
#pragma unroll 2
    for (int m = W.gw; m < T_; m += W.NGW) {
        const bool first = (m & (SEQ - 1)) == 0;
        const v4u zc = *(const v4u*)(Z + (size_t)m * NZ + 1792 + c0);
        v4u zp = (v4u){0u, 0u, 0u, 0u}; if (!first) zp = *(const v4u*)(Z + (size_t)(m - 1) * NZ + 1792 + c0);
        const v4u gq = *(const v4u*)(GBUF + (size_t)m * 512 + c0);
        const f32x4 y0 = *(const f32x4*)(YRAW + (size_t)m * 512 + c0), y1 = *(const f32x4*)(YRAW + (size_t)m * 512 + c0 + 4);
        const float bo = bonus[(size_t)m * 8 + h];
        float y[8] = {y0[0], y0[1], y0[2], y0[3], y1[0], y1[1], y1[2], y1[3]};
        float s = 0.f;
#pragma unroll
        for (int j = 0; j < 8; ++j) s += y[j];
        const float mean = sum8(s) * (1.0f / 64.0f); float q = 0.f;
#pragma unroll
        for (int j = 0; j < 8; ++j) { y[j] -= mean; q += y[j] * y[j]; }
        const float rstd = rsqrtf(sum8(q) * (1.0f / 64.0f) + GN_EPS);
        float o[8];
#pragma unroll
        for (int j = 0; j < 8; ++j) { const unsigned zw = zc[j >> 1], pw = zp[j >> 1], gw2 = gq[j >> 1];
            const float zv = (j & 1) ? bfhi(zw) : bflo(zw), pv = (j & 1) ? bfhi(pw) : bflo(pw), gv = (j & 1) ? bfhi(gw2) : bflo(gw2);
            const float v = zv + (pv - zv) * muv[j];
            o[j] = (y[j] * rstd * gg[j] + gb[j] + bo * v) * gv; }
        v4u ov; ov.x = pk2(o[0], o[1]); ov.y = pk2(o[2], o[3]); ov.z = pk2(o[4], o[5]); ov.w = pk2(o[6], o[7]);
        *(v4u*)(MIX + (size_t)m * D_ + 512 + c0) = ov;
    }
}

__device__ __forceinline__ void ln_compute(f32x4 (&v)[4], const f32x4 (&g)[4], const f32x4 (&bb)[4]) {
    float s = 0.f;
#pragma unroll
    for (int j = 0; j < 4; ++j) s += (v[j][0] + v[j][1]) + (v[j][2] + v[j][3]);
    const float mean = wave_sum_fast(s) * (1.f / D_); float s2 = 0.f;
#pragma unroll
    for (int j = 0; j < 4; ++j) { v[j] = v[j] - mean; s2 += (v[j][0] * v[j][0] + v[j][1] * v[j][1]) + (v[j][2] * v[j][2] + v[j][3] * v[j][3]); }
    const float rstd = rsqrtf(wave_sum_fast(s2) * (1.f / D_) + LN_EPS);
#pragma unroll
    for (int j = 0; j < 4; ++j) v[j] = v[j] * rstd * g[j] + bb[j];
}
__device__ __forceinline__ void ln_phase(const WInfo& W, float* X, bf16* XB, const float* gam, const float* bet, const bf16* ADD = nullptr) {
    f32x4 g[4], bb[4];
#pragma unroll
    for (int j = 0; j < 4; ++j) { g[j] = *(const f32x4*)(gam + 4 * W.lane + 256 * j); bb[j] = *(const f32x4*)(bet + 4 * W.lane + 256 * j); }
    for (int m = W.gw; m < T_; m += W.NGW) {
        f32x4* xr = (f32x4*)(X + (size_t)m * D_) + W.lane; f32x4 v[4];
#pragma unroll
        for (int j = 0; j < 4; ++j) v[j] = xr[64 * j];
        if (ADD) { const v2u* ar = (const v2u*)(ADD + (size_t)m * D_) + W.lane;
#pragma unroll
            for (int j = 0; j < 4; ++j) { const v2u a = ar[64 * j]; v[j][0] += bflo(a.x); v[j][1] += bfhi(a.x); v[j][2] += bflo(a.y); v[j][3] += bfhi(a.y); } }
        ln_compute(v, g, bb);
#pragma unroll
        for (int j = 0; j < 4; ++j) xr[64 * j] = v[j];
        if (XB) { v2u* o8 = (v2u*)(XB + (size_t)m * D_) + W.lane;
#pragma unroll
            for (int j = 0; j < 4; ++j) { v2u o; o.x = pk2(v[j][0], v[j][1]); o.y = pk2(v[j][2], v[j][3]); o8[64 * j] = o; } }
    }
}
__device__ __forceinline__ void ln_router_phase(const WInfo& W, LAS unsigned char* lds, float* X, bf16* XB, const float* gam, const float* bet, const float* rw, int* toke, float* tokp, int* wgcnt) {
    LAS float* RW = (LAS float*)lds;
    LAS int* CNT = (LAS int*)(lds + 32768);
    for (int i = W.tid; i < 8192; i += 512) RW[i] = rw[i];
    if (W.tid < 16) CNT[W.tid] = 0;
    __syncthreads();
    f32x4 g[4], bb[4];
#pragma unroll
    for (int j = 0; j < 4; ++j) { g[j] = *(const f32x4*)(gam + 4 * W.lane + 256 * j); bb[j] = *(const f32x4*)(bet + 4 * W.lane + 256 * j); }
    for (int wg = blockIdx.x; wg < 256; wg += W.G) {
        for (int i = 0; i < 16; ++i) {
            const int m = wg * 128 + W.wave * 16 + i;
            f32x4* xr = (f32x4*)(X + (size_t)m * D_) + W.lane; f32x4 v[4];
#pragma unroll
            for (int j = 0; j < 4; ++j) v[j] = xr[64 * j];
            ln_compute(v, g, bb);
#pragma unroll
            for (int j = 0; j < 4; ++j) xr[64 * j] = v[j];
            { unsigned* o4 = (unsigned*)((unsigned char*)XB + (size_t)m * D_) + W.lane;
#pragma unroll
              for (int j = 0; j < 4; ++j) o4[64 * j] = pg8::pk4_fp8(v[j][0], v[j][1], v[j][2], v[j][3]); }
            float lg[8];
#pragma unroll
            for (int e = 0; e < 8; ++e) lg[e] = 0.f;
#pragma unroll
            for (int j = 0; j < 4; ++j)
#pragma unroll
                for (int jj = 0; jj < 4; ++jj) { const int c = 4 * W.lane + 256 * j + jj; const f32x4 r0 = *(const LAS f32x4*)(RW + c * 8), r1 = *(const LAS f32x4*)(RW + c * 8 + 4); const float x = v[j][jj];
                    lg[0] += x * r0[0]; lg[1] += x * r0[1]; lg[2] += x * r0[2]; lg[3] += x * r0[3]; lg[4] += x * r1[0]; lg[5] += x * r1[1]; lg[6] += x * r1[2]; lg[7] += x * r1[3]; }
#pragma unroll
            for (int e = 0; e < 8; ++e) lg[e] = wave_sum_fast(lg[e]);
            int e1 = 0; float v1 = lg[0];
#pragma unroll
            for (int e = 1; e < 8; ++e) if (lg[e] > v1) { v1 = lg[e]; e1 = e; }
            int e2 = -1; float v2 = -3.0e38f;
#pragma unroll
            for (int e = 0; e < 8; ++e) if (e != e1 && lg[e] > v2) { v2 = lg[e]; e2 = e; }
            const float p2 = 1.0f / (1.0f + __expf(v1 - v2)), p1 = 1.0f - p2;
            if (W.lane == 0) { toke[m] = e1 | (e2 << 8); tokp[2 * m] = p1; tokp[2 * m + 1] = p2; atomicAdd((int*)(CNT + e1), 1); atomicAdd((int*)(CNT + 8 + e2), 1); }
        }
        __syncthreads();
        if (W.tid < 16) { wgcnt[wg * 16 + W.tid] = CNT[W.tid]; CNT[W.tid] = 0; }
        __syncthreads();
    }
}
__device__ __forceinline__ void route_phase(const WInfo& W, LAS unsigned char* lds, const int* toke, const int* wgcnt, int* perm, int* ptab) {
    LAS int* C = (LAS int*)lds;
    LAS int* TOT = (LAS int*)(lds + 16384);
    LAS int* PRE = TOT + 16;
    LAS int* OFF = TOT + 32;
    LAS int* CTR = TOT + 48;
    for (int wg = blockIdx.x; wg < 256; wg += W.G) {
        __syncthreads();
        for (int i = W.tid; i < 4096; i += 512) C[i] = wgcnt[i];
        if (W.tid < 16) CTR[W.tid] = 0;
        __syncthreads();
        if (W.tid < 16) { int tot = 0, pre = 0; for (int k = 0; k < 256; ++k) { const int c = C[k * 16 + W.tid]; tot += c; if (k < wg) pre += c; } TOT[W.tid] = tot; PRE[W.tid] = pre; }
        __syncthreads();
        if (W.tid == 0) { int cnt = 0, npass[2];
            for (int p = 0; p < 2; ++p) { int base = 0, np = 0;
                for (int e = 0; e < 8; ++e) { OFF[p * 8 + e] = p * PERMLEN + base + PRE[p * 8 + e]; const int pn = (TOT[p * 8 + e] + 255) >> 8;
                    if (wg == 0) for (int k = 0; k < pn; ++k) ptab[2 + cnt + k] = ((p * MAXPANEL + np + k) << 8) | e;
                    cnt += pn; np += pn; base += pn * 256; }
                npass[p] = np; }
            if (wg == 0) { ptab[0] = npass[0]; ptab[1] = npass[1]; } }
        __syncthreads();
        if (W.tid < 128) { const int m = wg * 128 + W.tid, te = toke[m], e1 = te & 255, e2 = te >> 8;
            const int s1 = OFF[e1] + atomicAdd((int*)(CTR + e1), 1); perm[s1] = m;
            const int s2 = OFF[8 + e2] + atomicAdd((int*)(CTR + 8 + e2), 1); perm[s2] = m; }
    }
}
__device__ __forceinline__ void conv_phase(const WInfo& W, const bf16* GB, const bf16* UP, bf16* CV, const float* cw) {
    const size_t gtid = (size_t)W.gw * 64 + W.lane, NT = (size_t)W.NGW * 64;
#pragma unroll 4
    for (size_t i = gtid; i < (size_t)T_ * D_ / 8; i += NT) {
        const int m = (int)(i >> 7), c = (int)(i & 127) * 8, t = m & (SEQ - 1);
        const v4u gv = *(const v4u*)(GB + (size_t)m * D_ + c), u2 = *(const v4u*)(UP + (size_t)m * D_ + c);
        v4u u1 = (v4u){0u, 0u, 0u, 0u}, u0 = (v4u){0u, 0u, 0u, 0u};
        if (t >= 1) u1 = *(const v4u*)(UP + (size_t)(m - 1) * D_ + c);
        if (t >= 2) u0 = *(const v4u*)(UP + (size_t)(m - 2) * D_ + c);
        float o[8];
#pragma unroll
        for (int e = 0; e < 4; ++e) {
            const f32x2 w0 = *(const f32x2*)(cw + c + 2 * e), w1 = *(const f32x2*)(cw + 1024 + c + 2 * e), w2 = *(const f32x2*)(cw + 2048 + c + 2 * e);
            o[2 * e] = bflo(gv[e]) * (bflo(u0[e]) * w0[0] + bflo(u1[e]) * w1[0] + bflo(u2[e]) * w2[0]);
            o[2 * e + 1] = bfhi(gv[e]) * (bfhi(u0[e]) * w0[1] + bfhi(u1[e]) * w1[1] + bfhi(u2[e]) * w2[1]); }
        v4u ov; ov.x = pk2(o[0], o[1]); ov.y = pk2(o[2], o[3]); ov.z = pk2(o[4], o[5]); ov.w = pk2(o[6], o[7]);
        *(v4u*)(CV + (size_t)m * D_ + c) = ov;
    }
}

constexpr int NPHASE = 18;
#ifndef PH_STOP
#define PH_STOP NPHASE
#endif
struct Args { const float* in[34]; float* out; unsigned char* ws; int ph_lo, ph_hi; };
__global__ void __launch_bounds__(512, 2) mk_fwd(Args args) {
    extern __shared__ __attribute__((aligned(16))) unsigned char lds_raw[];
    LAS unsigned char* lds = (LAS unsigned char*)lds_raw;
    WInfo W; W.tid = threadIdx.x; W.lane = W.tid & 63; W.wave = __builtin_amdgcn_readfirstlane(W.tid >> 6);
    W.G = gridDim.x; { const int bx = blockIdx.x; W.vcu = (W.G % 8 == 0) ? (bx % 8) * (W.G / 8) + bx / 8 : bx; }
    W.gw = W.vcu * 8 + W.wave; W.NGW = W.G * 8;
    unsigned char* ws = args.ws; float* out = args.out; const float* const* in = args.in;
    unsigned* ctl = (unsigned*)(ws + WS_CTL);
    volatile LAS unsigned* MISC = (volatile LAS unsigned*)(lds + MISC_OFF);
    for (int u = W.tid; u < 128; u += 512) ((LAS unsigned*)(lds + LDSCTL_OFF))[u] = 0u;
    __syncthreads();
    XcdBarrier bar; bar.bar = ctl + CW_BAR; bar.x = 0; bar.st = nullptr;
    if (MK_N_LAUNCHES == 1) bar = xcd_barrier_post(ctl + CW_BAR, MISC + 8);
    const int lo = args.ph_lo, hi = args.ph_hi;
#ifndef PH_MASK
#define PH_MASK 0x3ffff
#endif
#define IN(k) (((PH_MASK >> (k)) & 1) && lo <= (k) && (k) < hi)
#define SEAM(k) do { if (IN(k) && IN((k) + 1)) xcd_barrier(bar); } while (0)
    bf16* const B0 = (bf16*)(ws + WS_B0); bf16* const Zb = (bf16*)(ws + WS_B1); bf16* const ACT = (bf16*)(ws + WS_ACT); bf16* const CV = (bf16*)(ws + WS_CV);
    bf16* const AP = (bf16*)(ws + WS_AP); float* const YRAW = (float*)(ws + WS_YRAW); bf16* const ACTM = (bf16*)(ws + WS_ACTM);
    float* const WLOG = out; bf16* const ABUF = (bf16*)(out + (size_t)T_ * 512); bf16* const GBUF = ABUF + (size_t)T_ * 512;
    int* const toke = (int*)(ws + WS_TOKE); float* const tokp = (float*)(ws + WS_TOKP); int* const wgcnt = (int*)(ws + WS_WGCNT); int* const ptabg = (int*)(ws + WS_PTAB); int* const perm = (int*)(ws + WS_PERM);
    const int cblk = (int)blockIdx.x;

#ifdef DUMP_OFF
    if (lo == 100) { const bf16* s = (const bf16*)(ws + (size_t)(DUMP_OFF) * MiB);
        for (size_t i = (size_t)W.gw * 64 + W.lane; i < (size_t)T_ * D_; i += (size_t)W.NGW * 64) { const size_t m = i >> 10, c = i & 1023; out[i] = (c < DUMP_W) ? bf2f(s[m * DUMP_LD + DUMP_COL + c]) : 0.f; } return; }
#endif
    if (IN(0)) { p0_prologue(W, lds, in, ws); } SEAM(0);
    if (IN(1)) { pg8::DenseSched S{T_ / 256, NZ / 256, W.G, cblk, 1024, (const bf16*)(ws + WS_WIN0)}; pg8::EpiBf16 E{Zb, NZ}; pg8::gemm_phase(lds, B0, 1024, S, E); } SEAM(1);
    if (IN(2)) { aprime_phase(W, Zb, AP, in[4]); } SEAM(2);
    if (IN(3)) { const int KL = 256 + (hi >> 20); pg8::DenseSched S{T_ / 256, 6, W.G, cblk, KL, (const bf16*)(ws + WS_WLORA)}; pg8::EpiLora E{WLOG, ABUF, GBUF, in[5], in[7]}; pg8::gemm_phase(lds, AP, KL, S, E); } SEAM(3);
    if (IN(4)) { scan_prep_phase(W, lds, Zb, WLOG, ABUF, ws + WS_SLOT, (float*)(ws + WS_BONUS), in[4], in[10], in[11], in[12]); } SEAM(4);
    if (IN(5)) { if (blockIdx.x < 64) scan_seq_phase(W, lds, Zb, ws + WS_SLOT, YRAW, in[4]); attn_phase(W, lds, Zb, B0, in[3], in[1], ctl + 2048); deferred_work(W, lds, in, ws, ctl + 2112); } SEAM(5);
    if (IN(6)) { post_phase(W, Zb, GBUF, YRAW, (const float*)(ws + WS_BONUS), B0, in[4], in[13], in[14]); p0_weights(W, lds, in, ws, 0, NITEMS_MOE); } SEAM(6);
    float* const STP1 = (float*)(ws + WS_STP1); float* const STP2 = (float*)(ws + WS_STP2); const float* const SV = (const float*)(ws + WS_LNV); const float* const CVv = SV + 8704;
    LAS float* const PST = (LAS float*)(lds + PST_OFF); LAS float* const TBL = (LAS float*)(lds + STAT_OFF);
#define STAT_TABLE(S, stp) do { __syncthreads(); if (W.tid < 256) { f32x4 _a[11], _b[11]; int _n = 0; \
        _Pragma("unroll") for (int i = 0; i < 11; ++i) { pg8::Unit uu; if ((S).next(i, uu)) { _n = i + 1; const float* _p = (stp) + (size_t)(uu.pm * 256 + W.tid) * 8; _a[i] = *(const f32x4*)_p; _b[i] = *(const f32x4*)(_p + 4); } else { _a[i] = (f32x4){0.f, 0.f, 0.f, 0.f}; _b[i] = _a[i]; } } \
        _Pragma("unroll") for (int i = 0; i < 11; ++i) if (i < _n) { const float s = ((_a[i][0] + _a[i][2]) + _b[i][0]) + _b[i][2], q = ((_a[i][1] + _a[i][3]) + _b[i][1]) + _b[i][3]; const float mu = s * (1.0f / 1024.0f); \
            TBL[(i * 256 + W.tid) * 2] = mu; TBL[(i * 256 + W.tid) * 2 + 1] = rsqrtf(fmaxf(q * (1.0f / 1024.0f) - mu * mu, 0.f) + LN_EPS); } } __syncthreads(); } while (0)
    if (IN(7)) { pg8::DenseSched S{T_ / 256, 4, W.G, cblk, 1024, (const bf16*)(ws + WS_WOUT0)}; pg8::EpiResStats E{in[0], out, Zb, STP1, PST, TBL, nullptr, nullptr, nullptr}; pg8::gemm_phase(lds, B0, 1024, S, E); } SEAM(7);
    if (IN(8)) { pg8::DenseSched S{T_ / 256, 22, W.G, cblk, 1024, (const bf16*)(ws + WS_WFGU)}; STAT_TABLE(S, STP1); pg8::EpiSwigluLN E{ACT, FF, TBL, SV, CVv}; pg8::gemm_phase(lds, Zb, 1024, S, E); } SEAM(8);
    if (IN(9)) { pg8::DenseSched S{T_ / 256, 4, W.G, cblk, FF, (const bf16*)(ws + WS_WFD)}; STAT_TABLE(S, STP1); pg8::EpiResStats E{out, out, B0, STP2, PST, TBL, STP1, in[16], in[17]}; pg8::gemm_phase(lds, ACT, FF, S, E); } SEAM(9);
    if (IN(10)) { pg8::DenseSched S{T_ / 256, 12, W.G, cblk, 1024, (const bf16*)(ws + WS_WIN1)}; STAT_TABLE(S, STP2); pg8::EpiL1inLN E{Zb, ACT, TBL, SV + 5632, CVv + 5632}; pg8::gemm_phase(lds, B0, 1024, S, E); } SEAM(10);
    if (IN(11)) { conv_phase(W, Zb, ACT, CV, in[24]); } SEAM(11);
    if (IN(12)) { pg8::DenseSched S{T_ / 256, 4, W.G, cblk, 1024, (const bf16*)(ws + WS_WOUT1)}; STAT_TABLE(S, STP2); pg8::EpiResStats E{out, out, nullptr, nullptr, PST, TBL, STP2, in[21], in[22]}; pg8::gemm_phase(lds, CV, 1024, S, E); } SEAM(12);
    if (IN(13)) { ln_router_phase(W, lds, out, B0, in[26], in[27], in[28], toke, tokp, wgcnt); } SEAM(13);
    if (IN(14)) { route_phase(W, lds, toke, wgcnt, perm, ptabg); } SEAM(14);
#define MOE_TABLES() do { LAS int* ptl = (LAS int*)(lds + PTAB_OFF); __syncthreads(); if (W.tid < 280) ptl[W.tid] = ptabg[W.tid]; __syncthreads(); } while (0)
    if (IN(15)) { MOE_TABLES(); LAS int* ptl = (LAS int*)(lds + PTAB_OFF); LAS unsigned short* rtl = (LAS unsigned short*)(lds + RTAB_OFF);
        pg8::MoeUpSched S{ptl[0] + ptl[1], W.G, cblk, ws + WS_WMGU, ptl, rtl};
        for (int i = 0; i < 32; ++i) { pg8::Unit uu; if (!S.next(i, uu)) break; if (W.tid < 256) { const int r = perm[uu.pm * 256 + W.tid]; rtl[i * 256 + W.tid] = (unsigned short)(r < 0 ? 0 : r); } }
        __syncthreads(); pg8::EpiSwiglu8 E{(unsigned char*)ACTM, FFE}; pg8::gemm_phase<pg8::EpiSwiglu8, pg8::MoeUpSched, true>(lds, B0, 512 + (hi >> 20), S, E); } SEAM(15);
    if (IN(16)) { MOE_TABLES(); LAS int* ptl = (LAS int*)(lds + PTAB_OFF);
        pg8::MoeDownSched S{ptl[0] + ptl[1], 0, W.G, cblk, ws + WS_WMD, ptl}; pg8::EpiMoeDown E{out, (bf16*)(ws + WS_Y2), perm, tokp}; pg8::gemm_phase<pg8::EpiMoeDown, pg8::MoeDownSched, true>(lds, ACTM, FFE / 2 + (hi >> 20), S, E); } SEAM(16);
    if (IN(17)) { ln_phase(W, out, nullptr, in[32], in[33], (const bf16*)(ws + WS_Y2)); }
#undef IN
#undef SEAM
}

extern "C" void kernel_launch(void* const* d_in, const int* in_sizes, int n_in, void* d_out, int out_size, void* d_ws, size_t ws_size, hipStream_t stream) {
    static int grid = 0;
    if (grid == 0) {
        if (n_in != 34 || out_size != T_ * D_ || ws_size < WS_END) { fprintf(stderr, "kernel_launch: unexpected problem (n_in %d, out %d, ws %zu)\n", n_in, out_size, ws_size); grid = -1; return; }
        int dev = 0, cus = 0, per_cu = 0;
        if (hipGetDevice(&dev) != hipSuccess || hipDeviceGetAttribute(&cus, hipDeviceAttributeMultiprocessorCount, dev) != hipSuccess) { grid = -1; return; }
        if (hipFuncSetAttribute((const void*)mk_fwd, hipFuncAttributeMaxDynamicSharedMemorySize, LDS_BYTES) != hipSuccess) { fprintf(stderr, "kernel_launch: hipFuncSetAttribute failed\n"); grid = -1; return; }
        if (hipOccupancyMaxActiveBlocksPerMultiprocessor(&per_cu, (const void*)mk_fwd, 512, LDS_BYTES) != hipSuccess || per_cu < 1) fprintf(stderr, "kernel_launch: occupancy query reports %d\n", per_cu);
        (void)hipGetLastError();
        grid = cus;
        if (grid != 256) { fprintf(stderr, "kernel_launch: built for 256 CUs, got %d\n", grid); grid = -1; return; }
    }
    if (grid < 0) return;
    (void)hipMemsetAsync((char*)d_ws + WS_CTL, 0, CTL_ZERO_BYTES, stream);
    Args a{};
    for (int i = 0; i < 34; ++i) a.in[i] = (const float*)d_in[i];
    a.out = (float*)d_out; a.ws = (unsigned char*)d_ws;
    if (MK_N_LAUNCHES == 1) { a.ph_lo = 0; a.ph_hi = NPHASE; hipLaunchKernelGGL(mk_fwd, dim3(grid), dim3(512), LDS_BYTES, stream, a); }
    else { for (int p = 0; p < PH_STOP; ++p) { a.ph_lo = p; a.ph_hi = p + 1; hipLaunchKernelGGL(mk_fwd, dim3(grid), dim3(512), LDS_BYTES, stream, a);
#ifdef DUP_PHASE
            if (p == DUP_PHASE) for (int r = 0; r < DUP_N; ++r) hipLaunchKernelGGL(mk_fwd, dim3(grid), dim3(512), LDS_BYTES, stream, a);
#endif
        }
#ifdef DUMP_OFF
        a.ph_lo = 100; a.ph_hi = 101; hipLaunchKernelGGL(mk_fwd, dim3(grid), dim3(512), LDS_BYTES, stream, a);
#endif
    }
}
```

```cpp
#include <hip/hip_runtime.h>
#include <stdio.h>

#ifndef MK_N_LAUNCHES
#define MK_N_LAUNCHES 1
#endif

#define GAS __attribute__((address_space(1)))
#define LAS __attribute__((address_space(3)))
typedef unsigned short bf16;
typedef unsigned v4u __attribute__((ext_vector_type(4)));
typedef unsigned v2u __attribute__((ext_vector_type(2)));
typedef float f32x2 __attribute__((ext_vector_type(2)));
typedef float f32x4 __attribute__((ext_vector_type(4)));
typedef float f32x16 __attribute__((ext_vector_type(16)));
typedef short bf16x8 __attribute__((ext_vector_type(8)));
typedef short s16x4 __attribute__((ext_vector_type(4)));
#define LDS_WAIT() asm volatile("s_waitcnt lgkmcnt(0)" ::: "memory")
#define VM_WAIT() asm volatile("s_waitcnt vmcnt(0)" ::: "memory")

constexpr int T_ = 32768, D_ = 1024, SEQ = 4096, NZ = 2560, FF = 2816, FFE = 3584, NEXP = 8;
constexpr int MAXPANEL = 136, PERMLEN = MAXPANEL * 256;
constexpr float ALPHA = 1.41421356237309515f, LN_EPS = 1e-5f, GN_EPS = 64e-5f, LOG2E = 1.44269504088896341f;

constexpr size_t MiB = 1u << 20;
constexpr size_t WS_CTL = 0, CTL_ZERO_BYTES = 1 * MiB;
constexpr size_t WS_TOKE = 1 * MiB, WS_TOKP = 1 * MiB + 128 * 1024, WS_WGCNT = 1 * MiB + 384 * 1024, WS_PTAB = WS_WGCNT + 16 * 1024, WS_PERM = 1 * MiB + 512 * 1024;
constexpr size_t WS_WIN0 = 2 * MiB, WS_WLORA = 7 * MiB, WS_WOUT0 = 8 * MiB, WS_WFGU = 10 * MiB, WS_WFD = 21 * MiB, WS_WIN1 = 27 * MiB, WS_WOUT1 = 33 * MiB, WS_WMGU = 35 * MiB, WS_WMD = 91 * MiB;
constexpr size_t WS_Y2 = 119 * MiB;
constexpr size_t WS_STP1 = 197 * MiB, WS_STP2 = 198 * MiB, WS_LNV = 196 * MiB;
constexpr size_t WS_B0 = 204 * MiB;
constexpr size_t WS_B1 = 268 * MiB;
constexpr size_t WS_ACT = 332 * MiB;
constexpr size_t WS_CV = 396 * MiB;
constexpr size_t WS_AP = 428 * MiB;
constexpr size_t WS_YRAW = 444 * MiB;
constexpr size_t WS_ACTM = 268 * MiB;
constexpr size_t WS_BONUS = 508 * MiB;
constexpr size_t WS_SLOT = 35 * MiB;
constexpr size_t WS_END = 510 * MiB;
static_assert(WS_ACTM + (size_t)2 * PERMLEN * FFE <= WS_END, "ACTM");
static_assert(WS_ACT + (size_t)T_ * FF * 2 <= WS_END, "ACT");
constexpr int CW_TMO = 0, CW_CODE = 1, CW_BAR = 4096;

constexpr int RING_BYTES = 131072, LDSCTL_OFF = 163328, MISC_OFF = LDSCTL_OFF, PTAB_OFF = RING_BYTES, RTAB_OFF = RING_BYTES + 2048;
constexpr int LDS_BYTES = 163840, STAT_OFF = RTAB_OFF, PST_OFF = RTAB_OFF + 8192;

namespace pg8 {
#define PG8_LAS __attribute__((address_space(3)))
typedef unsigned short bf16_t;
constexpr int BM = 256, BK = 64, HALF = 128, HTB = HALF * BK * 2, STAGE_BYTES = 8 * HTB, NXCD = 8, WGM = 8;
__host__ __device__ __forceinline__ int lds_byte(int r, int c) { const int st = (r >> 4) * 2 + (c >> 5), rr = r & 15, cc = c & 31, ob = rr * 64 + cc * 2; return st * 1024 + (ob ^ (((ob >> 9) & 1) << 5)); }
__host__ __device__ __forceinline__ void stage_rc(int b, int& R, int& C) { const int st = b / 1024, sb = b % 1024, swz = sb ^ (((sb >> 9) & 1) << 5); R = (st >> 1) * 16 + swz / 64; C = (st & 1) * 32 + (swz % 64) / 2; }
__host__ __device__ __forceinline__ int perm32(int rho) { const int n = rho >> 4, i = rho & 15; return 8 * (i >> 2) + 4 * n + (i & 3); }
struct Unit { int pm, pn, e, ui; };
__device__ __forceinline__ bool tile_order(int i, int G, int c, int nM, int nN, int& pm, int& pn) {
    const int nwg = nM * nN; const long L = (long)i * G + c; if (L >= nwg) return false;
    int wgid = (int)L; { const int q = nwg / NXCD, r = nwg % NXCD, xcd = wgid % NXCD, off = wgid / NXCD; wgid = (xcd < r ? xcd * (q + 1) : r * (q + 1) + (xcd - r) * q) + off; }
    const int nig = WGM * nN, gid = wgid / nig, fm = gid * WGM, gsz = (nM - fm) < WGM ? (nM - fm) : WGM;
    pm = fm + ((wgid % nig) % gsz); pn = (wgid % nig) / gsz; return true;
}
typedef __bf16 bf16x2_t __attribute__((ext_vector_type(2)));
__device__ __forceinline__ unsigned cvt_pk_bf16(float lo, float hi) { const f32x2 v = {lo, hi}; const bf16x2_t b = __builtin_convertvector(v, bf16x2_t); return __builtin_bit_cast(unsigned, b); }

typedef int i32x8 __attribute__((ext_vector_type(8)));
__device__ __forceinline__ i32x8 cat8(bf16x8 lo, bf16x8 hi) { const v4u a = __builtin_bit_cast(v4u, lo), b = __builtin_bit_cast(v4u, hi); return (i32x8){(int)a.x, (int)a.y, (int)a.z, (int)a.w, (int)b.x, (int)b.y, (int)b.z, (int)b.w}; }
template <class Epi, class Sched, bool F8 = false>
__device__ __forceinline__ void gemm_phase(PG8_LAS unsigned char* lds, const bf16_t* Abase, const int K, const Sched& S, const Epi& E) {
    const int tid = threadIdx.x, wid = __builtin_amdgcn_readfirstlane(tid >> 6), lane = tid & 63, wr = wid >> 2, wc = wid & 3, fr = lane & 15, fq = lane >> 4;
    const int nt = K / BK;
    int Rr[2], Cc[2]; unsigned voffB[2];
#pragma unroll
    for (int i = 0; i < 2; ++i) { stage_rc(tid * 16 + i * 8192, Rr[i], Cc[i]); const int Rb = Epi::PERM ? ((Rr[i] & ~31) + perm32(Rr[i] & 31)) : Rr[i]; voffB[i] = (unsigned)(Rb * K + Cc[i]) * 2u; }
    const size_t kstep = (size_t)(BK * 2);
    const size_t hstep = (size_t)HALF * K * 2;
    const unsigned ldsw = (unsigned)wid * 1024u;
    const int aoff = lds_byte(wr * 64 + fr, fq * 8), boff = lds_byte(wc * 32 + fr, fq * 8);
#define PG8_SA(b, h) (((b) * 2 + (h)) * HTB)
#define PG8_SB(b, h) ((4 + (b) * 2 + (h)) * HTB)
#define PG8_STAGE(bufoff, gbase, voff) do { _Pragma("unroll") for (int _i = 0; _i < 2; ++_i) \
        __builtin_amdgcn_global_load_lds((const unsigned*)((const char*)(gbase) + (voff)[_i]), (PG8_LAS unsigned*)(lds + (bufoff) + ldsw + _i * 8192), 16, 0, 0); } while (0)
#define PG8_LDA(dst, b, h) do { _Pragma("unroll") for (int m = 0; m < 4; ++m) _Pragma("unroll") for (int k = 0; k < 2; ++k) { if constexpr (F8) { const v4u _q = *(const PG8_LAS v4u*)(lds + PG8_SA(b, h) + aoff + m * 2048 + k * 1024); \
        dst##8[m][4 * k] = (int)_q.x; dst##8[m][4 * k + 1] = (int)_q.y; dst##8[m][4 * k + 2] = (int)_q.z; dst##8[m][4 * k + 3] = (int)_q.w; } else dst[m][k] = *(const PG8_LAS bf16x8*)(lds + PG8_SA(b, h) + aoff + m * 2048 + k * 1024); } } while (0)
#define PG8_LDB(dst, b, h) do { _Pragma("unroll") for (int n = 0; n < 2; ++n) _Pragma("unroll") for (int k = 0; k < 2; ++k) { if constexpr (F8) { const v4u _q = *(const PG8_LAS v4u*)(lds + PG8_SB(b, h) + boff + n * 2048 + k * 1024); \
        dst##8[n][4 * k] = (int)_q.x; dst##8[n][4 * k + 1] = (int)_q.y; dst##8[n][4 * k + 2] = (int)_q.z; dst##8[n][4 * k + 3] = (int)_q.w; } else dst[n][k] = *(const PG8_LAS bf16x8*)(lds + PG8_SB(b, h) + boff + n * 2048 + k * 1024); } } while (0)
#define PG8_MMA(ai, bj, At, Bt) do { __builtin_amdgcn_s_setprio(1); if constexpr (F8) { _Pragma("unroll") for (int m = 0; m < 4; ++m) _Pragma("unroll") for (int n = 0; n < 2; ++n) \
        asm volatile("v_mfma_scale_f32_16x16x128_f8f6f4 %0, %1, %2, %0, %3, %4 op_sel_hi:[0,0,0]" : "+v"(acc[ai][bj][m][n]) : "v"(Bt##8[n]), "v"(At##8[m]), "v"(scl_w), "v"(scl_a)); } else { \
        _Pragma("unroll") for (int m = 0; m < 4; ++m) _Pragma("unroll") for (int n = 0; n < 2; ++n) _Pragma("unroll") for (int k = 0; k < 2; ++k) \
        acc[ai][bj][m][n] = __builtin_amdgcn_mfma_f32_16x16x32_bf16(Bt[n][k], At[m][k], acc[ai][bj][m][n], 0, 0, 0); } __builtin_amdgcn_s_setprio(0); } while (0)
#define PG8_WAIT_V(n) asm volatile("s_waitcnt vmcnt(" #n ")" ::: "memory")
#define PG8_WAIT_L(n) asm volatile("s_waitcnt lgkmcnt(" #n ")" ::: "memory")
#define PG8_BAR __builtin_amdgcn_s_barrier()
#define PG8_SCHED __builtin_amdgcn_sched_barrier(0)
#define PG8_AOFF(dst, u) do { _Pragma("unroll") for (int _h = 0; _h < 2; ++_h) _Pragma("unroll") for (int _i = 0; _i < 2; ++_i) dst[_h][_i] = S.a_off(u, _h * HALF + Rr[_i]) + (unsigned)Cc[_i] * 2u; } while (0)
    Unit cur, nxt; int ui = 0;
    if (!S.next(0, cur)) return;
    f32x4 acc[2][2][4][2];
#pragma unroll
    for (int a = 0; a < 2; ++a)
#pragma unroll
        for (int b = 0; b < 2; ++b)
#pragma unroll
            for (int m = 0; m < 4; ++m)
#pragma unroll
                for (int n = 0; n < 2; ++n) acc[a][b][m][n] = (f32x4){0.f, 0.f, 0.f, 0.f};
    bf16x8 At[4][2], B0[2][2], B1[2][2]; i32x8 At8[4], B08[2], B18[2];
    int scl_w = 0x7f7f7f7f, scl_a = 0x7f7f7f7f; if constexpr (F8) { scl_w = (int)Epi::SCALE_W; asm volatile("" : "+v"(scl_w), "+v"(scl_a)); }
    unsigned curA[2][2], nxtA[2][2];
    PG8_AOFF(curA, cur);
    const char* const A0 = (const char*)Abase;
    const char* cB = S.b_ptr(cur);
    PG8_STAGE(PG8_SB(0, 0), cB, voffB); PG8_STAGE(PG8_SB(0, 1), cB + hstep, voffB); PG8_STAGE(PG8_SA(0, 0), A0, curA[0]); PG8_STAGE(PG8_SA(0, 1), A0, curA[1]);
    if (wr == 1) PG8_BAR;
    PG8_WAIT_V(2); PG8_BAR;
    PG8_STAGE(PG8_SB(1, 0), cB + kstep, voffB); PG8_STAGE(PG8_SA(1, 0), A0 + kstep, curA[0]); PG8_STAGE(PG8_SB(1, 1), cB + hstep + kstep, voffB);
    PG8_WAIT_V(6); PG8_BAR;
    for (;;) {
        const bool has_next = S.next(ui + 1, nxt);
        const char* nB = has_next ? S.b_ptr(nxt) : cB;
        if (has_next) { PG8_AOFF(nxtA, nxt); } else {
#pragma unroll
            for (int h = 0; h < 2; ++h)
#pragma unroll
                for (int i = 0; i < 2; ++i) nxtA[h][i] = curA[h][i]; }
        for (int t = 0; t < nt; t += 2) {
            const bool last = (t == nt - 2);
            const char* a1 = A0 + (size_t)(t + 1) * kstep;
            const char* a2 = last ? A0 : A0 + (size_t)(t + 2) * kstep; const char* b2 = last ? nB : cB + (size_t)(t + 2) * kstep;
            const char* a3 = a2 + kstep; const char* b3 = b2 + kstep;
            unsigned o2[2][2];
#pragma unroll
            for (int h = 0; h < 2; ++h)
#pragma unroll
                for (int i = 0; i < 2; ++i) o2[h][i] = last ? nxtA[h][i] : curA[h][i];
            PG8_LDB(B0, 0, 0); PG8_LDB(B1, 0, 1); PG8_SCHED; PG8_LDA(At, 0, 0); PG8_STAGE(PG8_SA(1, 1), a1, curA[1]);
            PG8_WAIT_V(8); PG8_WAIT_L(0); PG8_BAR; PG8_MMA(0, 0, At, B0); PG8_MMA(0, 1, At, B1); PG8_BAR; PG8_SCHED;
            PG8_LDA(At, 0, 1); PG8_STAGE(PG8_SB(0, 0), b2, voffB); PG8_STAGE(PG8_SB(0, 1), b2 + hstep, voffB); PG8_STAGE(PG8_SA(0, 0), a2, o2[0]);
            PG8_WAIT_V(8); PG8_WAIT_L(0); PG8_BAR; PG8_MMA(1, 0, At, B0); PG8_MMA(1, 1, At, B1); PG8_BAR; PG8_SCHED;
            PG8_LDB(B0, 1, 0); PG8_LDB(B1, 1, 1); PG8_SCHED; PG8_LDA(At, 1, 0); PG8_STAGE(PG8_SA(0, 1), a2, o2[1]);
            PG8_WAIT_V(8); PG8_WAIT_L(0); PG8_BAR; PG8_MMA(0, 0, At, B0); PG8_MMA(0, 1, At, B1); PG8_BAR; PG8_SCHED;
            PG8_LDA(At, 1, 1); PG8_STAGE(PG8_SB(1, 0), b3, voffB); PG8_STAGE(PG8_SB(1, 1), b3 + hstep, voffB); PG8_STAGE(PG8_SA(1, 0), a3, o2[0]);
            PG8_WAIT_V(8); PG8_WAIT_L(0); PG8_BAR; PG8_MMA(1, 0, At, B0); PG8_MMA(1, 1, At, B1); PG8_BAR; PG8_SCHED;
        }
        if (wr == 0) PG8_BAR;
        if constexpr (F8) asm volatile("s_nop 15\n\ts_nop 7" ::: "memory");
        E(acc, cur, wr, wc, fr, fq);
        if (!has_next) break;
#pragma unroll
        for (int a = 0; a < 2; ++a)
#pragma unroll
            for (int b = 0; b < 2; ++b)
#pragma unroll
                for (int m = 0; m < 4; ++m)
#pragma unroll
                    for (int n = 0; n < 2; ++n) acc[a][b][m][n] = (f32x4){0.f, 0.f, 0.f, 0.f};
        cur = nxt; cB = nB; ++ui;
#pragma unroll
        for (int h = 0; h < 2; ++h)
#pragma unroll
            for (int i = 0; i < 2; ++i) curA[h][i] = nxtA[h][i];
        if (wr == 1) PG8_BAR;
    }
    PG8_WAIT_V(0);
    PG8_BAR;
#undef PG8_SA
#undef PG8_SB
#undef PG8_STAGE
#undef PG8_LDA
#undef PG8_LDB
#undef PG8_MMA
#undef PG8_WAIT_V
#undef PG8_WAIT_L
#undef PG8_BAR
#undef PG8_SCHED
#undef PG8_AOFF
}

struct DenseSched {
    int nM, nN, G, c, K; const bf16_t* Bt;
    __device__ __forceinline__ bool next(int i, Unit& u) const { u.e = 0; u.ui = i; return tile_order(i, G, c, nM, nN, u.pm, u.pn); }
    __device__ __forceinline__ unsigned a_off(const Unit& u, int rr) const { return (unsigned)((u.pm * BM + rr) * K) * 2u; }
    __device__ __forceinline__ const char* b_ptr(const Unit& u) const { return (const char*)Bt + (size_t)u.pn * BM * K * 2; }
};
struct MoeUpSched {
    int nP, G, c; const unsigned char* Bt; const PG8_LAS int* ptab; const PG8_LAS unsigned short* rtab;
    __device__ __forceinline__ bool next(int i, Unit& u) const { u.ui = i; int pi; if (!tile_order(i, G, c, nP, 28, pi, u.pn)) return false; const int en = ptab[2 + pi]; u.pm = en >> 8; u.e = en & 255; return true; }
    __device__ __forceinline__ unsigned a_off(const Unit& u, int rr) const { return (unsigned)rtab[u.ui * 256 + rr] * 1024u; }
    __device__ __forceinline__ const char* b_ptr(const Unit& u) const { return (const char*)Bt + ((size_t)u.e * 7168 + (size_t)u.pn * BM) * 1024; }
};
struct MoeDownSched {
    int nP, p0, G, c; const unsigned char* Bt; const PG8_LAS int* ptab;
    __device__ __forceinline__ bool next(int i, Unit& u) const { u.ui = i; int pi; if (!tile_order(i, G, c, nP, 4, pi, u.pn)) return false; const int en = ptab[2 + p0 + pi]; u.pm = en >> 8; u.e = en & 255; return true; }
    __device__ __forceinline__ unsigned a_off(const Unit& u, int rr) const { return (unsigned)(u.pm * BM + rr) * (unsigned)FFE; }
    __device__ __forceinline__ const char* b_ptr(const Unit& u) const { return (const char*)Bt + ((size_t)u.e * 1024 + (size_t)u.pn * BM) * FFE; }
};

struct EpiBf16 {
    static constexpr bool PERM = true;
    bf16_t* O; int ldc;
    __device__ __forceinline__ void operator()(const f32x4 (&acc)[2][2][4][2], const Unit& u, int wr, int wc, int fr, int fq) const {
        const int row0 = u.pm * BM + wr * 64 + fr, col0 = u.pn * BM + wc * 32 + 8 * fq;
#pragma unroll
        for (int ai = 0; ai < 2; ++ai)
#pragma unroll
            for (int m = 0; m < 4; ++m) { bf16_t* rowp = O + (size_t)(row0 + ai * HALF + m * 16) * ldc + col0;
#pragma unroll
                for (int bj = 0; bj < 2; ++bj) { const f32x4 v0 = acc[ai][bj][m][0], v1 = acc[ai][bj][m][1];
                    v4u w; w.x = cvt_pk_bf16(v0[0], v0[1]); w.y = cvt_pk_bf16(v0[2], v0[3]); w.z = cvt_pk_bf16(v1[0], v1[1]); w.w = cvt_pk_bf16(v1[2], v1[3]);
                    *(v4u*)(rowp + bj * HALF) = w; } }
    }
};
__device__ __forceinline__ float silu_f(float g) { return g * __builtin_amdgcn_rcpf(1.0f + __expf(-g)); }
struct EpiSwiglu {
    static constexpr bool PERM = true;
    bf16_t* O; int ldc;
    __device__ __forceinline__ void operator()(const f32x4 (&acc)[2][2][4][2], const Unit& u, int wr, int wc, int fr, int fq) const {
        const int row0 = u.pm * BM + wr * 64 + fr, col0 = u.pn * HALF + wc * 32 + 8 * fq;
#pragma unroll
        for (int ai = 0; ai < 2; ++ai)
#pragma unroll
            for (int m = 0; m < 4; ++m) { bf16_t* rowp = O + (size_t)(row0 + ai * HALF + m * 16) * ldc + col0;
                const f32x4 g0 = acc[ai][0][m][0], g1 = acc[ai][0][m][1], u0 = acc[ai][1][m][0], u1 = acc[ai][1][m][1];
                v4u w; w.x = cvt_pk_bf16(silu_f(g0[0]) * u0[0], silu_f(g0[1]) * u0[1]); w.y = cvt_pk_bf16(silu_f(g0[2]) * u0[2], silu_f(g0[3]) * u0[3]);
                w.z = cvt_pk_bf16(silu_f(g1[0]) * u1[0], silu_f(g1[1]) * u1[1]); w.w = cvt_pk_bf16(silu_f(g1[2]) * u1[2], silu_f(g1[3]) * u1[3]);
                *(v4u*)rowp = w; }
    }
};
__device__ __forceinline__ unsigned pk4_fp8(float a, float b, float c, float d) { int p = 0; p = __builtin_amdgcn_cvt_pk_fp8_f32(a, b, p, false); p = __builtin_amdgcn_cvt_pk_fp8_f32(c, d, p, true); return (unsigned)p; }
__device__ __forceinline__ float sat8(float x) { return __builtin_amdgcn_fmed3f(x, -448.0f, 448.0f); }
struct EpiSwiglu8 {
    static constexpr bool PERM = true; static constexpr unsigned SCALE_W = 0x7a7a7a7au;
    unsigned char* O; int ldc;
    __device__ __forceinline__ void operator()(const f32x4 (&acc)[2][2][4][2], const Unit& u, int wr, int wc, int fr, int fq) const {
        const int row0 = u.pm * BM + wr * 64 + fr, col0 = u.pn * HALF + wc * 32 + 8 * fq;
#pragma unroll
        for (int ai = 0; ai < 2; ++ai)
#pragma unroll
            for (int m = 0; m < 4; ++m) { unsigned char* rowp = O + (size_t)(row0 + ai * HALF + m * 16) * ldc + col0;
                const f32x4 g0 = acc[ai][0][m][0], g1 = acc[ai][0][m][1], u0 = acc[ai][1][m][0], u1 = acc[ai][1][m][1];
                v2u w; w.x = pk4_fp8(sat8(silu_f(g0[0]) * u0[0]), sat8(silu_f(g0[1]) * u0[1]), sat8(silu_f(g0[2]) * u0[2]), sat8(silu_f(g0[3]) * u0[3]));
                w.y = pk4_fp8(sat8(silu_f(g1[0]) * u1[0]), sat8(silu_f(g1[1]) * u1[1]), sat8(silu_f(g1[2]) * u1[2]), sat8(silu_f(g1[3]) * u1[3]));
                *(v2u*)rowp = w; }
    }
};
struct EpiL1in {
    static constexpr bool PERM = true;
    bf16_t* GB; bf16_t* UP;
    __device__ __forceinline__ void operator()(const f32x4 (&acc)[2][2][4][2], const Unit& u, int wr, int wc, int fr, int fq) const {
        const int row0 = u.pm * BM + wr * 64 + fr;
        if (u.pn < 4) {
            const int col0 = u.pn * BM + wc * 32 + 8 * fq;
#pragma unroll
            for (int ai = 0; ai < 2; ++ai)
#pragma unroll
                for (int m = 0; m < 4; ++m) { bf16_t* rowp = GB + (size_t)(row0 + ai * HALF + m * 16) * D_ + col0;
#pragma unroll
                    for (int bj = 0; bj < 2; ++bj) { const f32x4 v0 = acc[ai][bj][m][0], v1 = acc[ai][bj][m][1];
                        v4u w; w.x = cvt_pk_bf16(v0[0], v0[1]); w.y = cvt_pk_bf16(v0[2], v0[3]); w.z = cvt_pk_bf16(v1[0], v1[1]); w.w = cvt_pk_bf16(v1[2], v1[3]);
                        *(v4u*)(rowp + bj * HALF) = w; } }
        } else {
            const int col0 = (u.pn - 4) * HALF + wc * 32 + 8 * fq;
#pragma unroll
            for (int ai = 0; ai < 2; ++ai)
#pragma unroll
                for (int m = 0; m < 4; ++m) { bf16_t* rowp = UP + (size_t)(row0 + ai * HALF + m * 16) * D_ + col0;
                    const f32x4 g0 = acc[ai][0][m][0], g1 = acc[ai][0][m][1], u0 = acc[ai][1][m][0], u1 = acc[ai][1][m][1];
                    v4u w; w.x = cvt_pk_bf16(g0[0] * u0[0], g0[1] * u0[1]); w.y = cvt_pk_bf16(g0[2] * u0[2], g0[3] * u0[3]);
                    w.z = cvt_pk_bf16(g1[0] * u1[0], g1[1] * u1[1]); w.w = cvt_pk_bf16(g1[2] * u1[2], g1[3] * u1[3]);
                    *(v4u*)rowp = w; }
        }
    }
};
struct EpiLora {
    static constexpr bool PERM = false;
    float* WLOG; bf16_t* AB; bf16_t* GBUF; const float* w0; const float* a0;
    __device__ __forceinline__ void operator()(const f32x4 (&acc)[2][2][4][2], const Unit& u, int wr, int wc, int fr, int fq) const {
        const int row0 = u.pm * BM + wr * 64 + fr, sec = u.pn >> 1, chb = (u.pn & 1) * BM + wc * 32 + 4 * fq;
        if (sec == 0) {
#pragma unroll
            for (int bj = 0; bj < 2; ++bj)
#pragma unroll
                for (int n = 0; n < 2; ++n) { const int ch = chb + bj * HALF + n * 16; const f32x4 bias = *(const f32x4*)(w0 + ch);
#pragma unroll
                    for (int ai = 0; ai < 2; ++ai)
#pragma unroll
                        for (int m = 0; m < 4; ++m) { const size_t ro = (size_t)(row0 + ai * HALF + m * 16) * 512 + ch; const f32x4 v = acc[ai][bj][m][n] + bias; f32x4 o;
#pragma unroll
                            for (int j = 0; j < 4; ++j) o[j] = -0.60653065971263342f * __builtin_amdgcn_rcpf(1.0f + __expf(-v[j]));
                            *(f32x4*)(WLOG + ro) = o; } }
        } else if (sec == 1) {
#pragma unroll
            for (int bj = 0; bj < 2; ++bj)
#pragma unroll
                for (int n = 0; n < 2; ++n) { const int ch = chb + bj * HALF + n * 16; const f32x4 bias = *(const f32x4*)(a0 + ch);
#pragma unroll
                    for (int ai = 0; ai < 2; ++ai)
#pragma unroll
                        for (int m = 0; m < 4; ++m) { const size_t ro = (size_t)(row0 + ai * HALF + m * 16) * 512 + ch; const f32x4 v = acc[ai][bj][m][n] + bias; f32x4 o;
#pragma unroll
                            for (int j = 0; j < 4; ++j) o[j] = __builtin_amdgcn_rcpf(1.0f + __expf(-v[j]));
                            v2u w; w.x = cvt_pk_bf16(o[0], o[1]); w.y = cvt_pk_bf16(o[2], o[3]); *(v2u*)(AB + ro) = w; } }
        } else {
#pragma unroll
            for (int bj = 0; bj < 2; ++bj)
#pragma unroll
                for (int n = 0; n < 2; ++n) { const int ch = chb + bj * HALF + n * 16;
#pragma unroll
                    for (int ai = 0; ai < 2; ++ai)
#pragma unroll
                        for (int m = 0; m < 4; ++m) { const size_t ro = (size_t)(row0 + ai * HALF + m * 16) * 512 + ch; const f32x4 v = acc[ai][bj][m][n];
                            v2u w; w.x = cvt_pk_bf16(v[0], v[1]); w.y = cvt_pk_bf16(v[2], v[3]); *(v2u*)(GBUF + ro) = w; } }
        }
    }
};
__device__ __forceinline__ void row_stats(const float* stp, int row, float& mu, float& r) {
    const f32x4 a = *(const f32x4*)(stp + (size_t)row * 8), b = *(const f32x4*)(stp + (size_t)row * 8 + 4);
    const float s = ((a[0] + a[2]) + b[0]) + b[2], q = ((a[1] + a[3]) + b[1]) + b[3];
    mu = s * (1.0f / 1024.0f); r = rsqrtf(fmaxf(q * (1.0f / 1024.0f) - mu * mu, 0.f) + LN_EPS);
}
struct EpiResStats {
    static constexpr bool PERM = false;
    const float* base; float* out; bf16_t* outb; float* stp_out; PG8_LAS float* P; const PG8_LAS float* tbl; const float* stp_in; const float* gin; const float* bin;
    __device__ __forceinline__ void operator()(const f32x4 (&acc)[2][2][4][2], const Unit& u, int wr, int wc, int fr, int fq) const {
        const int row0 = u.pm * BM + wr * 64 + fr, col0 = u.pn * BM + wc * 32 + 4 * fq;
        f32x4 gv[2][2], bv[2][2];
        if (stp_in) {
#pragma unroll
            for (int bj = 0; bj < 2; ++bj)
#pragma unroll
                for (int n = 0; n < 2; ++n) { gv[bj][n] = *(const f32x4*)(gin + col0 + bj * HALF + n * 16); bv[bj][n] = *(const f32x4*)(bin + col0 + bj * HALF + n * 16); } }
#pragma unroll
        for (int ai = 0; ai < 2; ++ai)
#pragma unroll
            for (int m = 0; m < 4; ++m) { const int row = row0 + ai * HALF + m * 16; const size_t off = (size_t)row * D_ + col0;
                float mu = 0.f, rr = 1.f; if (stp_in) { const f32x2 mr = *(const PG8_LAS f32x2*)(tbl + (u.ui * 256 + ai * HALF + wr * 64 + m * 16 + fr) * 2); mu = mr[0]; rr = mr[1]; }
                float s = 0.f, q = 0.f;
#pragma unroll
                for (int bj = 0; bj < 2; ++bj)
#pragma unroll
                    for (int n = 0; n < 2; ++n) { f32x4 h = *(const f32x4*)(base + off + bj * HALF + n * 16);
                        if (stp_in) h = (h - mu) * rr * gv[bj][n] + bv[bj][n];
                        const f32x4 v = h * ALPHA + acc[ai][bj][m][n];
                        *(f32x4*)(out + off + bj * HALF + n * 16) = v;
                        if (outb) { v2u w; w.x = cvt_pk_bf16(v[0], v[1]); w.y = cvt_pk_bf16(v[2], v[3]); *(v2u*)(outb + off + bj * HALF + n * 16) = w; }
                        s += (v[0] + v[1]) + (v[2] + v[3]); q += (v[0] * v[0] + v[1] * v[1]) + (v[2] * v[2] + v[3] * v[3]); }
                if (stp_out) { s += __shfl_xor(s, 16); s += __shfl_xor(s, 32); q += __shfl_xor(q, 16); q += __shfl_xor(q, 32);
                    if (fq == 0) { PG8_LAS float* p = P + ((ai * HALF + wr * 64 + m * 16 + fr) * 4 + wc) * 2; p[0] = s; p[1] = q; } } }
        if (stp_out) {
            asm volatile("s_waitcnt lgkmcnt(0)" ::: "memory"); __builtin_amdgcn_s_barrier(); asm volatile("" ::: "memory");
            const int t = threadIdx.x;
            if (t < 256) { const f32x4 a = *(const PG8_LAS f32x4*)(P + t * 8), b = *(const PG8_LAS f32x4*)(P + t * 8 + 4);
                f32x2 o; o[0] = ((a[0] + a[2]) + b[0]) + b[2]; o[1] = ((a[1] + a[3]) + b[1]) + b[3];
                *(f32x2*)(stp_out + (size_t)(u.pm * BM + t) * 8 + u.pn * 2) = o; } }
    }
};
struct EpiSwigluLN {
    static constexpr bool PERM = true;
    bf16_t* O; int ldc; const PG8_LAS float* tbl; const float* sv; const float* cv;
    __device__ __forceinline__ void operator()(const f32x4 (&acc)[2][2][4][2], const Unit& u, int wr, int wc, int fr, int fq) const {
        const int row0 = u.pm * BM + wr * 64 + fr, col0 = u.pn * HALF + wc * 32 + 8 * fq, n0 = u.pn * BM + wc * 32 + 8 * fq;
        f32x4 sg[2], cg[2], su[2], cu[2];
#pragma unroll
        for (int n = 0; n < 2; ++n) { sg[n] = *(const f32x4*)(sv + n0 + 4 * n); cg[n] = *(const f32x4*)(cv + n0 + 4 * n); su[n] = *(const f32x4*)(sv + n0 + HALF + 4 * n); cu[n] = *(const f32x4*)(cv + n0 + HALF + 4 * n); }
#pragma unroll
        for (int ai = 0; ai < 2; ++ai)
#pragma unroll
            for (int m = 0; m < 4; ++m) { const int row = row0 + ai * HALF + m * 16; bf16_t* rowp = O + (size_t)row * ldc + col0;
                const f32x2 mr = *(const PG8_LAS f32x2*)(tbl + (u.ui * 256 + ai * HALF + wr * 64 + m * 16 + fr) * 2); const float mu = mr[0], rr = mr[1];
                const f32x4 g0 = (acc[ai][0][m][0] - sg[0] * mu) * rr + cg[0], g1 = (acc[ai][0][m][1] - sg[1] * mu) * rr + cg[1];
                const f32x4 u0 = (acc[ai][1][m][0] - su[0] * mu) * rr + cu[0], u1 = (acc[ai][1][m][1] - su[1] * mu) * rr + cu[1];
                v4u w; w.x = cvt_pk_bf16(silu_f(g0[0]) * u0[0], silu_f(g0[1]) * u0[1]); w.y = cvt_pk_bf16(silu_f(g0[2]) * u0[2], silu_f(g0[3]) * u0[3]);
                w.z = cvt_pk_bf16(silu_f(g1[0]) * u1[0], silu_f(g1[1]) * u1[1]); w.w = cvt_pk_bf16(silu_f(g1[2]) * u1[2], silu_f(g1[3]) * u1[3]);
                *(v4u*)rowp = w; }
    }
};
struct EpiL1inLN {
    static constexpr bool PERM = true;
    bf16_t* GB; bf16_t* UP; const PG8_LAS float* tbl; const float* sv; const float* cv;
    __device__ __forceinline__ void operator()(const f32x4 (&acc)[2][2][4][2], const Unit& u, int wr, int wc, int fr, int fq) const {
        const int row0 = u.pm * BM + wr * 64 + fr, n0 = u.pn * BM + wc * 32 + 8 * fq;
        f32x4 s0[2], c0[2], s1[2], c1[2];
#pragma unroll
        for (int n = 0; n < 2; ++n) { s0[n] = *(const f32x4*)(sv + n0 + 4 * n); c0[n] = *(const f32x4*)(cv + n0 + 4 * n); s1[n] = *(const f32x4*)(sv + n0 + HALF + 4 * n); c1[n] = *(const f32x4*)(cv + n0 + HALF + 4 * n); }
#pragma unroll
        for (int ai = 0; ai < 2; ++ai)
#pragma unroll
            for (int m = 0; m < 4; ++m) { const int row = row0 + ai * HALF + m * 16;
                const f32x2 mr = *(const PG8_LAS f32x2*)(tbl + (u.ui * 256 + ai * HALF + wr * 64 + m * 16 + fr) * 2); const float mu = mr[0], rr = mr[1];
                const f32x4 a0 = (acc[ai][0][m][0] - s0[0] * mu) * rr + c0[0], a1 = (acc[ai][0][m][1] - s0[1] * mu) * rr + c0[1];
                const f32x4 b0 = (acc[ai][1][m][0] - s1[0] * mu) * rr + c1[0], b1 = (acc[ai][1][m][1] - s1[1] * mu) * rr + c1[1];
                if (u.pn < 4) { bf16_t* rowp = GB + (size_t)row * D_ + n0;
                    v4u w; w.x = cvt_pk_bf16(a0[0], a0[1]); w.y = cvt_pk_bf16(a0[2], a0[3]); w.z = cvt_pk_bf16(a1[0], a1[1]); w.w = cvt_pk_bf16(a1[2], a1[3]); *(v4u*)rowp = w;
                    v4u x; x.x = cvt_pk_bf16(b0[0], b0[1]); x.y = cvt_pk_bf16(b0[2], b0[3]); x.z = cvt_pk_bf16(b1[0], b1[1]); x.w = cvt_pk_bf16(b1[2], b1[3]); *(v4u*)(rowp + HALF) = x; }
                else { bf16_t* rowp = UP + (size_t)row * D_ + (u.pn - 4) * HALF + wc * 32 + 8 * fq;
                    v4u w; w.x = cvt_pk_bf16(a0[0] * b0[0], a0[1] * b0[1]); w.y = cvt_pk_bf16(a0[2] * b0[2], a0[3] * b0[3]); w.z = cvt_pk_bf16(a1[0] * b1[0], a1[1] * b1[1]); w.w = cvt_pk_bf16(a1[2] * b1[2], a1[3] * b1[3]); *(v4u*)rowp = w; } }
    }
};
struct EpiMoeDown {
    static constexpr bool PERM = false; static constexpr unsigned SCALE_W = 0x78787878u;
    float* out; bf16_t* Y2; const int* perm; const float* tokp;
    __device__ __forceinline__ void operator()(const f32x4 (&acc)[2][2][4][2], const Unit& u, int wr, int wc, int fr, int fq) const {
        const int slot0 = u.pm * BM + wr * 64 + fr, col0 = u.pn * BM + wc * 32 + 4 * fq; const int pass = u.pm >= MAXPANEL ? 1 : 0;
#pragma unroll
        for (int ai = 0; ai < 2; ++ai)
#pragma unroll
            for (int m = 0; m < 4; ++m) { const int tok = perm[slot0 + ai * HALF + m * 16];
                if (tok >= 0) { const float p = tokp[2 * tok + pass]; const size_t off = (size_t)tok * D_ + col0;
                    if (pass == 0) {
#pragma unroll
                        for (int bj = 0; bj < 2; ++bj)
#pragma unroll
                            for (int n = 0; n < 2; ++n) { const f32x4 bs = *(const f32x4*)(out + off + bj * HALF + n * 16); *(f32x4*)(out + off + bj * HALF + n * 16) = bs * ALPHA + acc[ai][bj][m][n] * p; }
                    } else {
#pragma unroll
                        for (int bj = 0; bj < 2; ++bj)
#pragma unroll
                            for (int n = 0; n < 2; ++n) { const f32x4 v = acc[ai][bj][m][n] * p; v2u w; w.x = cvt_pk_bf16(v[0], v[1]); w.y = cvt_pk_bf16(v[2], v[3]); *(v2u*)(Y2 + off + bj * HALF + n * 16) = w; }
                    } } }
    }
};
}

#define XB_TMO      128
#define XB_XCNT(j)  (256  + 64 * (j))
#define XB_XSUB(j)  (1280 + 64 * (j))
#define XB_XGEN(j)  (2304 + 64 * (j))
#define XB_TOP      3328
#define XB_TOPGEN   3392
#define XCD_BAR_WORDS 3456
#define XB_SPIN_CAP (1u << 22)
__device__ __forceinline__ unsigned xb_ld(unsigned* p)              { return __hip_atomic_load(p, __ATOMIC_RELAXED, __HIP_MEMORY_SCOPE_AGENT); }
__device__ __forceinline__ unsigned xb_add(unsigned* p, unsigned v) { return __hip_atomic_fetch_add(p, v, __ATOMIC_RELAXED, __HIP_MEMORY_SCOPE_AGENT); }
__device__ __forceinline__ unsigned xb_xcc_id() { return (unsigned)__builtin_amdgcn_s_getreg((3 << 11) | 20) & 0xFu; }
#define XB_SPIN(cond, bar) do { unsigned _sp = 0; while (cond) { __builtin_amdgcn_s_sleep(1); \
    if ((++_sp & 255u) == 0u) { if (xb_ld(&(bar)[XB_TMO])) break; if (_sp > XB_SPIN_CAP) { atomicAdd(&(bar)[XB_TMO], 1u); break; } } } } while (0)
struct XcdBarrier { unsigned* bar; unsigned x; volatile LAS unsigned* st; };
__device__ __forceinline__ XcdBarrier xcd_barrier_post(unsigned* bar, volatile LAS unsigned* st) {
    XcdBarrier b; b.bar = bar; b.x = xb_xcc_id(); b.st = st;
    if (threadIdx.x == 0) (void)xb_add(&bar[XB_XCNT(b.x)], 1u);
    return b;
}
__device__ __forceinline__ void xcd_barrier_complete(unsigned* bar, unsigned x, unsigned& nloc, unsigned& nx) {
    const unsigned G = gridDim.x * gridDim.y * gridDim.z;
    unsigned sum, cnt, mine, sp = 0u;
    for (;;) {
        sum = 0u; cnt = 0u; mine = 0u;
#pragma unroll
        for (unsigned j = 0; j < 16; ++j) { const unsigned c = xb_ld(&bar[XB_XCNT(j)]); sum += c; cnt += (c > 0u) ? 1u : 0u; mine = (j == x) ? c : mine; }
        if (sum == G) break;
        __builtin_amdgcn_s_sleep(1);
        if ((++sp & 255u) == 0u) { if (xb_ld(&bar[XB_TMO])) break; if (sp > XB_SPIN_CAP) { atomicAdd(&bar[XB_TMO], 1u); break; } }
    }
    nloc = mine > 0u ? mine : 1u; nx = cnt > 0u ? cnt : 1u;
}
__device__ __forceinline__ void xcd_barrier(const XcdBarrier& b) {
    asm volatile("s_waitcnt vmcnt(0)" ::: "memory");
    __syncthreads();
    if (threadIdx.x == 0) {
        unsigned* bar = b.bar;
        __builtin_amdgcn_s_waitcnt(0);
        unsigned nloc = b.st[0], nx = b.st[1];
        if (nloc == 0u) { xcd_barrier_complete(bar, b.x, nloc, nx); b.st[0] = nloc; b.st[1] = nx; }
        const unsigned old = xb_add(&bar[XB_XSUB(b.x)], 1u);
        const unsigned gen = old / nloc;
        if (old + 1u == (gen + 1u) * nloc) {
            __builtin_amdgcn_fence(__ATOMIC_RELEASE, "agent");
            asm volatile("s_waitcnt vmcnt(0)" ::: "memory");
            const unsigned og = xb_add(&bar[XB_TOP], 1u);
            const unsigned tg = og / nx;
            if (og + 1u == (tg + 1u) * nx) xb_add(&bar[XB_TOPGEN], 1u);
            else XB_SPIN(xb_ld(&bar[XB_TOPGEN]) == tg, bar);
            __builtin_amdgcn_fence(__ATOMIC_ACQUIRE, "agent");
            xb_add(&bar[XB_XGEN(b.x)], 1u);
            asm volatile("s_waitcnt vmcnt(0)" ::: "memory");
        } else {
            XB_SPIN(xb_ld(&bar[XB_XGEN(b.x)]) == gen, bar);
            __builtin_amdgcn_fence(__ATOMIC_ACQUIRE, "agent");
            asm volatile("s_waitcnt vmcnt(0)" ::: "memory");
        }
    }
    __syncthreads();
}

__device__ __forceinline__ unsigned f2bf(float f) { unsigned u = __builtin_bit_cast(unsigned, f); return (u + 0x7fffu + ((u >> 16) & 1u)) >> 16; }
__device__ __forceinline__ unsigned pk2(float lo, float hi) { return pg8::cvt_pk_bf16(lo, hi); }
__device__ __forceinline__ float bf2f(unsigned short b) { return __builtin_bit_cast(float, ((unsigned)b) << 16); }
__device__ __forceinline__ float bflo(unsigned w) { return __builtin_bit_cast(float, w << 16); }
__device__ __forceinline__ float bfhi(unsigned w) { return __builtin_bit_cast(float, w & 0xffff0000u); }
__device__ __forceinline__ float wave_sum(float v) {
#pragma unroll
    for (int o = 1; o < 64; o <<= 1) v += __shfl_xor(v, o);
    return v;
}
template <int CTRL> __device__ __forceinline__ float dpp_mov(float x) { return __builtin_bit_cast(float, __builtin_amdgcn_update_dpp(0, __builtin_bit_cast(int, x), CTRL, 0xf, 0xf, false)); }
__device__ __forceinline__ float row16_sum(float x) { x += dpp_mov<0x128>(x); x += dpp_mov<0x124>(x); x += dpp_mov<0x122>(x); x += dpp_mov<0x121>(x); return x; }

__device__ __forceinline__ float rl_f(float x, int l) { return __builtin_bit_cast(float, __builtin_amdgcn_readlane(__builtin_bit_cast(int, x), l)); }
template <int CTRL, int RMASK> __device__ __forceinline__ float dpp_add_rm(float x) { return x + __builtin_bit_cast(float, __builtin_amdgcn_update_dpp(0, __builtin_bit_cast(int, x), CTRL, RMASK, 0xf, true)); }
__device__ __forceinline__ float wave_sum_fast(float x) { x = row16_sum(x); x = dpp_add_rm<0x142, 0xA>(x); x = dpp_add_rm<0x143, 0xC>(x); return rl_f(x, 63); }
struct WInfo { int tid, lane, wave, vcu, G, gw, NGW; };

__device__ __forceinline__ void tr_item(const float* __restrict__ W, int Nsrc, int c0, int k0, bf16* WT, int K, int n0, LAS float* scr, int lane, const float* ksc = nullptr) {
#pragma unroll 32
    for (int i = 0; i < 32; ++i) { const int kk = 2 * i + (lane >> 5); const float wv = W[(size_t)(k0 + kk) * Nsrc + c0 + (lane & 31)]; scr[kk * 33 + (lane & 31)] = ksc ? wv * ksc[k0 + kk] : wv; }
    LDS_WAIT(); asm volatile("" ::: "memory");
    const int c = lane & 7;
#pragma unroll
    for (int j = 0; j < 4; ++j) { const int n = (lane >> 3) + 8 * j; const LAS float* s = scr + (8 * c) * 33 + n;
        v4u o; o.x = pk2(s[0 * 33], s[1 * 33]); o.y = pk2(s[2 * 33], s[3 * 33]); o.z = pk2(s[4 * 33], s[5 * 33]); o.w = pk2(s[6 * 33], s[7 * 33]);
        *(v4u*)(WT + (size_t)(n0 + n) * K + k0 + 8 * c) = o; }
    LDS_WAIT(); asm volatile("" ::: "memory");
}
__device__ __forceinline__ void tr_item8(const float* __restrict__ Wsrc, int Nsrc, int c0, int k0, unsigned char* WT, int K, int n0, float scale, LAS float* scr, int lane) {
#pragma unroll 32
    for (int i = 0; i < 32; ++i) { const int kk = 2 * i + (lane >> 5); scr[kk * 33 + (lane & 31)] = Wsrc[(size_t)(k0 + kk) * Nsrc + c0 + (lane & 31)] * scale; }
    LDS_WAIT(); asm volatile("" ::: "memory");
    const int n = lane & 31, kh = lane >> 5; const LAS float* s = scr + (kh * 32) * 33 + n;
    v4u o0, o1;
#pragma unroll
    for (int q = 0; q < 4; ++q) { o0[q] = pg8::pk4_fp8(s[(4 * q) * 33], s[(4 * q + 1) * 33], s[(4 * q + 2) * 33], s[(4 * q + 3) * 33]); o1[q] = pg8::pk4_fp8(s[(16 + 4 * q) * 33], s[(17 + 4 * q) * 33], s[(18 + 4 * q) * 33], s[(19 + 4 * q) * 33]); }
    unsigned char* dst = WT + (size_t)(n0 + n) * K + k0 + kh * 32; *(v4u*)dst = o0; *(v4u*)(dst + 16) = o1;
    LDS_WAIT(); asm volatile("" ::: "memory");
}
constexpr int I_WIN0 = 16 * 80, I_WOUT = 16 * 32, I_FGU = 16 * 176, I_FD = 44 * 32, I_IN1 = 16 * 96, I_MGU1 = 16 * 224, I_MD1 = 56 * 32;
constexpr int NITEMS_MOE = 8 * I_MGU1 + 8 * I_MD1, NITEMS = I_WIN0 + I_WOUT + I_FGU + I_FD + I_IN1 + I_WOUT + NITEMS_MOE;
__device__ __forceinline__ void weight_item(const WInfo& W, LAS unsigned char* lds, const float* const* in, unsigned char* ws, int it) {
    LAS float* scr = (LAS float*)(lds + W.wave * 16384);
    for (int once = 0; once < 1; ++once) {
        int r = it;
        if (r < 8 * I_MGU1) { const int e = r / I_MGU1, r2 = r % I_MGU1, kb = r2 / 224, nb = r2 % 224, n0 = nb * 32, q = n0 >> 8, rr = n0 & 255;
            const float* src = (rr < 128 ? in[29] : in[30]) + (size_t)e * 1024 * FFE;
            tr_item8(src, FFE, q * 128 + (rr & 127), kb * 64, ws + WS_WMGU + (size_t)e * 7168 * 1024, 1024, n0, 32.0f, scr, W.lane); continue; } r -= 8 * I_MGU1;
        if (r < 8 * I_MD1) { const int e = r / I_MD1, r2 = r % I_MD1, kb = r2 / 32, nb = r2 % 32;
            tr_item8(in[31] + (size_t)e * FFE * 1024, 1024, nb * 32, kb * 64, ws + WS_WMD + (size_t)e * 1024 * FFE, FFE, nb * 32, 128.0f, scr, W.lane); continue; } r -= 8 * I_MD1;
        if (r < I_WIN0) { const int kb = r / 80, nb = r % 80; tr_item(in[2], NZ, nb * 32, kb * 64, (bf16*)(ws + WS_WIN0), 1024, nb * 32, scr, W.lane); continue; } r -= I_WIN0;
        if (r < I_WOUT) { const int kb = r / 32, nb = r % 32; tr_item(in[15], 1024, nb * 32, kb * 64, (bf16*)(ws + WS_WOUT0), 1024, nb * 32, scr, W.lane); continue; } r -= I_WOUT;
        if (r < I_FGU) { const int kb = r / 176, nb = r % 176, n0 = nb * 32, q = n0 >> 8, rr = n0 & 255;
            tr_item(rr < 128 ? in[18] : in[19], FF, q * 128 + (rr & 127), kb * 64, (bf16*)(ws + WS_WFGU), 1024, n0, scr, W.lane, in[16]); continue; } r -= I_FGU;
        if (r < I_FD) { const int kb = r / 32, nb = r % 32; tr_item(in[20], 1024, nb * 32, kb * 64, (bf16*)(ws + WS_WFD), FF, nb * 32, scr, W.lane); continue; } r -= I_FD;
        if (r < I_IN1) { const int kb = r / 96, nb = r % 96, n0 = nb * 32; int c0 = n0;
            if (n0 >= 1024) { const int q = (n0 - 1024) >> 8, rr = (n0 - 1024) & 255; c0 = (rr < 128 ? 1024 : 2048) + q * 128 + (rr & 127); }
            tr_item(in[23], 3072, c0, kb * 64, (bf16*)(ws + WS_WIN1), 1024, n0, scr, W.lane, in[21]); continue; } r -= I_IN1;
        { const int kb = r / 32, nb = r % 32; tr_item(in[25], 1024, nb * 32, kb * 64, (bf16*)(ws + WS_WOUT1), 1024, nb * 32, scr, W.lane); }
    }
}
__device__ __forceinline__ void p0_weights(const WInfo& W, LAS unsigned char* lds, const float* const* in, unsigned char* ws, int it_lo, int it_hi) {
    for (int it = it_lo + W.gw; it < it_hi; it += W.NGW) weight_item(W, lds, in, ws, it);
}
__device__ __forceinline__ void lnvec_block(const WInfo& W, LAS unsigned char* lds, const float* const* in, unsigned char* ws, int blk) {
    LAS float* red = (LAS float*)lds;
    float* SV = (float*)(ws + WS_LNV); float* CV = SV + 8704;
    {
        const bool ffn = blk < 88; const int n = (ffn ? blk : blk - 88) * 64 + W.lane;
        const float* src; int Nsrc, col; const float* gk; const float* bk;
        if (ffn) { const int q = n >> 8, rr = n & 255; src = rr < 128 ? in[18] : in[19]; Nsrc = FF; col = q * 128 + (rr & 127); gk = in[16]; bk = in[17]; }
        else { src = in[23]; Nsrc = 3072; col = n; if (n >= 1024) { const int q = (n - 1024) >> 8, rr = (n - 1024) & 255; col = (rr < 128 ? 1024 : 2048) + q * 128 + (rr & 127); } gk = in[21]; bk = in[22]; }
        float s = 0.f, c = 0.f;
#pragma unroll 32
        for (int kk = 0; kk < 128; ++kk) { const int k = W.wave * 128 + kk; const float wv = src[(size_t)k * Nsrc + col]; s += bflo(pk2(wv * gk[k], 0.f)); c += wv * bk[k]; }
        __syncthreads();
        red[(W.wave * 64 + W.lane) * 2] = s; red[(W.wave * 64 + W.lane) * 2 + 1] = c;
        __syncthreads();
        if (W.wave == 0) { float ss = 0.f, cc = 0.f;
#pragma unroll
            for (int w8 = 0; w8 < 8; ++w8) { ss += red[(w8 * 64 + W.lane) * 2]; cc += red[(w8 * 64 + W.lane) * 2 + 1]; }
            const int o = (ffn ? 0 : 5632) + n; SV[o] = ss; CV[o] = cc; }
    }
}
__device__ __forceinline__ void p0_prologue(const WInfo& W, LAS unsigned char* lds, const float* const* in, unsigned char* ws) {
    p0_weights(W, lds, in, ws, NITEMS_MOE, NITEMS_MOE + I_WIN0);
    const size_t gtid = (size_t)W.gw * 64 + W.lane, NT = (size_t)W.NGW * 64;
    { bf16* WL = (bf16*)(ws + WS_WLORA);
      for (size_t i = gtid; i < (size_t)1536 * 256; i += NT) { const int n = (int)(i >> 8), k = (int)(i & 255), s = n >> 9, ch = n & 511; float v = 0.f;
          if (s == 0) { if (k < 64) v = in[6][k * 512 + ch]; } else if (s == 1) { if (k >= 64 && k < 128) v = in[8][(k - 64) * 512 + ch]; } else { if (k >= 128) v = in[9][(k - 128) * 512 + ch]; }
          WL[i] = (bf16)f2bf(v); } }
    { const f32x4* x4 = (const f32x4*)in[0]; v4u* xb = (v4u*)(ws + WS_B0);
      for (size_t i = gtid; i < (size_t)T_ * D_ / 8; i += NT) { const f32x4 a = x4[2 * i], b = x4[2 * i + 1]; v4u o; o.x = pk2(a[0], a[1]); o.y = pk2(a[2], a[3]); o.z = pk2(b[0], b[1]); o.w = pk2(b[2], b[3]); xb[i] = o; } }
    { int* pm = (int*)(ws + WS_PERM); for (size_t i = gtid; i < (size_t)2 * PERMLEN; i += NT) pm[i] = -1; }
}

__device__ __forceinline__ void deferred_work(const WInfo& W, LAS unsigned char* lds, const float* const* in, unsigned char* ws, unsigned* qctr) {
    constexpr int ITEM0 = NITEMS_MOE + I_WIN0, NCH = (NITEMS - ITEM0 + 7) / 8;
    LAS int* qsh = (LAS int*)(lds + RING_BYTES);
    for (;;) {
        __syncthreads();
        if (W.tid == 0) qsh[0] = (int)__hip_atomic_fetch_add(qctr, 1u, __ATOMIC_RELAXED, __HIP_MEMORY_SCOPE_AGENT);
        __syncthreads();
        const int q = qsh[0]; if (q >= 136 + NCH) break;
        if (q < 136) lnvec_block(W, lds, in, ws, q);
        else { const int it = ITEM0 + (q - 136) * 8 + W.wave; if (it < NITEMS) weight_item(W, lds, in, ws, it); }
    }
}
#define MFMA32(a, b, c) __builtin_amdgcn_mfma_f32_32x32x16_bf16((a), (b), (c), 0, 0, 0)
__device__ __forceinline__ void attn_phase(const WInfo& W, LAS unsigned char* lds, const bf16* Z, bf16* MIX, const float* sinks, const float* relb, unsigned* qctr) {
    LAS bf16* Ks = (LAS bf16*)lds;
    LAS bf16* Vt = (LAS bf16*)(lds + 36864);
    LAS float* BT = (LAS float*)(lds + 36864 + 33280);
    const int tid = W.tid, lane = W.lane, w = W.wave, r32 = lane & 31, hh = lane >> 5;
    LAS float* BB = (LAS float*)(lds + 36864 + 33280 + 16 * 388 * 4);
    for (int i = tid; i < 1024; i += 512) { const int hq = i >> 7, dist = i & 127; int bucket = dist;
        if (dist >= 16) { const float lr = logf((float)dist / 16.0f) / 2.0794415416798357f; bucket = 16 + (int)(lr * 16.0f); if (bucket > 31) bucket = 31; }
        BB[i] = relb[bucket * 8 + hq] * LOG2E; }
    int last_kvh = -1;
    LAS int* qsh = (LAS int*)(lds + RING_BYTES);
    if (tid == 0) qsh[0] = (int)__hip_atomic_fetch_add(qctr, 1u, __ATOMIC_RELAXED, __HIP_MEMORY_SCOPE_AGENT);
    for (;;) {
        __syncthreads();
        const int u = qsh[0];
        __syncthreads();
        if (u >= 512) break;
        if (tid == 0) qsh[0] = (int)__hip_atomic_fetch_add(qctr, 1u, __ATOMIC_RELAXED, __HIP_MEMORY_SCOPE_AGENT);
        const int b = u >> 6, kvh = (u >> 5) & 1, nb = u & 31;
        if (kvh != last_kvh) { last_kvh = kvh;
            for (int i = tid; i < 16 * 388; i += 512) { const int k = i / (4 * 388), g = (i / 388) & 3, y = i % 388, x = y + k - 128;
                BT[i] = (x >= 1 && x <= 128) ? BB[(kvh * 4 + g) * 128 + (128 - x)] : 0.f; } }
        { const int key = tid >> 1, half = tid & 1, s = nb * 128 - 128 + key;
          v4u kq[4], vq[4];
          if (s >= 0) { const bf16* zr = Z + (size_t)(b * SEQ + s) * NZ;
#pragma unroll
              for (int j = 0; j < 4; ++j) { kq[j] = *(const v4u*)(zr + 512 + kvh * 64 + half * 32 + 8 * j); vq[j] = *(const v4u*)(zr + 640 + kvh * 64 + half * 32 + 8 * j); } }
          else {
#pragma unroll
              for (int j = 0; j < 4; ++j) { kq[j] = (v4u){0u, 0u, 0u, 0u}; vq[j] = (v4u){0u, 0u, 0u, 0u}; } }
#pragma unroll
          for (int j = 0; j < 4; ++j) { *(LAS v4u*)(Ks + key * 72 + half * 32 + 8 * j) = kq[j];
#pragma unroll
              for (int e = 0; e < 4; ++e) { const unsigned wv = vq[j][e]; const int d = half * 32 + 8 * j + 2 * e; Vt[d * 260 + key] = (bf16)(wv & 0xffffu); Vt[(d + 1) * 260 + key] = (bf16)(wv >> 16); } } }
        __syncthreads();
        const int g = w >> 1, rh = w & 1, habs = kvh * 4 + g;
        bf16x8 qf[2][4]; int qi[2]; size_t mq[2];
#pragma unroll
        for (int qt = 0; qt < 2; ++qt) { qi[qt] = 64 * rh + 32 * qt + r32; mq[qt] = (size_t)(b * SEQ + nb * 128 + qi[qt]);
#pragma unroll
            for (int s = 0; s < 4; ++s) qf[qt][s] = *(const bf16x8*)(Z + mq[qt] * NZ + habs * 64 + 16 * s + 8 * hh); }
        const float sinkl = sinks[habs] * LOG2E;
        float mrun[2] = {sinkl, sinkl}, lsum[2] = {hh == 0 ? 1.f : 0.f, hh == 0 ? 1.f : 0.f};
        f32x16 ot[2][2];
#pragma unroll
        for (int a = 0; a < 2; ++a)
#pragma unroll
            for (int c = 0; c < 2; ++c)
#pragma unroll
                for (int i = 0; i < 16; ++i) ot[a][c][i] = 0.f;
        for (int ks = 2 * rh; ks < 2 * rh + 6; ++ks) {
            bool act[2], full[2];
#pragma unroll
            for (int qt = 0; qt < 2; ++qt) { const int q0 = 64 * rh + 32 * qt, q1 = q0 + 31, k0 = 32 * ks, k1 = k0 + 31;
                act[qt] = (k1 - q0 >= 1) && (k0 - q1 <= 128) && (nb > 0 || k1 >= 128);
                full[qt] = (k0 - q1 >= 1) && (k1 - q0 <= 128) && (nb > 0 || k0 >= 128); }
            if (!act[0] && !act[1]) continue;
            f32x16 sc[2];
#pragma unroll
            for (int qt = 0; qt < 2; ++qt)
#pragma unroll
                for (int i = 0; i < 16; ++i) sc[qt][i] = 0.f;
#pragma unroll
            for (int s = 0; s < 4; ++s) { const bf16x8 kf = *(const LAS bf16x8*)(Ks + (32 * ks + r32) * 72 + 16 * s + 8 * hh);
                if (act[0]) sc[0] = MFMA32(kf, qf[0][s], sc[0]); if (act[1]) sc[1] = MFMA32(kf, qf[1][s], sc[1]); }
            bf16x8 pf[2][2];
#pragma unroll
            for (int qt = 0; qt < 2; ++qt) if (act[qt]) {
                float mx = -1e30f;
#pragma unroll
                for (int c = 0; c < 4; ++c) { const int kbase = 32 * ks + 8 * c + 4 * hh, xbase = kbase - qi[qt], X = xbase + 128, kk = X & 3, y = X - kk;
                    const f32x4 b4 = *(const LAS f32x4*)(BT + (kk * 4 + g) * 388 + y);
                    if (full[qt]) {
#pragma unroll
                        for (int j = 0; j < 4; ++j) { const float t = sc[qt][4 * c + j] * (0.125f * LOG2E) + b4[j]; sc[qt][4 * c + j] = t; mx = fmaxf(mx, t); }
                    } else {
#pragma unroll
                        for (int j = 0; j < 4; ++j) { const int x = xbase + j; const bool valid = (x >= 1) && (x <= 128) && (nb > 0 || kbase + j >= 128);
                            const float t = valid ? (sc[qt][4 * c + j] * (0.125f * LOG2E) + b4[j]) : -1e30f; sc[qt][4 * c + j] = t; mx = fmaxf(mx, t); } } }
                mx = fmaxf(mx, __shfl_xor(mx, 32));
                const float mnew = fmaxf(mrun[qt], mx), corr = __builtin_amdgcn_exp2f(mrun[qt] - mnew); mrun[qt] = mnew;
                float ps = 0.f;
#pragma unroll
                for (int i = 0; i < 16; ++i) { const float p = __builtin_amdgcn_exp2f(sc[qt][i] - mnew); sc[qt][i] = p; ps += p; }
                lsum[qt] = lsum[qt] * corr + ps;
#pragma unroll
                for (int dt = 0; dt < 2; ++dt)
#pragma unroll
                    for (int i = 0; i < 16; ++i) ot[dt][qt][i] *= corr;
#pragma unroll
                for (int s2 = 0; s2 < 2; ++s2) { v4u pk;
#pragma unroll
                    for (int e = 0; e < 4; ++e) pk[e] = pk2(sc[qt][8 * s2 + 2 * e], sc[qt][8 * s2 + 2 * e + 1]);
                    pf[qt][s2] = __builtin_bit_cast(bf16x8, pk); } }
#pragma unroll
            for (int dt = 0; dt < 2; ++dt)
#pragma unroll
                for (int s2 = 0; s2 < 2; ++s2) { const int kb0 = 32 * ks + 16 * s2, d = 32 * dt + r32;
                    const s16x4 lo = *(const LAS s16x4*)(Vt + d * 260 + kb0 + 4 * hh), hi = *(const LAS s16x4*)(Vt + d * 260 + kb0 + 8 + 4 * hh);
                    const bf16x8 vf = __builtin_shufflevector(lo, hi, 0, 1, 2, 3, 4, 5, 6, 7);
                    if (act[0]) ot[dt][0] = MFMA32(vf, pf[0][s2], ot[dt][0]); if (act[1]) ot[dt][1] = MFMA32(vf, pf[1][s2], ot[dt][1]); }
        }
#pragma unroll
        for (int qt = 0; qt < 2; ++qt) { const float lt = lsum[qt] + __shfl_xor(lsum[qt], 32), inv = 1.0f / lt;
#pragma unroll
            for (int dt = 0; dt < 2; ++dt)
#pragma unroll
                for (int c = 0; c < 4; ++c) { const int d0 = 32 * dt + 8 * c + 4 * hh; v2u o; o.x = pk2(ot[dt][qt][4 * c] * inv, ot[dt][qt][4 * c + 1] * inv); o.y = pk2(ot[dt][qt][4 * c + 2] * inv, ot[dt][qt][4 * c + 3] * inv);
                    *(v2u*)(MIX + mq[qt] * D_ + habs * 64 + d0) = o; } }
    }
}

__device__ __forceinline__ void aprime_phase(const WInfo& W, const bf16* Z, bf16* AP, const float* mu) {
    const int c = 4 * W.lane;
    const f32x4 m4 = *(const f32x4*)(mu + 1536 + c);
#pragma unroll 4
    for (int m = W.gw; m < T_; m += W.NGW) {
        const v2u zc = *(const v2u*)(Z + (size_t)m * NZ + 2304 + c);
        v2u zp = (v2u){0u, 0u}; if ((m & (SEQ - 1)) != 0) zp = *(const v2u*)(Z + (size_t)(m - 1) * NZ + 2304 + c);
        float z[4] = {bflo(zc.x), bfhi(zc.x), bflo(zc.y), bfhi(zc.y)}, p[4] = {bflo(zp.x), bfhi(zp.x), bflo(zp.y), bfhi(zp.y)}, o[4];
#pragma unroll
        for (int j = 0; j < 4; ++j) { const float v = z[j] + (p[j] - z[j]) * m4[j]; o[j] = c < 64 ? tanhf(v) : (c < 128 ? v : 1.0f / (1.0f + __expf(-v))); }
        v2u w; w.x = pk2(o[0], o[1]); w.y = pk2(o[2], o[3]); *(v2u*)(AP + (size_t)m * 256 + c) = w;
    }
}

constexpr int SL_W = 0, SL_R = 2048, SL_BKT = 4096, SL_ARBK = 8192, SL_M1 = 9216, SL_PC = 9728, SLOT_BYTES = 10240;
static_assert(WS_SLOT + (size_t)64 * 256 * SLOT_BYTES <= WS_B0, "slots end below the activation buffers");
#define MFMA16(a, b, c) __builtin_amdgcn_mfma_f32_16x16x32_bf16((a), (b), (c), 0, 0, 0)
__device__ __forceinline__ bf16x8 mk8(v2u lo, v2u hi) { v4u q; q.x = lo.x; q.y = lo.y; q.z = hi.x; q.w = hi.y; return __builtin_bit_cast(bf16x8, q); }
struct S1In { unsigned short zr[17], zk[17], av[16]; float wl[16]; };
__device__ __forceinline__ void s1_load(S1In& o, int unit, int lane, const bf16* Z, const float* WLOG, const bf16* AB) {
    const int c = 255 - (unit >> 6), bh = unit & 63, h = bh & 7, b = bh >> 3, chn = h * 64 + lane; const size_t m0 = (size_t)b * SEQ + c * 16;
    const bf16* zp = Z + (m0 - (c > 0 ? 1 : 0)) * NZ + 768 + chn; o.zr[0] = zp[0]; o.zk[0] = zp[512];
#pragma unroll
    for (int t = 0; t < 16; ++t) { const bf16* zc = Z + (m0 + t) * NZ + 768 + chn; o.zr[1 + t] = zc[0]; o.zk[1 + t] = zc[512]; o.wl[t] = WLOG[(m0 + t) * 512 + chn]; o.av[t] = AB[(m0 + t) * 512 + chn]; }
}
__device__ __forceinline__ void scan_prep_phase(const WInfo& W, LAS unsigned char* lds, const bf16* Z, const float* WLOG, const bf16* AB, unsigned char* slots, float* bonus,
                                                const float* mu, const float* k_k, const float* k_a, const float* r_k) {
    LAS unsigned char* sc = lds + W.wave * 16384;
    LAS bf16* RT = (LAS bf16*)sc; LAS bf16* AT = (LAS bf16*)(sc + 2304); LAS bf16* BT = (LAS bf16*)(sc + 4608); LAS bf16* KT = (LAS bf16*)(sc + 6912);
    LAS bf16* ATT = (LAS bf16*)(sc + 9216);
    LAS float* AAB = (LAS float*)(sc + 11264);
    LAS bf16* M1x = (LAS bf16*)(sc + 11264);
    LAS bf16* TT = (LAS bf16*)(sc + 12288);
    LAS bf16* WW = (LAS bf16*)(sc + 12800);
    LAS bf16* ARx = (LAS bf16*)(sc + 15104);
    const int lane = W.lane, fr = lane & 15, g = lane >> 4;
    S1In cur, nxt;
    if (W.gw < 64 * 256) s1_load(nxt, W.gw, lane, Z, WLOG, AB);
    for (int unit = W.gw; unit < 64 * 256; unit += W.NGW) {
        const int c = 255 - (unit >> 6), bh = unit & 63, h = bh & 7, b = bh >> 3;
        const int chn = h * 64 + lane; const size_t m0 = (size_t)b * SEQ + c * 16;
        unsigned char* slot = slots + (size_t)(bh * 256 + c) * SLOT_BYTES;
        const float mu_r = mu[chn], mu_k = mu[512 + chn], kkc = k_k[chn], kac = k_a[chn], rkc = r_k[chn];
        cur = nxt;
        if (unit + W.NGW < 64 * 256) s1_load(nxt, unit + W.NGW, lane, Z, WLOG, AB);
        float pr = (c > 0) ? bf2f(cur.zr[0]) : 0.f, pk = (c > 0) ? bf2f(cur.zk[0]) : 0.f;
        float lw = 0.f, Pprev = 1.f, bsave = 0.f, Pt = 1.f;
        unsigned apk[8], bpk[8], kpk[8]; float ah = 0.f, bh2 = 0.f, kh = 0.f;
#pragma unroll
        for (int t = 0; t < 16; ++t) {
            const float zr = bf2f(cur.zr[1 + t]), zk = bf2f(cur.zk[1 + t]); const float wl = cur.wl[t], av = bf2f(cur.av[t]);
            const float r = zr + (pr - zr) * mu_r, kz = zk + (pk - zk) * mu_k; pr = zr; pk = zk;
            float kk = kz * kkc; const float nrm = sqrtf(wave_sum_fast(kk * kk)); kk = kk * __builtin_amdgcn_rcpf(fmaxf(nrm, 1e-12f));
            const float k2 = kz * (1.0f + (av - 1.0f) * kac);
            const float bo = wave_sum_fast(r * k2 * rkc); if (lane == t) bsave = bo;
            lw += wl; Pt = __expf(lw); const float iP = __expf(-lw);
            const float rt = r * Pt, kt = k2 * iP, at = -kk * Pprev, bt = kk * av * iP; Pprev = Pt;
            { const unsigned ra = pk2(rt, at), bk = pk2(bt, kt); RT[t * 72 + lane] = (bf16)(ra & 0xffffu); AT[t * 72 + lane] = (bf16)(ra >> 16); BT[t * 72 + lane] = (bf16)(bk & 0xffffu); KT[t * 72 + lane] = (bf16)(bk >> 16); }
            if (t & 1) { apk[t >> 1] = pk2(ah, at); bpk[t >> 1] = pk2(bh2, bt); kpk[t >> 1] = pk2(kh, kt); } else { ah = at; bh2 = bt; kh = kt; }
        }
        *(LAS v4u*)(ATT + lane * 16) = (v4u){apk[0], apk[1], apk[2], apk[3]}; *(LAS v4u*)(ATT + lane * 16 + 8) = (v4u){apk[4], apk[5], apk[6], apk[7]};
#pragma unroll
        for (int gg = 0; gg < 4; ++gg) *(v4u*)(slot + SL_BKT + ((lane >> 4) * 64 + gg * 16 + (lane & 15)) * 16) = (v4u){bpk[2 * gg], bpk[2 * gg + 1], kpk[2 * gg], kpk[2 * gg + 1]};
        *(float*)(slot + SL_PC + lane * 4) = Pt;
        if (lane < 16) bonus[(m0 + lane) * 8 + h] = bsave;
        LDS_WAIT(); asm volatile("" ::: "memory");
        f32x4 Aab = (f32x4){0.f, 0.f, 0.f, 0.f}, Aak = Aab, Arb = Aab, Ark = Aab;
#pragma unroll
        for (int s = 0; s < 2; ++s) { const int o = fr * 72 + 32 * s + 8 * g;
            const bf16x8 af = *(const LAS bf16x8*)(AT + o), rf = *(const LAS bf16x8*)(RT + o), bb = *(const LAS bf16x8*)(BT + o), kb = *(const LAS bf16x8*)(KT + o);
            Aab = MFMA16(af, bb, Aab); Aak = MFMA16(af, kb, Aak); Arb = MFMA16(rf, bb, Arb); Ark = MFMA16(rf, kb, Ark); }
#pragma unroll
        for (int rg = 0; rg < 4; ++rg) { const int t = 4 * g + rg; const bool lo = fr < t, le = fr <= t;
            Aab[rg] = lo ? Aab[rg] : 0.f; Aak[rg] = lo ? Aak[rg] : 0.f; Arb[rg] = le ? Arb[rg] : 0.f; Ark[rg] = le ? Ark[rg] : 0.f;
            AAB[t * 16 + fr] = Aab[rg]; { const unsigned rk = pk2(Arb[rg], Ark[rg]); ARx[t * 16 + fr] = (bf16)(rk & 0xffffu); ARx[256 + t * 16 + fr] = (bf16)(rk >> 16); } }
        LDS_WAIT(); asm volatile("" ::: "memory");
        float Tc[16];
#pragma unroll
        for (int t = 0; t < 16; ++t) { float acc = (t == fr) ? 1.f : 0.f;
#pragma unroll
            for (int q4 = 0; q4 < (t + 3) / 4; ++q4) { const f32x4 a4 = *(const LAS f32x4*)(AAB + t * 16 + 4 * q4);
#pragma unroll
                for (int e = 0; e < 4; ++e) if (4 * q4 + e < t) acc += a4[e] * Tc[4 * q4 + e]; }
            Tc[t] = acc; }
#pragma unroll
        for (int t = 0; t < 16; t += 2) { const unsigned tt = pk2(Tc[t], Tc[t + 1]); TT[t * 16 + fr] = (bf16)(tt & 0xffffu); TT[(t + 1) * 16 + fr] = (bf16)(tt >> 16); }
        LDS_WAIT(); asm volatile("" ::: "memory");
        const v2u z2 = (v2u){0u, 0u};
        const bf16x8 Tf = mk8(*(const LAS v2u*)(TT + fr * 16 + 4 * g), z2);
        { v2u ak; ak.x = pk2(Aak[0], Aak[1]); ak.y = pk2(Aak[2], Aak[3]);
          const f32x4 M1 = MFMA16(Tf, mk8(ak, z2), ((f32x4){0.f, 0.f, 0.f, 0.f}));
          f32x4 Wt[4];
#pragma unroll
          for (int jt = 0; jt < 4; ++jt) Wt[jt] = MFMA16(Tf, mk8(*(const LAS v2u*)(ATT + (16 * jt + fr) * 16 + 4 * g), z2), ((f32x4){0.f, 0.f, 0.f, 0.f}));
#pragma unroll
          for (int rg = 0; rg < 4; ++rg) { const int t = 4 * g + rg; const unsigned w01 = pk2(Wt[0][rg], Wt[1][rg]), w23 = pk2(Wt[2][rg], Wt[3][rg]), m1 = pk2(M1[rg], 0.f); M1x[t * 16 + fr] = (bf16)(m1 & 0xffffu);
              WW[t * 72 + fr] = (bf16)(w01 & 0xffffu); WW[t * 72 + 16 + fr] = (bf16)(w01 >> 16); WW[t * 72 + 32 + fr] = (bf16)(w23 & 0xffffu); WW[t * 72 + 48 + fr] = (bf16)(w23 >> 16); } }
        LDS_WAIT(); asm volatile("" ::: "memory");
#pragma unroll
        for (int s = 0; s < 2; ++s) { const int o = fr * 72 + 32 * s + 4 * g;
            const v2u w0 = *(const LAS v2u*)(WW + o), w1 = *(const LAS v2u*)(WW + o + 16), r0 = *(const LAS v2u*)(RT + o), r1 = *(const LAS v2u*)(RT + o + 16);
            *(v4u*)(slot + SL_W + (s * 64 + lane) * 16) = (v4u){w0.x, w0.y, w1.x, w1.y}; *(v4u*)(slot + SL_R + (s * 64 + lane) * 16) = (v4u){r0.x, r0.y, r1.x, r1.y}; }
        { const v2u x0 = *(const LAS v2u*)(ARx + fr * 16 + 4 * g), x1 = *(const LAS v2u*)(ARx + 256 + fr * 16 + 4 * g), m1 = *(const LAS v2u*)(M1x + fr * 16 + 4 * g);
          *(v4u*)(slot + SL_ARBK + lane * 16) = (v4u){x0.x, x0.y, x1.x, x1.y}; *(v2u*)(slot + SL_M1 + lane * 8) = m1; }
        LDS_WAIT(); asm volatile("" ::: "memory");
    }
}
__device__ __forceinline__ void glds16(const void* gsrc, unsigned lds_dst) { unsigned keep;
    asm volatile("s_mov_b32 %0, m0\n\ts_mov_b32 m0, %2\n\ts_nop 0\n\tglobal_load_lds_dwordx4 %1, off\n\ts_mov_b32 m0, %0" : "=&s"(keep) : "v"(gsrc), "s"(lds_dst) : "memory"); }
struct ScanOps { bf16x8 Wf[2], Rf[2], Bk[4], ARBK; v2u M1; f32x4 PC[4]; unsigned vz[5]; unsigned pad; };
constexpr int S2_NS = 12, S2_D = 11, S2_VST = 2048;
__device__ __forceinline__ void scan_lds_load(ScanOps& o, const LAS unsigned char* st, const LAS unsigned char* vs, const LAS unsigned char* vprev, int lane, int g, int icol) {
#pragma unroll
    for (int s = 0; s < 2; ++s) { o.Wf[s] = *(const LAS bf16x8*)(st + SL_W + (s * 64 + lane) * 16); o.Rf[s] = *(const LAS bf16x8*)(st + SL_R + (s * 64 + lane) * 16); }
#pragma unroll
    for (int jt = 0; jt < 4; ++jt) { o.Bk[jt] = *(const LAS bf16x8*)(st + SL_BKT + (jt * 64 + lane) * 16); o.PC[jt] = *(const LAS f32x4*)(st + SL_PC + (16 * jt + 4 * g) * 4); }
    o.ARBK = *(const LAS bf16x8*)(st + SL_ARBK + lane * 16); o.M1 = *(const LAS v2u*)(st + SL_M1 + lane * 8);
    o.vz[0] = (unsigned)*(const LAS unsigned short*)((g == 0 ? vprev + 15 * 128 : vs + (4 * g - 1) * 128) + icol * 2);
#pragma unroll
    for (int j = 0; j < 4; ++j) o.vz[1 + j] = (unsigned)*(const LAS unsigned short*)(vs + (4 * g + j) * 128 + icol * 2);
    o.pad = 0u;
}
__device__ __forceinline__ void scan_issue(int cc, int lw, int lane, const unsigned char* sbase, const bf16* zvh, LAS unsigned char* ring, LAS unsigned char* vring) {
    const unsigned char* slot = sbase + (size_t)cc * SLOT_BYTES; LAS unsigned char* st = ring + (cc % S2_NS) * 10240; LAS unsigned char* vs = vring + (cc % S2_NS) * S2_VST;
#pragma unroll
    for (int k = 0; k < 3; ++k) { const int p = lw + 4 * k; if (p < 10) glds16(slot + p * 1024 + lane * 16, (unsigned)(size_t)(st + p * 1024)); }
    if (lw >= 2) { const int blk = lw - 2; const int r = cc * 16 + blk * 8 + (lane >> 3);
        glds16((const unsigned char*)(zvh + (size_t)r * NZ) + (lane & 7) * 16, (unsigned)(size_t)(vs + blk * 1024)); }
}
__device__ __forceinline__ void scan_seq_phase(const WInfo& W, LAS unsigned char* lds, const bf16* Z, const unsigned char* slots, float* YRAW, const float* mu) {
    const int id = blockIdx.x; if (id >= 64) return;
    const int lane = W.lane, fr = lane & 15, g = lane >> 4, w = W.wave;
    const int b = id >> 3, h = id & 7;
    LAS unsigned char* ring = lds; LAS unsigned char* vring = lds + S2_NS * 10240;
    const unsigned char* sbase = slots + (size_t)id * 256 * SLOT_BYTES;
    const bf16* zvh = Z + (size_t)b * SEQ * NZ + 1792 + h * 64;
    const bool loader = w >= 4; const int lw = w - 4;
    const int i = 16 * (w & 3) + fr;
    float mu_v = mu[1024 + h * 64 + i];
    VM_WAIT(); asm volatile("" : "+v"(mu_v));
    float* yb = YRAW + (size_t)b * SEQ * 512 + h * 64 + i;
#define S2_WAIT_AHEAD() asm volatile("s_waitcnt vmcnt(27)" ::: "memory")
    if (loader) { for (int cc = 0; cc < S2_D; ++cc) scan_issue(cc, lw, lane, sbase, zvh, ring, vring); S2_WAIT_AHEAD(); }
    __builtin_amdgcn_s_barrier();
    f32x4 st[4];
#pragma unroll
    for (int jt = 0; jt < 4; ++jt) st[jt] = (f32x4){0.f, 0.f, 0.f, 0.f};
    if (loader) {
        for (int c = 0; c < 256; ++c) {
            if (c + S2_D < 256) { scan_issue(c + S2_D, lw, lane, sbase, zvh, ring, vring); S2_WAIT_AHEAD(); } else asm volatile("s_waitcnt vmcnt(0)" ::: "memory");
            __builtin_amdgcn_s_barrier();
        }
    } else {
        ScanOps opA, opB;
        scan_lds_load(opA, ring, vring, vring, lane, g, i);
        LAS float* ybuf = (LAS float*)(lds + 147456);
        float* yo = YRAW + (size_t)b * SEQ * 512 + h * 64 + (size_t)(4 * w + g) * 512 + 4 * fr;
#define S2_STEP(c, CUR, NXT) do { \
            if ((c) + 1 < 256) scan_lds_load(NXT, ring + (((c) + 1) % S2_NS) * 10240, vring + (((c) + 1) % S2_NS) * S2_VST, vring + ((c) % S2_NS) * S2_VST, lane, g, i); \
            float vm[4]; const float zprev = ((c) == 0 && g == 0) ? 0.f : bf2f((unsigned short)CUR.vz[0]); \
            _Pragma("unroll") for (int j = 0; j < 4; ++j) { const float zc = bf2f((unsigned short)CUR.vz[1 + j]), zp = (j == 0) ? zprev : bf2f((unsigned short)CUR.vz[j]); vm[j] = zc + (zp - zc) * mu_v; } \
            v2u vb; vb.x = pk2(vm[0], vm[1]); vb.y = pk2(vm[2], vm[3]); const v2u z2 = (v2u){0u, 0u}; bf16x8 Sb[2]; \
            _Pragma("unroll") for (int s = 0; s < 2; ++s) { v2u lo, hi; lo.x = pk2(st[2 * s][0], st[2 * s][1]); lo.y = pk2(st[2 * s][2], st[2 * s][3]); hi.x = pk2(st[2 * s + 1][0], st[2 * s + 1][1]); hi.y = pk2(st[2 * s + 1][2], st[2 * s + 1][3]); Sb[s] = mk8(lo, hi); } \
            f32x4 U = MFMA16(CUR.Wf[0], Sb[0], ((f32x4){0.f, 0.f, 0.f, 0.f})); U = MFMA16(CUR.Wf[1], Sb[1], U); U = MFMA16(mk8(CUR.M1, z2), mk8(vb, z2), U); \
            f32x4 Y = MFMA16(CUR.Rf[0], Sb[0], ((f32x4){0.f, 0.f, 0.f, 0.f})); Y = MFMA16(CUR.Rf[1], Sb[1], Y); \
            v2u ub; ub.x = pk2(U[0], U[1]); ub.y = pk2(U[2], U[3]); const bf16x8 UV = mk8(ub, vb); \
            Y = MFMA16(CUR.ARBK, UV, Y); \
            _Pragma("unroll") for (int jt = 0; jt < 4; ++jt) { const f32x4 a = MFMA16(CUR.Bk[jt], UV, st[jt]); st[jt] = a * CUR.PC[jt]; } \
            if ((c) > 0) { const f32x4 yv = *(const LAS f32x4*)(ybuf + (((c) - 1) & 1) * 1024 + (4 * w + g) * 64 + 4 * fr); *(f32x4*)(yo + (size_t)(((c) - 1) * 16) * 512) = yv; } \
            _Pragma("unroll") for (int rg = 0; rg < 4; ++rg) ybuf[((c) & 1) * 1024 + (4 * g + rg) * 64 + i] = Y[rg]; \
            LDS_WAIT(); \
            __builtin_amdgcn_s_barrier(); } while (0)
        for (int c = 0; c < 256; c += 2) { S2_STEP(c, opA, opB); S2_STEP(c + 1, opB, opA); }
#undef S2_STEP
        { const f32x4 yv = *(const LAS f32x4*)(ybuf + 1024 + (4 * w + g) * 64 + 4 * fr); *(f32x4*)(yo + (size_t)(255 * 16) * 512) = yv; }
    }
    VM_WAIT();
    __builtin_amdgcn_s_barrier();
#undef S2_WAIT_AHEAD
}

__device__ __forceinline__ float sum8(float x) { x += dpp_mov<0xB1>(x); x += dpp_mov<0x4E>(x); x += dpp_mov<0x141>(x); return x; }
__device__ __forceinline__ void post_phase(const WInfo& W, const bf16* Z, const bf16* GBUF, const float* YRAW, const float* bonus, bf16* MIX,
                                           const float* mu, const float* gn_g, const float* gn_b) {
    const int lane = W.lane, c0 = 8 * lane, h = lane >> 3;
    float muv[8], gg[8], gb[8];
#pragma unroll
    for (int j = 0; j < 8; ++j) { muv[j] = mu[1024 + c0 + j]; gg[j] = gn_g[c0 + j]; gb[j] = gn_b[c0 + j]; }
#pragma unroll 2
    for (int m = W.gw; m < T_; m += W.NGW) {
        const bool first = (m & (SEQ - 1)) == 0;
        const v4u zc = *(const v4u*)(Z + (size_t)m * NZ + 1792 + c0);
        v4u zp = (v4u){0u, 0u, 0u, 0u}; if (!first) zp = *(const v4u*)(Z + (size_t)(m - 1) * NZ + 1792 + c0);
        const v4u gq = *(const v4u*)(GBUF + (size_t)m * 512 + c0);
        const f32x4 y0 = *(const f32x4*)(YRAW + (size_t)m * 512 + c0), y1 = *(const f32x4*)(YRAW + (size_t)m * 512 + c0 + 4);
        const float bo = bonus[(size_t)m * 8 + h];
        float y[8] = {y0[0], y0[1], y0[2], y0[3], y1[0], y1[1], y1[2], y1[3]};
        float s = 0.f;
#pragma unroll
        for (int j = 0; j < 8; ++j) s += y[j];
        const float mean = sum8(s) * (1.0f / 64.0f); float q = 0.f;
#pragma unroll
        for (int j = 0; j < 8; ++j) { y[j] -= mean; q += y[j] * y[j]; }
        const float rstd = rsqrtf(sum8(q) * (1.0f / 64.0f) + GN_EPS);
        float o[8];
#pragma unroll
        for (int j = 0; j < 8; ++j) { const unsigned zw = zc[j >> 1], pw = zp[j >> 1], gw2 = gq[j >> 1];
            const float zv = (j & 1) ? bfhi(zw) : bflo(zw), pv = (j & 1) ? bfhi(pw) : bflo(pw), gv = (j & 1) ? bfhi(gw2) : bflo(gw2);
            const float v = zv + (pv - zv) * muv[j];
            o[j] = (y[j] * rstd * gg[j] + gb[j] + bo * v) * gv; }
        v4u ov; ov.x = pk2(o[0], o[1]); ov.y = pk2(o[2], o[3]); ov.z = pk2(o[4], o[5]); ov.w = pk2(o[6], o[7]);
        *(v4u*)(MIX + (size_t)m * D_ + 512 + c0) = ov;
    }
}

__device__ __forceinline__ void ln_compute(f32x4 (&v)[4], const f32x4 (&g)[4], const f32x4 (&bb)[4]) {
    float s = 0.f;
#pragma unroll
    for (int j = 0; j < 4; ++j) s += (v[j][0] + v[j][1]) + (v[j][2] + v[j][3]);
    const float mean = wave_sum_fast(s) * (1.f / D_); float s2 = 0.f;
#pragma unroll
    for (int j = 0; j < 4; ++j) { v[j] = v[j] - mean; s2 += (v[j][0] * v[j][0] + v[j][1] * v[j][1]) + (v[j][2] * v[j][2] + v[j][3] * v[j][3]); }
    const float rstd = rsqrtf(wave_sum_fast(s2) * (1.f / D_) + LN_EPS);
#pragma unroll
    for (int j = 0; j < 4; ++j) v[j] = v[j] * rstd * g[j] + bb[j];
}
__device__ __forceinline__ void ln_phase(const WInfo& W, float* X, bf16* XB, const float* gam, const float* bet, const bf16* ADD = nullptr) {
    f32x4 g[4], bb[4];
#pragma unroll
    for (int j = 0; j < 4; ++j) { g[j] = *(const f32x4*)(gam + 4 * W.lane + 256 * j); bb[j] = *(const f32x4*)(bet + 4 * W.lane + 256 * j); }
    for (int m = W.gw; m < T_; m += 2 * W.NGW) {
        const int m2 = m + W.NGW;
        f32x4* xr = (f32x4*)(X + (size_t)m * D_) + W.lane; f32x4* xr2 = (f32x4*)(X + (size_t)m2 * D_) + W.lane; f32x4 v[4], v2[4]; v2u a[4], a2[4];
#pragma unroll
        for (int j = 0; j < 4; ++j) { v[j] = xr[64 * j]; v2[j] = xr2[64 * j]; }
        if (ADD) { const v2u* ar = (const v2u*)(ADD + (size_t)m * D_) + W.lane; const v2u* ar2 = (const v2u*)(ADD + (size_t)m2 * D_) + W.lane;
#pragma unroll
            for (int j = 0; j < 4; ++j) { a[j] = ar[64 * j]; a2[j] = ar2[64 * j]; }
#pragma unroll
            for (int j = 0; j < 4; ++j) { v[j][0] += bflo(a[j].x); v[j][1] += bfhi(a[j].x); v[j][2] += bflo(a[j].y); v[j][3] += bfhi(a[j].y);
                                          v2[j][0] += bflo(a2[j].x); v2[j][1] += bfhi(a2[j].x); v2[j][2] += bflo(a2[j].y); v2[j][3] += bfhi(a2[j].y); } }
        ln_compute(v, g, bb); ln_compute(v2, g, bb);
#pragma unroll
        for (int j = 0; j < 4; ++j) { xr[64 * j] = v[j]; xr2[64 * j] = v2[j]; }
        if (XB) { v2u* o8 = (v2u*)(XB + (size_t)m * D_) + W.lane; v2u* o82 = (v2u*)(XB + (size_t)m2 * D_) + W.lane;
#pragma unroll
            for (int j = 0; j < 4; ++j) { v2u o; o.x = pk2(v[j][0], v[j][1]); o.y = pk2(v[j][2], v[j][3]); o8[64 * j] = o; o.x = pk2(v2[j][0], v2[j][1]); o.y = pk2(v2[j][2], v2[j][3]); o82[64 * j] = o; } }
    }
}
__device__ __forceinline__ void ln_router_phase(const WInfo& W, LAS unsigned char* lds, float* X, bf16* XB, const float* gam, const float* bet, const float* rw, int* toke, float* tokp, int* wgcnt) {
    LAS float* RW = (LAS float*)lds;
    LAS int* CNT = (LAS int*)(lds + 32768);
    for (int i = W.tid; i < 8192; i += 512) RW[i] = rw[i];
    if (W.tid < 16) CNT[W.tid] = 0;
    __syncthreads();
    f32x4 g[4], bb[4];
#pragma unroll
    for (int j = 0; j < 4; ++j) { g[j] = *(const f32x4*)(gam + 4 * W.lane + 256 * j); bb[j] = *(const f32x4*)(bet + 4 * W.lane + 256 * j); }
    for (int wg = blockIdx.x; wg < 256; wg += W.G) {
        f32x4 nv[4];
        { const f32x4* x0 = (const f32x4*)(X + (size_t)(wg * 128 + W.wave * 16) * D_) + W.lane;
#pragma unroll
          for (int j = 0; j < 4; ++j) nv[j] = x0[64 * j]; }
        for (int i = 0; i < 16; ++i) {
            const int m = wg * 128 + W.wave * 16 + i;
            f32x4* xr = (f32x4*)(X + (size_t)m * D_) + W.lane; f32x4 v[4];
#pragma unroll
            for (int j = 0; j < 4; ++j) v[j] = nv[j];
            if (i + 1 < 16) {
#pragma unroll
                for (int j = 0; j < 4; ++j) nv[j] = xr[256 + 64 * j]; }
            asm volatile("" ::: "memory");
            ln_compute(v, g, bb);
#pragma unroll
            for (int j = 0; j < 4; ++j) xr[64 * j] = v[j];
            { unsigned* o4 = (unsigned*)((unsigned char*)XB + (size_t)m * D_) + W.lane;
#pragma unroll
              for (int j = 0; j < 4; ++j) o4[64 * j] = pg8::pk4_fp8(v[j][0], v[j][1], v[j][2], v[j][3]); }
            float lg[8];
#pragma unroll
            for (int e = 0; e < 8; ++e) lg[e] = 0.f;
#pragma unroll
            for (int j = 0; j < 4; ++j)
#pragma unroll
                for (int jj = 0; jj < 4; ++jj) { const int c = 4 * W.lane + 256 * j + jj; const f32x4 r0 = *(const LAS f32x4*)(RW + c * 8), r1 = *(const LAS f32x4*)(RW + c * 8 + 4); const float x = v[j][jj];
                    lg[0] += x * r0[0]; lg[1] += x * r0[1]; lg[2] += x * r0[2]; lg[3] += x * r0[3]; lg[4] += x * r1[0]; lg[5] += x * r1[1]; lg[6] += x * r1[2]; lg[7] += x * r1[3]; }
#pragma unroll
            for (int e = 0; e < 8; ++e) lg[e] = wave_sum_fast(lg[e]);
            int e1 = 0; float v1 = lg[0];
#pragma unroll
            for (int e = 1; e < 8; ++e) if (lg[e] > v1) { v1 = lg[e]; e1 = e; }
            int e2 = -1; float v2 = -3.0e38f;
#pragma unroll
            for (int e = 0; e < 8; ++e) if (e != e1 && lg[e] > v2) { v2 = lg[e]; e2 = e; }
            const float p2 = 1.0f / (1.0f + __expf(v1 - v2)), p1 = 1.0f - p2;
            if (W.lane == 0) { toke[m] = e1 | (e2 << 8); tokp[2 * m] = p1; tokp[2 * m + 1] = p2; atomicAdd((int*)(CNT + e1), 1); atomicAdd((int*)(CNT + 8 + e2), 1); }
        }
        __syncthreads();
        if (W.tid < 16) { wgcnt[wg * 16 + W.tid] = CNT[W.tid]; CNT[W.tid] = 0; }
        __syncthreads();
    }
}
__device__ __forceinline__ void route_phase(const WInfo& W, LAS unsigned char* lds, const int* toke, const int* wgcnt, int* perm, int* ptab) {
    LAS int* C = (LAS int*)lds;
    LAS int* TOT = (LAS int*)(lds + 16384);
    LAS int* PRE = TOT + 16;
    LAS int* OFF = TOT + 32;
    LAS int* CTR = TOT + 48;
    for (int wg = blockIdx.x; wg < 256; wg += W.G) {
        __syncthreads();
        for (int i = W.tid; i < 4096; i += 512) C[i] = wgcnt[i];
        if (W.tid < 16) CTR[W.tid] = 0;
        __syncthreads();
        if (W.tid < 16) { int tot = 0, pre = 0; for (int k = 0; k < 256; ++k) { const int c = C[k * 16 + W.tid]; tot += c; if (k < wg) pre += c; } TOT[W.tid] = tot; PRE[W.tid] = pre; }
        __syncthreads();
        if (W.tid == 0) { int cnt = 0, npass[2];
            for (int p = 0; p < 2; ++p) { int base = 0, np = 0;
                for (int e = 0; e < 8; ++e) { OFF[p * 8 + e] = p * PERMLEN + base + PRE[p * 8 + e]; const int pn = (TOT[p * 8 + e] + 255) >> 8;
                    if (wg == 0) for (int k = 0; k < pn; ++k) ptab[2 + cnt + k] = ((p * MAXPANEL + np + k) << 8) | e;
                    cnt += pn; np += pn; base += pn * 256; }
                npass[p] = np; }
            if (wg == 0) { ptab[0] = npass[0]; ptab[1] = npass[1]; } }
        __syncthreads();
        if (W.tid < 128) { const int m = wg * 128 + W.tid, te = toke[m], e1 = te & 255, e2 = te >> 8;
            const int s1 = OFF[e1] + atomicAdd((int*)(CTR + e1), 1); perm[s1] = m;
            const int s2 = OFF[8 + e2] + atomicAdd((int*)(CTR + 8 + e2), 1); perm[s2] = m; }
    }
}
__device__ __forceinline__ void conv_phase(const WInfo& W, const bf16* GB, const bf16* UP, bf16* CV, const float* cw) {
    const size_t gtid = (size_t)W.gw * 64 + W.lane, NT = (size_t)W.NGW * 64;
#pragma unroll 4
    for (size_t i = gtid; i < (size_t)T_ * D_ / 8; i += NT) {
        const int m = (int)(i >> 7), c = (int)(i & 127) * 8, t = m & (SEQ - 1);
        const v4u gv = *(const v4u*)(GB + (size_t)m * D_ + c), u2 = *(const v4u*)(UP + (size_t)m * D_ + c);
        v4u u1 = (v4u){0u, 0u, 0u, 0u}, u0 = (v4u){0u, 0u, 0u, 0u};
        if (t >= 1) u1 = *(const v4u*)(UP + (size_t)(m - 1) * D_ + c);
        if (t >= 2) u0 = *(const v4u*)(UP + (size_t)(m - 2) * D_ + c);
        float o[8];
#pragma unroll
        for (int e = 0; e < 4; ++e) {
            const f32x2 w0 = *(const f32x2*)(cw + c + 2 * e), w1 = *(const f32x2*)(cw + 1024 + c + 2 * e), w2 = *(const f32x2*)(cw + 2048 + c + 2 * e);
            o[2 * e] = bflo(gv[e]) * (bflo(u0[e]) * w0[0] + bflo(u1[e]) * w1[0] + bflo(u2[e]) * w2[0]);
            o[2 * e + 1] = bfhi(gv[e]) * (bfhi(u0[e]) * w0[1] + bfhi(u1[e]) * w1[1] + bfhi(u2[e]) * w2[1]); }
        v4u ov; ov.x = pk2(o[0], o[1]); ov.y = pk2(o[2], o[3]); ov.z = pk2(o[4], o[5]); ov.w = pk2(o[6], o[7]);
        *(v4u*)(CV + (size_t)m * D_ + c) = ov;
    }
}

constexpr int NPHASE = 18;
#ifndef PH_STOP
#define PH_STOP NPHASE
#endif
struct Args { const float* in[34]; float* out; unsigned char* ws; int ph_lo, ph_hi; };
__global__ void __launch_bounds__(512, 2) mk_fwd(Args args) {
    extern __shared__ __attribute__((aligned(16))) unsigned char lds_raw[];
    LAS unsigned char* lds = (LAS unsigned char*)lds_raw;
    WInfo W; W.tid = threadIdx.x; W.lane = W.tid & 63; W.wave = __builtin_amdgcn_readfirstlane(W.tid >> 6);
    W.G = gridDim.x; { const int bx = blockIdx.x; W.vcu = (W.G % 8 == 0) ? (bx % 8) * (W.G / 8) + bx / 8 : bx; }
    W.gw = W.vcu * 8 + W.wave; W.NGW = W.G * 8;
    unsigned char* ws = args.ws; float* out = args.out; const float* const* in = args.in;
    unsigned* ctl = (unsigned*)(ws + WS_CTL);
    volatile LAS unsigned* MISC = (volatile LAS unsigned*)(lds + MISC_OFF);
    for (int u = W.tid; u < 128; u += 512) ((LAS unsigned*)(lds + LDSCTL_OFF))[u] = 0u;
    __syncthreads();
    XcdBarrier bar; bar.bar = ctl + CW_BAR; bar.x = 0; bar.st = nullptr;
    if (MK_N_LAUNCHES == 1) bar = xcd_barrier_post(ctl + CW_BAR, MISC + 8);
    const int lo = args.ph_lo, hi = args.ph_hi;
#ifndef PH_MASK
#define PH_MASK 0x3ffff
#endif
#define IN(k) (((PH_MASK >> (k)) & 1) && lo <= (k) && (k) < hi)
#define SEAM(k) do { if (IN(k) && IN((k) + 1)) xcd_barrier(bar); } while (0)
    bf16* const B0 = (bf16*)(ws + WS_B0); bf16* const Zb = (bf16*)(ws + WS_B1); bf16* const ACT = (bf16*)(ws + WS_ACT); bf16* const CV = (bf16*)(ws + WS_CV);
    bf16* const AP = (bf16*)(ws + WS_AP); float* const YRAW = (float*)(ws + WS_YRAW); bf16* const ACTM = (bf16*)(ws + WS_ACTM);
    float* const WLOG = out; bf16* const ABUF = (bf16*)(out + (size_t)T_ * 512); bf16* const GBUF = ABUF + (size_t)T_ * 512;
    int* const toke = (int*)(ws + WS_TOKE); float* const tokp = (float*)(ws + WS_TOKP); int* const wgcnt = (int*)(ws + WS_WGCNT); int* const ptabg = (int*)(ws + WS_PTAB); int* const perm = (int*)(ws + WS_PERM);
    const int cblk = (int)blockIdx.x;

#ifdef DUMP_OFF
    if (lo == 100) { const bf16* s = (const bf16*)(ws + (size_t)(DUMP_OFF) * MiB);
        for (size_t i = (size_t)W.gw * 64 + W.lane; i < (size_t)T_ * D_; i += (size_t)W.NGW * 64) { const size_t m = i >> 10, c = i & 1023; out[i] = (c < DUMP_W) ? bf2f(s[m * DUMP_LD + DUMP_COL + c]) : 0.f; } return; }
#endif
    if (IN(0)) { p0_prologue(W, lds, in, ws); } SEAM(0);
    if (IN(1)) { pg8::DenseSched S{T_ / 256, NZ / 256, W.G, cblk, 1024, (const bf16*)(ws + WS_WIN0)}; pg8::EpiBf16 E{Zb, NZ}; pg8::gemm_phase(lds, B0, 1024, S, E); } SEAM(1);
    if (IN(2)) { aprime_phase(W, Zb, AP, in[4]); } SEAM(2);
    if (IN(3)) { const int KL = 256 + (hi >> 20); pg8::DenseSched S{T_ / 256, 6, W.G, cblk, KL, (const bf16*)(ws + WS_WLORA)}; pg8::EpiLora E{WLOG, ABUF, GBUF, in[5], in[7]}; pg8::gemm_phase(lds, AP, KL, S, E); } SEAM(3);
    if (IN(4)) { scan_prep_phase(W, lds, Zb, WLOG, ABUF, ws + WS_SLOT, (float*)(ws + WS_BONUS), in[4], in[10], in[11], in[12]); } SEAM(4);
    if (IN(5)) { if (blockIdx.x < 64) scan_seq_phase(W, lds, Zb, ws + WS_SLOT, YRAW, in[4]); attn_phase(W, lds, Zb, B0, in[3], in[1], ctl + 2048); deferred_work(W, lds, in, ws, ctl + 2112); } SEAM(5);
    if (IN(6)) { post_phase(W, Zb, GBUF, YRAW, (const float*)(ws + WS_BONUS), B0, in[4], in[13], in[14]); p0_weights(W, lds, in, ws, 0, NITEMS_MOE); } SEAM(6);
    float* const STP1 = (float*)(ws + WS_STP1); float* const STP2 = (float*)(ws + WS_STP2); const float* const SV = (const float*)(ws + WS_LNV); const float* const CVv = SV + 8704;
    LAS float* const PST = (LAS float*)(lds + PST_OFF); LAS float* const TBL = (LAS float*)(lds + STAT_OFF);
#define STAT_TABLE(S, stp) do { __syncthreads(); if (W.tid < 256) { f32x4 _a[11], _b[11]; int _n = 0; \
        _Pragma("unroll") for (int i = 0; i < 11; ++i) { pg8::Unit uu; if ((S).next(i, uu)) { _n = i + 1; const float* _p = (stp) + (size_t)(uu.pm * 256 + W.tid) * 8; _a[i] = *(const f32x4*)_p; _b[i] = *(const f32x4*)(_p + 4); } else { _a[i] = (f32x4){0.f, 0.f, 0.f, 0.f}; _b[i] = _a[i]; } } \
        _Pragma("unroll") for (int i = 0; i < 11; ++i) if (i < _n) { const float s = ((_a[i][0] + _a[i][2]) + _b[i][0]) + _b[i][2], q = ((_a[i][1] + _a[i][3]) + _b[i][1]) + _b[i][3]; const float mu = s * (1.0f / 1024.0f); \
            TBL[(i * 256 + W.tid) * 2] = mu; TBL[(i * 256 + W.tid) * 2 + 1] = rsqrtf(fmaxf(q * (1.0f / 1024.0f) - mu * mu, 0.f) + LN_EPS); } } __syncthreads(); } while (0)
    if (IN(7)) { pg8::DenseSched S{T_ / 256, 4, W.G, cblk, 1024, (const bf16*)(ws + WS_WOUT0)}; pg8::EpiResStats E{in[0], out, Zb, STP1, PST, TBL, nullptr, nullptr, nullptr}; pg8::gemm_phase(lds, B0, 1024, S, E); } SEAM(7);
    if (IN(8)) { pg8::DenseSched S{T_ / 256, 22, W.G, cblk, 1024, (const bf16*)(ws + WS_WFGU)}; STAT_TABLE(S, STP1); pg8::EpiSwigluLN E{ACT, FF, TBL, SV, CVv}; pg8::gemm_phase(lds, Zb, 1024, S, E); } SEAM(8);
    if (IN(9)) { pg8::DenseSched S{T_ / 256, 4, W.G, cblk, FF, (const bf16*)(ws + WS_WFD)}; STAT_TABLE(S, STP1); pg8::EpiResStats E{out, out, B0, STP2, PST, TBL, STP1, in[16], in[17]}; pg8::gemm_phase(lds, ACT, FF, S, E); } SEAM(9);
    if (IN(10)) { pg8::DenseSched S{T_ / 256, 12, W.G, cblk, 1024, (const bf16*)(ws + WS_WIN1)}; STAT_TABLE(S, STP2); pg8::EpiL1inLN E{Zb, ACT, TBL, SV + 5632, CVv + 5632}; pg8::gemm_phase(lds, B0, 1024, S, E); } SEAM(10);
    if (IN(11)) { conv_phase(W, Zb, ACT, CV, in[24]); } SEAM(11);
    if (IN(12)) { pg8::DenseSched S{T_ / 256, 4, W.G, cblk, 1024, (const bf16*)(ws + WS_WOUT1)}; STAT_TABLE(S, STP2); pg8::EpiResStats E{out, out, nullptr, nullptr, PST, TBL, STP2, in[21], in[22]}; pg8::gemm_phase(lds, CV, 1024, S, E); } SEAM(12);
    if (IN(13)) { ln_router_phase(W, lds, out, B0, in[26], in[27], in[28], toke, tokp, wgcnt); } SEAM(13);
    if (IN(14)) { route_phase(W, lds, toke, wgcnt, perm, ptabg); } SEAM(14);
#define MOE_TABLES() do { LAS int* ptl = (LAS int*)(lds + PTAB_OFF); __syncthreads(); if (W.tid < 280) ptl[W.tid] = ptabg[W.tid]; __syncthreads(); } while (0)
    if (IN(15)) { MOE_TABLES(); LAS int* ptl = (LAS int*)(lds + PTAB_OFF); LAS unsigned short* rtl = (LAS unsigned short*)(lds + RTAB_OFF);
        pg8::MoeUpSched S{ptl[0] + ptl[1], W.G, cblk, ws + WS_WMGU, ptl, rtl};
        for (int i = 0; i < 32; ++i) { pg8::Unit uu; if (!S.next(i, uu)) break; if (W.tid < 256) { const int r = perm[uu.pm * 256 + W.tid]; rtl[i * 256 + W.tid] = (unsigned short)(r < 0 ? 0 : r); } }
        __syncthreads(); pg8::EpiSwiglu8 E{(unsigned char*)ACTM, FFE}; pg8::gemm_phase<pg8::EpiSwiglu8, pg8::MoeUpSched, true>(lds, B0, 512 + (hi >> 20), S, E); } SEAM(15);
    if (IN(16)) { MOE_TABLES(); LAS int* ptl = (LAS int*)(lds + PTAB_OFF);
        pg8::MoeDownSched S{ptl[0] + ptl[1], 0, W.G, cblk, ws + WS_WMD, ptl}; pg8::EpiMoeDown E{out, (bf16*)(ws + WS_Y2), perm, tokp}; pg8::gemm_phase<pg8::EpiMoeDown, pg8::MoeDownSched, true>(lds, ACTM, FFE / 2 + (hi >> 20), S, E); } SEAM(16);
    if (IN(17)) { ln_phase(W, out, nullptr, in[32], in[33], (const bf16*)(ws + WS_Y2)); }
#undef IN
#undef SEAM
}

extern "C" void kernel_launch(void* const* d_in, const int* in_sizes, int n_in, void* d_out, int out_size, void* d_ws, size_t ws_size, hipStream_t stream) {
    static int grid = 0;
    if (grid == 0) {
        if (n_in != 34 || out_size != T_ * D_ || ws_size < WS_END) { fprintf(stderr, "kernel_launch: unexpected problem (n_in %d, out %d, ws %zu)\n", n_in, out_size, ws_size); grid = -1; return; }
        int dev = 0, cus = 0, per_cu = 0;
        if (hipGetDevice(&dev) != hipSuccess || hipDeviceGetAttribute(&cus, hipDeviceAttributeMultiprocessorCount, dev) != hipSuccess) { grid = -1; return; }
        if (hipFuncSetAttribute((const void*)mk_fwd, hipFuncAttributeMaxDynamicSharedMemorySize, LDS_BYTES) != hipSuccess) { fprintf(stderr, "kernel_launch: hipFuncSetAttribute failed\n"); grid = -1; return; }
        if (hipOccupancyMaxActiveBlocksPerMultiprocessor(&per_cu, (const void*)mk_fwd, 512, LDS_BYTES) != hipSuccess || per_cu < 1) fprintf(stderr, "kernel_launch: occupancy query reports %d\n", per_cu);
        (void)hipGetLastError();
        grid = cus;
        if (grid != 256) { fprintf(stderr, "kernel_launch: built for 256 CUs, got %d\n", grid); grid = -1; return; }
    }
    if (grid < 0) return;
    (void)hipMemsetAsync((char*)d_ws + WS_CTL, 0, CTL_ZERO_BYTES, stream);
    Args a{};
    for (int i = 0; i < 34; ++i) a.in[i] = (const float*)d_in[i];
    a.out = (float*)d_out; a.ws = (unsigned char*)d_ws;
    if (MK_N_LAUNCHES == 1) { a.ph_lo = 0; a.ph_hi = NPHASE; hipLaunchKernelGGL(mk_fwd, dim3(grid), dim3(512), LDS_BYTES, stream, a); }
    else { for (int p = 0; p < PH_STOP; ++p) { a.ph_lo = p; a.ph_hi = p + 1; hipLaunchKernelGGL(mk_fwd, dim3(grid), dim3(512), LDS_BYTES, stream, a);
#ifdef DUP_PHASE
            if (p == DUP_PHASE) for (int r = 0; r < DUP_N; ++r) hipLaunchKernelGGL(mk_fwd, dim3(grid), dim3(512), LDS_BYTES, stream, a);
#endif
        }
#ifdef DUMP_OFF
        a.ph_lo = 100; a.ph_hi = 101; hipLaunchKernelGGL(mk_fwd, dim3(grid), dim3(512), LDS_BYTES, stream, a);
#endif
    }
}
```

```cpp
#include <hip/hip_runtime.h>
#include <stdio.h>

#ifndef MK_N_LAUNCHES
#define MK_N_LAUNCHES 1
#endif

#define GAS __attribute__((address_space(1)))
#define LAS __attribute__((address_space(3)))
typedef unsigned short bf16;
typedef unsigned v4u __attribute__((ext_vector_type(4)));
typedef unsigned v2u __attribute__((ext_vector_type(2)));
typedef float f32x2 __attribute__((ext_vector_type(2)));
typedef float f32x4 __attribute__((ext_vector_type(4)));
typedef float f32x16 __attribute__((ext_vector_type(16)));
typedef short bf16x8 __attribute__((ext_vector_type(8)));
typedef short s16x4 __attribute__((ext_vector_type(4)));
#define LDS_WAIT() asm volatile("s_waitcnt lgkmcnt(0)" ::: "memory")
#define VM_WAIT() asm volatile("s_waitcnt vmcnt(0)" ::: "memory")

constexpr int T_ = 32768, D_ = 1024, SEQ = 4096, NZ = 2560, FF = 2816, FFE = 3584, NEXP = 8;
constexpr int MAXPANEL = 136, PERMLEN = MAXPANEL * 256;
constexpr float ALPHA = 1.41421356237309515f, LN_EPS = 1e-5f, GN_EPS = 64e-5f, LOG2E = 1.44269504088896341f;

constexpr size_t MiB = 1u << 20;
constexpr size_t WS_CTL = 0, CTL_ZERO_BYTES = 1 * MiB;
constexpr size_t WS_TOKE = 1 * MiB, WS_TOKP = 1 * MiB + 128 * 1024, WS_WGCNT = 1 * MiB + 384 * 1024, WS_PTAB = WS_WGCNT + 16 * 1024, WS_PERM = 1 * MiB + 512 * 1024;
constexpr size_t WS_WIN0 = 2 * MiB, WS_WLORA = 7 * MiB, WS_WOUT0 = 8 * MiB, WS_WFGU = 10 * MiB, WS_WFD = 21 * MiB, WS_WIN1 = 27 * MiB, WS_WOUT1 = 33 * MiB, WS_WMGU = 35 * MiB, WS_WMD = 91 * MiB;
constexpr size_t WS_A8B = 151 * MiB;
constexpr size_t WS_A8 = 119 * MiB;
constexpr size_t WS_Y2 = 119 * MiB;
constexpr size_t WS_STP1 = 197 * MiB, WS_STP2 = 198 * MiB, WS_LNV = 196 * MiB;
constexpr size_t WS_SLOTP = 199 * MiB;
constexpr size_t WS_B0 = 204 * MiB;
constexpr size_t WS_B1 = 268 * MiB;
constexpr size_t WS_ACT = 332 * MiB;
constexpr size_t WS_CV = 396 * MiB;
constexpr size_t WS_AP = 428 * MiB;
constexpr size_t WS_YRAW = 444 * MiB;
constexpr size_t WS_XQ = 444 * MiB;
constexpr size_t WS_XS = 196 * MiB + 512 * 1024;
constexpr size_t WS_ACTM = 268 * MiB;
constexpr size_t WS_BONUS = 508 * MiB;
constexpr size_t WS_SLOT = 35 * MiB;
constexpr size_t WS_END = 510 * MiB;
static_assert(WS_ACTM + (size_t)2 * PERMLEN * FFE <= WS_END, "ACTM");
static_assert(WS_ACT + (size_t)T_ * FF * 2 <= WS_END, "ACT");
constexpr int CW_TMO = 0, CW_CODE = 1, CW_BAR = 4096;

constexpr int RING_BYTES = 131072, LDSCTL_OFF = 163328, MISC_OFF = LDSCTL_OFF, PTAB_OFF = RING_BYTES, RTAB_OFF = RING_BYTES + 2048;
constexpr int LDS_BYTES = 163840, STAT_OFF = RTAB_OFF, PST_OFF = RTAB_OFF + 8192;

namespace pg8 {
#define PG8_LAS __attribute__((address_space(3)))
typedef unsigned short bf16_t;
constexpr int BM = 256, BK = 64, HALF = 128, HTB = HALF * BK * 2, STAGE_BYTES = 8 * HTB, NXCD = 8, WGM = 8;
__host__ __device__ __forceinline__ int lds_byte(int r, int c) { const int st = (r >> 4) * 2 + (c >> 5), rr = r & 15, cc = c & 31, ob = rr * 64 + cc * 2; return st * 1024 + (ob ^ (((ob >> 9) & 1) << 5)); }
__host__ __device__ __forceinline__ void stage_rc(int b, int& R, int& C) { const int st = b / 1024, sb = b % 1024, swz = sb ^ (((sb >> 9) & 1) << 5); R = (st >> 1) * 16 + swz / 64; C = (st & 1) * 32 + (swz % 64) / 2; }
__host__ __device__ __forceinline__ int perm32(int rho) { const int n = rho >> 4, i = rho & 15; return 8 * (i >> 2) + 4 * n + (i & 3); }
struct Unit { int pm, pn, e, ui; };
__device__ __forceinline__ bool tile_order(int i, int G, int c, int nM, int nN, int& pm, int& pn) {
    const int nwg = nM * nN; const long L = (long)i * G + c; if (L >= nwg) return false;
    int wgid = (int)L; { const int q = nwg / NXCD, r = nwg % NXCD, xcd = wgid % NXCD, off = wgid / NXCD; wgid = (xcd < r ? xcd * (q + 1) : r * (q + 1) + (xcd - r) * q) + off; }
    const int nig = WGM * nN, gid = wgid / nig, fm = gid * WGM, gsz = (nM - fm) < WGM ? (nM - fm) : WGM;
    pm = fm + ((wgid % nig) % gsz); pn = (wgid % nig) / gsz; return true;
}
typedef __bf16 bf16x2_t __attribute__((ext_vector_type(2)));
__device__ __forceinline__ unsigned cvt_pk_bf16(float lo, float hi) { const f32x2 v = {lo, hi}; const bf16x2_t b = __builtin_convertvector(v, bf16x2_t); return __builtin_bit_cast(unsigned, b); }

typedef int i32x8 __attribute__((ext_vector_type(8)));
typedef int v4i __attribute__((ext_vector_type(4)));
__device__ __forceinline__ i32x8 cat8(bf16x8 lo, bf16x8 hi) { const v4u a = __builtin_bit_cast(v4u, lo), b = __builtin_bit_cast(v4u, hi); return (i32x8){(int)a.x, (int)a.y, (int)a.z, (int)a.w, (int)b.x, (int)b.y, (int)b.z, (int)b.w}; }
template <class Epi, class Sched, int F8 = 0>
__device__ __forceinline__ void gemm_phase(PG8_LAS unsigned char* lds, const bf16_t* Abase, const int K, const Sched& S, const Epi& E) {
    const int tid = threadIdx.x, wid = __builtin_amdgcn_readfirstlane(tid >> 6), lane = tid & 63, wr = wid >> 2, wc = wid & 3, fr = lane & 15, fq = lane >> 4;
    const int nt = K / BK;
    int Rr[2], Cc[2]; unsigned voffB[2];
#pragma unroll
    for (int i = 0; i < 2; ++i) { stage_rc(tid * 16 + i * 8192, Rr[i], Cc[i]); const int Rb = Epi::PERM ? ((Rr[i] & ~31) + perm32(Rr[i] & 31)) : Rr[i]; voffB[i] = (unsigned)(Rb * K + Cc[i]) * 2u; }
    const size_t kstep = (size_t)(BK * 2);
    const size_t hstep = (size_t)HALF * K * 2;
    const unsigned ldsw = (unsigned)wid * 1024u;
    const int aoff = lds_byte(wr * 64 + fr, fq * 8), boff = lds_byte(wc * 32 + fr, fq * 8);
#define PG8_SA(b, h) (((b) * 2 + (h)) * HTB)
#define PG8_SB(b, h) ((4 + (b) * 2 + (h)) * HTB)
#define PG8_STAGE(bufoff, gbase, voff) do { _Pragma("unroll") for (int _i = 0; _i < 2; ++_i) \
        __builtin_amdgcn_global_load_lds((const unsigned*)((const char*)(gbase) + (voff)[_i]), (PG8_LAS unsigned*)(lds + (bufoff) + ldsw + _i * 8192), 16, 0, 0); } while (0)
#define PG8_LDA(dst, b, h) do { _Pragma("unroll") for (int m = 0; m < 4; ++m) _Pragma("unroll") for (int k = 0; k < 2; ++k) { if constexpr (F8 == 1) { const v4u _q = *(const PG8_LAS v4u*)(lds + PG8_SA(b, h) + aoff + m * 2048 + k * 1024); \
        dst##8[m][4 * k] = (int)_q.x; dst##8[m][4 * k + 1] = (int)_q.y; dst##8[m][4 * k + 2] = (int)_q.z; dst##8[m][4 * k + 3] = (int)_q.w; } else dst[m][k] = *(const PG8_LAS bf16x8*)(lds + PG8_SA(b, h) + aoff + m * 2048 + k * 1024); } } while (0)
#define PG8_LDB(dst, b, h) do { _Pragma("unroll") for (int n = 0; n < 2; ++n) _Pragma("unroll") for (int k = 0; k < 2; ++k) { if constexpr (F8 == 1) { const v4u _q = *(const PG8_LAS v4u*)(lds + PG8_SB(b, h) + boff + n * 2048 + k * 1024); \
        dst##8[n][4 * k] = (int)_q.x; dst##8[n][4 * k + 1] = (int)_q.y; dst##8[n][4 * k + 2] = (int)_q.z; dst##8[n][4 * k + 3] = (int)_q.w; } else dst[n][k] = *(const PG8_LAS bf16x8*)(lds + PG8_SB(b, h) + boff + n * 2048 + k * 1024); } } while (0)
#define PG8_MMA(ai, bj, At, Bt) do { __builtin_amdgcn_s_setprio(1); if constexpr (F8 == 1) { _Pragma("unroll") for (int m = 0; m < 4; ++m) _Pragma("unroll") for (int n = 0; n < 2; ++n) \
        asm volatile("v_mfma_scale_f32_16x16x128_f8f6f4 %0, %1, %2, %0, %3, %4 op_sel_hi:[0,0,0]" : "+v"(acc[ai][bj][m][n]) : "v"(Bt##8[n]), "v"(At##8[m]), "v"(scl_w), "v"(scl_a)); } else if constexpr (F8 == 2) { \
        _Pragma("unroll") for (int m = 0; m < 4; ++m) _Pragma("unroll") for (int n = 0; n < 2; ++n) _Pragma("unroll") for (int k = 0; k < 2; ++k) \
        acc[ai][bj][m][n] = __builtin_bit_cast(f32x4, __builtin_amdgcn_mfma_i32_16x16x64_i8(__builtin_bit_cast(v4i, Bt[n][k]), __builtin_bit_cast(v4i, At[m][k]), __builtin_bit_cast(v4i, acc[ai][bj][m][n]), 0, 0, 0)); } else { \
        _Pragma("unroll") for (int m = 0; m < 4; ++m) _Pragma("unroll") for (int n = 0; n < 2; ++n) _Pragma("unroll") for (int k = 0; k < 2; ++k) \
        acc[ai][bj][m][n] = __builtin_amdgcn_mfma_f32_16x16x32_bf16(Bt[n][k], At[m][k], acc[ai][bj][m][n], 0, 0, 0); } __builtin_amdgcn_s_setprio(0); } while (0)
#define PG8_WAIT_V(n) asm volatile("s_waitcnt vmcnt(" #n ")" ::: "memory")
#define PG8_WAIT_L(n) asm volatile("s_waitcnt lgkmcnt(" #n ")" ::: "memory")
#define PG8_BAR __builtin_amdgcn_s_barrier()
#define PG8_SCHED __builtin_amdgcn_sched_barrier(0)
#define PG8_AOFF(dst, u) do { _Pragma("unroll") for (int _h = 0; _h < 2; ++_h) _Pragma("unroll") for (int _i = 0; _i < 2; ++_i) dst[_h][_i] = S.a_off(u, _h * HALF + Rr[_i]) + (unsigned)Cc[_i] * 2u; } while (0)
    Unit cur, nxt; int ui = 0;
    if (!S.next(0, cur)) return;
    f32x4 acc[2][2][4][2];
#pragma unroll
    for (int a = 0; a < 2; ++a)
#pragma unroll
        for (int b = 0; b < 2; ++b)
#pragma unroll
            for (int m = 0; m < 4; ++m)
#pragma unroll
                for (int n = 0; n < 2; ++n) acc[a][b][m][n] = (f32x4){0.f, 0.f, 0.f, 0.f};
    bf16x8 At[4][2], B0[2][2], B1[2][2]; i32x8 At8[4], B08[2], B18[2];
    int scl_w = 0x7f7f7f7f, scl_a = 0x7f7f7f7f; if constexpr (F8 == 1) { scl_w = (int)Epi::SCALE_W; asm volatile("" : "+v"(scl_w), "+v"(scl_a)); }
    unsigned curA[2][2], nxtA[2][2];
    PG8_AOFF(curA, cur);
    const char* const A0 = (const char*)Abase;
    const char* cB = S.b_ptr(cur);
    PG8_STAGE(PG8_SB(0, 0), cB, voffB); PG8_STAGE(PG8_SB(0, 1), cB + hstep, voffB); PG8_STAGE(PG8_SA(0, 0), A0, curA[0]); PG8_STAGE(PG8_SA(0, 1), A0, curA[1]);
    if (wr == 1) PG8_BAR;
    PG8_WAIT_V(2); PG8_BAR;
    PG8_STAGE(PG8_SB(1, 0), cB + kstep, voffB); PG8_STAGE(PG8_SA(1, 0), A0 + kstep, curA[0]); PG8_STAGE(PG8_SB(1, 1), cB + hstep + kstep, voffB);
    PG8_WAIT_V(6); PG8_BAR;
    for (;;) {
        const bool has_next = S.next(ui + 1, nxt);
        const char* nB = has_next ? S.b_ptr(nxt) : cB;
        if (has_next) { PG8_AOFF(nxtA, nxt); } else {
#pragma unroll
            for (int h = 0; h < 2; ++h)
#pragma unroll
                for (int i = 0; i < 2; ++i) nxtA[h][i] = curA[h][i]; }
        for (int t = 0; t < nt; t += 2) {
            const bool last = (t == nt - 2);
            const char* a1 = A0 + (size_t)(t + 1) * kstep;
            const char* a2 = last ? A0 : A0 + (size_t)(t + 2) * kstep; const char* b2 = last ? nB : cB + (size_t)(t + 2) * kstep;
            const char* a3 = a2 + kstep; const char* b3 = b2 + kstep;
            unsigned o2[2][2];
#pragma unroll
            for (int h = 0; h < 2; ++h)
#pragma unroll
                for (int i = 0; i < 2; ++i) o2[h][i] = last ? nxtA[h][i] : curA[h][i];
            PG8_LDB(B0, 0, 0); PG8_LDB(B1, 0, 1); PG8_SCHED; PG8_LDA(At, 0, 0); PG8_STAGE(PG8_SA(1, 1), a1, curA[1]);
            asm volatile("s_cmp_lg_u32 %0, 0\n\ts_cbranch_scc1 .Lrx%=\n\ts_cmp_eq_u32 %1, 0\n\ts_cbranch_scc1 .Lrx%=\n\ts_waitcnt vmcnt(%2)\n\ts_branch .Lry%=\n.Lrx%=:\n\ts_waitcnt vmcnt(8)\n.Lry%=:" :: "s"(t), "s"(ui), "n"(8 + Epi::NST) : "memory", "scc"); PG8_WAIT_L(0); PG8_BAR; PG8_MMA(0, 0, At, B0); PG8_MMA(0, 1, At, B1); PG8_BAR; PG8_SCHED;
            PG8_LDA(At, 0, 1); PG8_STAGE(PG8_SB(0, 0), b2, voffB); PG8_STAGE(PG8_SB(0, 1), b2 + hstep, voffB); PG8_STAGE(PG8_SA(0, 0), a2, o2[0]);
            asm volatile("s_cmp_lg_u32 %0, 0\n\ts_cbranch_scc1 .Lrx%=\n\ts_cmp_eq_u32 %1, 0\n\ts_cbranch_scc1 .Lrx%=\n\ts_waitcnt vmcnt(%2)\n\ts_branch .Lry%=\n.Lrx%=:\n\ts_waitcnt vmcnt(8)\n.Lry%=:" :: "s"(t), "s"(ui), "n"(8 + Epi::NST) : "memory", "scc"); PG8_WAIT_L(0); PG8_BAR; PG8_MMA(1, 0, At, B0); PG8_MMA(1, 1, At, B1); PG8_BAR; PG8_SCHED;
            PG8_LDB(B0, 1, 0); PG8_LDB(B1, 1, 1); PG8_SCHED; PG8_LDA(At, 1, 0); PG8_STAGE(PG8_SA(0, 1), a2, o2[1]);
            PG8_WAIT_V(8); PG8_WAIT_L(0); PG8_BAR; PG8_MMA(0, 0, At, B0); PG8_MMA(0, 1, At, B1); PG8_BAR; PG8_SCHED;
            PG8_LDA(At, 1, 1); PG8_STAGE(PG8_SB(1, 0), b3, voffB); PG8_STAGE(PG8_SB(1, 1), b3 + hstep, voffB); PG8_STAGE(PG8_SA(1, 0), a3, o2[0]);
            PG8_WAIT_V(8); PG8_WAIT_L(0); PG8_BAR; PG8_MMA(1, 0, At, B0); PG8_MMA(1, 1, At, B1); PG8_BAR; PG8_SCHED;
        }
        if (wr == 0) PG8_BAR;
        if constexpr (F8 == 1) asm volatile("s_nop 15\n\ts_nop 7" ::: "memory");
        E(acc, cur, wr, wc, fr, fq);
        if (!has_next) break;
#pragma unroll
        for (int a = 0; a < 2; ++a)
#pragma unroll
            for (int b = 0; b < 2; ++b)
#pragma unroll
                for (int m = 0; m < 4; ++m)
#pragma unroll
                    for (int n = 0; n < 2; ++n) acc[a][b][m][n] = (f32x4){0.f, 0.f, 0.f, 0.f};
        cur = nxt; cB = nB; ++ui;
#pragma unroll
        for (int h = 0; h < 2; ++h)
#pragma unroll
            for (int i = 0; i < 2; ++i) curA[h][i] = nxtA[h][i];
        if (wr == 1) PG8_BAR;
    }
    PG8_WAIT_V(0);
    PG8_BAR;
#undef PG8_SA
#undef PG8_SB
#undef PG8_STAGE
#undef PG8_LDA
#undef PG8_LDB
#undef PG8_MMA
#undef PG8_WAIT_V
#undef PG8_WAIT_L
#undef PG8_BAR
#undef PG8_SCHED
#undef PG8_AOFF
}

struct DenseSched {
    int nM, nN, G, c, K; const bf16_t* Bt;
    __device__ __forceinline__ bool next(int i, Unit& u) const { u.e = 0; u.ui = i; return tile_order(i, G, c, nM, nN, u.pm, u.pn); }
    __device__ __forceinline__ unsigned a_off(const Unit& u, int rr) const { return (unsigned)((u.pm * BM + rr) * K) * 2u; }
    __device__ __forceinline__ const char* b_ptr(const Unit& u) const { return (const char*)Bt + (size_t)u.pn * BM * K * 2; }
};
struct MoeUpSched {
    int nP, G, c; const unsigned char* Bt; const PG8_LAS int* ptab; const PG8_LAS unsigned short* rtab;
    __device__ __forceinline__ bool next(int i, Unit& u) const { u.ui = i; int pi; if (!tile_order(i, G, c, nP, 28, pi, u.pn)) return false; const int en = ptab[2 + pi]; u.pm = en >> 8; u.e = en & 255; return true; }
    __device__ __forceinline__ unsigned a_off(const Unit& u, int rr) const { return (unsigned)rtab[u.ui * 256 + rr] * 1024u; }
    __device__ __forceinline__ const char* b_ptr(const Unit& u) const { return (const char*)Bt + ((size_t)u.e * 7168 + (size_t)u.pn * BM) * 1024; }
};
struct MoeDownSched {
    int nP, part, G, c; const unsigned char* Bt; const PG8_LAS int* ptab;
    __device__ __forceinline__ bool next(int i, Unit& u) const { u.ui = i; int pi;
        if (part == 0) { if (!tile_order(i, G, c, nP < 256 ? nP : 256, 4, pi, u.pn)) return false; }
        else { const long L = (long)i * G + c; if (L >= (long)(nP - 256) * 4) return false; pi = 256 + (int)(L >> 2); u.pn = (int)(L & 3); }
        const int en = ptab[2 + pi]; u.pm = en >> 8; u.e = en & 255; return true; }
    __device__ __forceinline__ unsigned a_off(const Unit& u, int rr) const { return (unsigned)(u.pm * BM + rr) * (unsigned)FFE; }
    __device__ __forceinline__ const char* b_ptr(const Unit& u) const { return (const char*)Bt + ((size_t)u.e * 1024 + (size_t)u.pn * BM) * FFE; }
};

struct EpiBf16 {
    static constexpr bool PERM = true; static constexpr int NST = 16;
    bf16_t* O; int ldc;
    __device__ __forceinline__ void operator()(const f32x4 (&acc)[2][2][4][2], const Unit& u, int wr, int wc, int fr, int fq) const {
        const int row0 = u.pm * BM + wr * 64 + fr, col0 = u.pn * BM + wc * 32 + 8 * fq;
#pragma unroll
        for (int ai = 0; ai < 2; ++ai)
#pragma unroll
            for (int m = 0; m < 4; ++m) { bf16_t* rowp = O + (size_t)(row0 + ai * HALF + m * 16) * ldc + col0;
#pragma unroll
                for (int bj = 0; bj < 2; ++bj) { const f32x4 v0 = acc[ai][bj][m][0], v1 = acc[ai][bj][m][1];
                    v4u w; w.x = cvt_pk_bf16(v0[0], v0[1]); w.y = cvt_pk_bf16(v0[2], v0[3]); w.z = cvt_pk_bf16(v1[0], v1[1]); w.w = cvt_pk_bf16(v1[2], v1[3]);
                    *(v4u*)(rowp + bj * HALF) = w; } }
    }
};
struct EpiBf16i8 {
    static constexpr bool PERM = true; static constexpr int NST = 16;
    bf16_t* O; int ldc; const float* xs; const float* sn;
    __device__ __forceinline__ void operator()(const f32x4 (&acc)[2][2][4][2], const Unit& u, int wr, int wc, int fr, int fq) const {
        const int row0 = u.pm * BM + wr * 64 + fr, col0 = u.pn * BM + wc * 32 + 8 * fq;
        float rs[8]; f32x4 cs[2][2];
#pragma unroll
        for (int r = 0; r < 8; ++r) rs[r] = xs[row0 + (r >> 2) * HALF + (r & 3) * 16];
#pragma unroll
        for (int bj = 0; bj < 2; ++bj)
#pragma unroll
            for (int n = 0; n < 2; ++n) cs[bj][n] = *(const f32x4*)(sn + col0 + bj * HALF + 4 * n);
#pragma unroll
        for (int ai = 0; ai < 2; ++ai)
#pragma unroll
            for (int m = 0; m < 4; ++m) { bf16_t* rowp = O + (size_t)(row0 + ai * HALF + m * 16) * ldc + col0; const float r = rs[ai * 4 + m];
#pragma unroll
                for (int bj = 0; bj < 2; ++bj) { const f32x4 v0 = __builtin_convertvector(__builtin_bit_cast(v4i, acc[ai][bj][m][0]), f32x4) * (cs[bj][0] * r), v1 = __builtin_convertvector(__builtin_bit_cast(v4i, acc[ai][bj][m][1]), f32x4) * (cs[bj][1] * r);
                    v4u w; w.x = cvt_pk_bf16(v0[0], v0[1]); w.y = cvt_pk_bf16(v0[2], v0[3]); w.z = cvt_pk_bf16(v1[0], v1[1]); w.w = cvt_pk_bf16(v1[2], v1[3]);
                    *(v4u*)(rowp + bj * HALF) = w; } }
    }
};
__device__ __forceinline__ float silu_f(float g) { return g * __builtin_amdgcn_rcpf(1.0f + __expf(-g)); }
constexpr float SW_TG = -1.44269504088896341f, SW_TU = -0.69314718055994531f;
__device__ __forceinline__ f32x4 swiglu4(f32x4 t, f32x4 up) {
    f32x4 e, r;
#pragma unroll
    for (int j = 0; j < 4; ++j) e[j] = __builtin_amdgcn_exp2f(t[j]);
    const f32x4 d = e + 1.0f;
#pragma unroll
    for (int j = 0; j < 4; ++j) r[j] = __builtin_amdgcn_rcpf(d[j]);
    return (t * r) * up;
}
__device__ __forceinline__ unsigned pk4_fp8(float a, float b, float c, float d) { int p = 0; p = __builtin_amdgcn_cvt_pk_fp8_f32(a, b, p, false); p = __builtin_amdgcn_cvt_pk_fp8_f32(c, d, p, true); return (unsigned)p; }
__device__ __forceinline__ float sat8(float x) { return __builtin_amdgcn_fmed3f(x, -448.0f, 448.0f); }
constexpr float Q8_CLIP = 6.5f, Q8_SA = Q8_CLIP / 127.0f, Q8_INV = 127.0f / Q8_CLIP;
__device__ __forceinline__ unsigned pack4_lo8(unsigned a, unsigned b, unsigned c, unsigned d) { return __builtin_amdgcn_perm(__builtin_amdgcn_perm(d, c, 0x0c0c0400u), __builtin_amdgcn_perm(b, a, 0x0c0c0400u), 0x05040100u); }
__device__ __forceinline__ unsigned q8_1(float v) { const float M = 12582912.0f; return __builtin_bit_cast(unsigned, __builtin_amdgcn_fmed3f(__builtin_fmaf(v, Q8_INV, M), M - 127.0f, M + 127.0f)); }
__device__ __forceinline__ unsigned q8x4(float a, float b, float c, float d) { return pack4_lo8(q8_1(a), q8_1(b), q8_1(c), q8_1(d)); }
struct EpiSwiglu8 {
    static constexpr bool PERM = true; static constexpr int NST = 8; static constexpr unsigned SCALE_W = 0x7a7a7a7au;
    unsigned char* O; int ldc;
    __device__ __forceinline__ void operator()(const f32x4 (&acc)[2][2][4][2], const Unit& u, int wr, int wc, int fr, int fq) const {
        const int row0 = u.pm * BM + wr * 64 + fr, col0 = u.pn * HALF + wc * 32 + 8 * fq;
#pragma unroll
        for (int ai = 0; ai < 2; ++ai)
#pragma unroll
            for (int m = 0; m < 4; ++m) { unsigned char* rowp = O + (size_t)(row0 + ai * HALF + m * 16) * ldc + col0;
                const f32x4 g0 = acc[ai][0][m][0], g1 = acc[ai][0][m][1], u0 = acc[ai][1][m][0], u1 = acc[ai][1][m][1];
                const f32x4 y0 = swiglu4(g0, u0), y1 = swiglu4(g1, u1);
                v2u w; w.x = pk4_fp8(sat8(y0[0]), sat8(y0[1]), sat8(y0[2]), sat8(y0[3])); w.y = pk4_fp8(sat8(y1[0]), sat8(y1[1]), sat8(y1[2]), sat8(y1[3]));
                *(v2u*)rowp = w; }
    }
};
struct EpiL1in {
    static constexpr bool PERM = true; static constexpr int NST = 8;
    bf16_t* GB; bf16_t* UP;
    __device__ __forceinline__ void operator()(const f32x4 (&acc)[2][2][4][2], const Unit& u, int wr, int wc, int fr, int fq) const {
        const int row0 = u.pm * BM + wr * 64 + fr;
        if (u.pn < 4) {
            const int col0 = u.pn * BM + wc * 32 + 8 * fq;
#pragma unroll
            for (int ai = 0; ai < 2; ++ai)
#pragma unroll
                for (int m = 0; m < 4; ++m) { bf16_t* rowp = GB + (size_t)(row0 + ai * HALF + m * 16) * D_ + col0;
#pragma unroll
                    for (int bj = 0; bj < 2; ++bj) { const f32x4 v0 = acc[ai][bj][m][0], v1 = acc[ai][bj][m][1];
                        v4u w; w.x = cvt_pk_bf16(v0[0], v0[1]); w.y = cvt_pk_bf16(v0[2], v0[3]); w.z = cvt_pk_bf16(v1[0], v1[1]); w.w = cvt_pk_bf16(v1[2], v1[3]);
                        *(v4u*)(rowp + bj * HALF) = w; } }
        } else {
            const int col0 = (u.pn - 4) * HALF + wc * 32 + 8 * fq;
#pragma unroll
            for (int ai = 0; ai < 2; ++ai)
#pragma unroll
                for (int m = 0; m < 4; ++m) { bf16_t* rowp = UP + (size_t)(row0 + ai * HALF + m * 16) * D_ + col0;
                    const f32x4 g0 = acc[ai][0][m][0], g1 = acc[ai][0][m][1], u0 = acc[ai][1][m][0], u1 = acc[ai][1][m][1];
                    v4u w; w.x = cvt_pk_bf16(g0[0] * u0[0], g0[1] * u0[1]); w.y = cvt_pk_bf16(g0[2] * u0[2], g0[3] * u0[3]);
                    w.z = cvt_pk_bf16(g1[0] * u1[0], g1[1] * u1[1]); w.w = cvt_pk_bf16(g1[2] * u1[2], g1[3] * u1[3]);
                    *(v4u*)rowp = w; }
        }
    }
};
struct EpiLora {
    static constexpr bool PERM = true; static constexpr int NST = 16;
    bf16_t* WLOG; bf16_t* AB; bf16_t* GBUF; const float* w0; const float* a0;
    __device__ __forceinline__ void operator()(const f32x4 (&acc)[2][2][4][2], const Unit& u, int wr, int wc, int fr, int fq) const {
        const int row0 = u.pm * BM + wr * 64 + fr, sec = u.pn >> 1, chb = (u.pn & 1) * BM + wc * 32 + 8 * fq;
        f32x4 bia[2][2];
#pragma unroll
        for (int bj = 0; bj < 2; ++bj)
#pragma unroll
            for (int n = 0; n < 2; ++n) { const int ch = chb + bj * HALF + n * 4; bia[bj][n] = sec == 0 ? *(const f32x4*)(w0 + ch) : (sec == 1 ? *(const f32x4*)(a0 + ch) : (f32x4){0.f, 0.f, 0.f, 0.f}); }
        if (sec == 0) {
#pragma unroll
            for (int bj = 0; bj < 2; ++bj)
#pragma unroll
                for (int ai = 0; ai < 2; ++ai)
#pragma unroll
                    for (int m = 0; m < 4; ++m) { const size_t ro = (size_t)(row0 + ai * HALF + m * 16) * 512 + chb + bj * HALF; const f32x4 v0 = acc[ai][bj][m][0] + bia[bj][0], v1 = acc[ai][bj][m][1] + bia[bj][1]; f32x4 o0, o1;
#pragma unroll
                        for (int j = 0; j < 4; ++j) { o0[j] = -0.60653065971263342f * __builtin_amdgcn_rcpf(1.0f + __expf(-v0[j])); o1[j] = -0.60653065971263342f * __builtin_amdgcn_rcpf(1.0f + __expf(-v1[j])); }
                        v4u w; w.x = cvt_pk_bf16(o0[0], o0[1]); w.y = cvt_pk_bf16(o0[2], o0[3]); w.z = cvt_pk_bf16(o1[0], o1[1]); w.w = cvt_pk_bf16(o1[2], o1[3]); *(v4u*)(WLOG + ro) = w; }
        } else if (sec == 1) {
#pragma unroll
            for (int bj = 0; bj < 2; ++bj)
#pragma unroll
                for (int ai = 0; ai < 2; ++ai)
#pragma unroll
                    for (int m = 0; m < 4; ++m) { const size_t ro = (size_t)(row0 + ai * HALF + m * 16) * 512 + chb + bj * HALF; const f32x4 v0 = acc[ai][bj][m][0] + bia[bj][0], v1 = acc[ai][bj][m][1] + bia[bj][1]; f32x4 o0, o1;
#pragma unroll
                        for (int j = 0; j < 4; ++j) { o0[j] = __builtin_amdgcn_rcpf(1.0f + __expf(-v0[j])); o1[j] = __builtin_amdgcn_rcpf(1.0f + __expf(-v1[j])); }
                        v4u w; w.x = cvt_pk_bf16(o0[0], o0[1]); w.y = cvt_pk_bf16(o0[2], o0[3]); w.z = cvt_pk_bf16(o1[0], o1[1]); w.w = cvt_pk_bf16(o1[2], o1[3]); *(v4u*)(AB + ro) = w; }
        } else {
#pragma unroll
            for (int bj = 0; bj < 2; ++bj)
#pragma unroll
                for (int ai = 0; ai < 2; ++ai)
#pragma unroll
                    for (int m = 0; m < 4; ++m) { const size_t ro = (size_t)(row0 + ai * HALF + m * 16) * 512 + chb + bj * HALF; const f32x4 v0 = acc[ai][bj][m][0], v1 = acc[ai][bj][m][1];
                        v4u w; w.x = cvt_pk_bf16(v0[0], v0[1]); w.y = cvt_pk_bf16(v0[2], v0[3]); w.z = cvt_pk_bf16(v1[0], v1[1]); w.w = cvt_pk_bf16(v1[2], v1[3]); *(v4u*)(GBUF + ro) = w; }
        }
    }
};
__device__ __forceinline__ void row_stats(const float* stp, int row, float& mu, float& r) {
    const f32x4 a = *(const f32x4*)(stp + (size_t)row * 8), b = *(const f32x4*)(stp + (size_t)row * 8 + 4);
    const float s = ((a[0] + a[2]) + b[0]) + b[2], q = ((a[1] + a[3]) + b[1]) + b[3];
    mu = s * (1.0f / 1024.0f); r = rsqrtf(fmaxf(q * (1.0f / 1024.0f) - mu * mu, 0.f) + LN_EPS);
}
struct EpiResStats {
    static constexpr bool PERM = false; static constexpr int NST = 32;
    const float* base; float* out; bf16_t* outb; float* stp_out; PG8_LAS float* P; const PG8_LAS float* tbl; const float* stp_in; const float* gin; const float* bin;
    __device__ __forceinline__ void operator()(const f32x4 (&acc)[2][2][4][2], const Unit& u, int wr, int wc, int fr, int fq) const {
        const int row0 = u.pm * BM + wr * 64 + fr, col0 = u.pn * BM + wc * 32 + 4 * fq;
        f32x4 gv[2][2], bv[2][2];
        if (stp_in) {
#pragma unroll
            for (int bj = 0; bj < 2; ++bj)
#pragma unroll
                for (int n = 0; n < 2; ++n) { gv[bj][n] = *(const f32x4*)(gin + col0 + bj * HALF + n * 16); bv[bj][n] = *(const f32x4*)(bin + col0 + bj * HALF + n * 16); } }
#pragma unroll
        for (int ai = 0; ai < 2; ++ai)
#pragma unroll
            for (int m = 0; m < 4; ++m) { const int row = row0 + ai * HALF + m * 16; const size_t off = (size_t)row * D_ + col0;
                float mu = 0.f, rr = 1.f; if (stp_in) { const f32x2 mr = *(const PG8_LAS f32x2*)(tbl + (u.ui * 256 + ai * HALF + wr * 64 + m * 16 + fr) * 2); mu = mr[0]; rr = mr[1]; }
                float s = 0.f, q = 0.f;
#pragma unroll
                for (int bj = 0; bj < 2; ++bj)
#pragma unroll
                    for (int n = 0; n < 2; ++n) { f32x4 h = *(const f32x4*)(base + off + bj * HALF + n * 16);
                        if (stp_in) h = (h - mu) * rr * gv[bj][n] + bv[bj][n];
                        const f32x4 v = h * ALPHA + acc[ai][bj][m][n];
                        *(f32x4*)(out + off + bj * HALF + n * 16) = v;
                        if (outb) { v2u w; w.x = cvt_pk_bf16(v[0], v[1]); w.y = cvt_pk_bf16(v[2], v[3]); *(v2u*)(outb + off + bj * HALF + n * 16) = w; }
                        s += (v[0] + v[1]) + (v[2] + v[3]); q += (v[0] * v[0] + v[1] * v[1]) + (v[2] * v[2] + v[3] * v[3]); }
                if (stp_out) { s += __shfl_xor(s, 16); s += __shfl_xor(s, 32); q += __shfl_xor(q, 16); q += __shfl_xor(q, 32);
                    if (fq == 0) { PG8_LAS float* p = P + ((ai * HALF + wr * 64 + m * 16 + fr) * 4 + wc) * 2; p[0] = s; p[1] = q; } } }
        if (stp_out) {
            asm volatile("s_waitcnt lgkmcnt(0)" ::: "memory"); __builtin_amdgcn_s_barrier(); asm volatile("" ::: "memory");
            const int t = threadIdx.x;
            if (t < 256) { const f32x4 a = *(const PG8_LAS f32x4*)(P + t * 8), b = *(const PG8_LAS f32x4*)(P + t * 8 + 4);
                f32x2 o; o[0] = ((a[0] + a[2]) + b[0]) + b[2]; o[1] = ((a[1] + a[3]) + b[1]) + b[3];
                *(f32x2*)(stp_out + (size_t)(u.pm * BM + t) * 8 + u.pn * 2) = o; } }
    }
};
template <bool BASEF32, bool Q8 = false> struct EpiRes16 {
    static constexpr bool PERM = true; static constexpr int NST = 16; static constexpr int GR = 4, NG = 16 / GR;
    const void* base; bf16_t* outb; float* stp_out; PG8_LAS float* P; const PG8_LAS float* tbl; const float* gin; const float* bin; unsigned char* out8;
    __device__ __forceinline__ void operator()(const f32x4 (&acc)[2][2][4][2], const Unit& u, int wr, int wc, int fr, int fq) const {
        const int row0 = u.pm * BM + wr * 64 + fr, col0 = u.pn * BM + wc * 32 + 8 * fq;
        float s[8], q[8]; v2u q8[Q8 ? GR : 1];
#pragma unroll
        for (int r = 0; r < 8; ++r) { s[r] = 0.f; q[r] = 0.f; }
#pragma unroll
        for (int g = 0; g < NG; ++g) { const int bj = GR == 8 ? g : (g & 1), rb = GR == 8 ? 0 : (g >> 1) * 4, cb = col0 + bj * HALF;
            f32x4 g0 = (f32x4){1.f, 1.f, 1.f, 1.f}, g1 = g0, b0 = (f32x4){0.f, 0.f, 0.f, 0.f}, b1 = b0;
            if (gin) { g0 = *(const f32x4*)(gin + cb); g1 = *(const f32x4*)(gin + cb + 4); b0 = *(const f32x4*)(bin + cb); b1 = *(const f32x4*)(bin + cb + 4); }
            f32x4 hf0[BASEF32 ? GR : 1], hf1[BASEF32 ? GR : 1]; v4u hb[BASEF32 ? 1 : GR];
#pragma unroll
            for (int i = 0; i < GR; ++i) { const int r = rb + i; const size_t off = (size_t)(row0 + (r >> 2) * HALF + (r & 3) * 16) * D_ + cb;
                if constexpr (BASEF32) { hf0[i] = *(const f32x4*)((const float*)base + off); hf1[i] = *(const f32x4*)((const float*)base + off + 4); }
                else hb[i] = *(const v4u*)((const bf16_t*)base + off); }
            if constexpr (Q8) { if (g > 0) { const int pbj = GR == 8 ? g - 1 : ((g - 1) & 1), prb = GR == 8 ? 0 : ((g - 1) >> 1) * 4;
#pragma unroll
                for (int i = 0; i < GR; ++i) { const int r = prb + i; *(v2u*)(out8 + (size_t)(row0 + (r >> 2) * HALF + (r & 3) * 16) * D_ + col0 + pbj * HALF) = q8[i]; } } }
#pragma unroll
            for (int i = 0; i < GR; ++i) { const int r = rb + i, ai = r >> 2, m = r & 3, rl = ai * HALF + wr * 64 + m * 16 + fr;
                f32x4 a0, a1;
                if constexpr (BASEF32) { a0 = hf0[i]; a1 = hf1[i]; }
                else { const v4u w = hb[i];
                    a0 = (f32x4){__builtin_bit_cast(float, w.x << 16), __builtin_bit_cast(float, w.x & 0xffff0000u), __builtin_bit_cast(float, w.y << 16), __builtin_bit_cast(float, w.y & 0xffff0000u)};
                    a1 = (f32x4){__builtin_bit_cast(float, w.z << 16), __builtin_bit_cast(float, w.z & 0xffff0000u), __builtin_bit_cast(float, w.w << 16), __builtin_bit_cast(float, w.w & 0xffff0000u)}; }
                if (gin) { const f32x2 mr = *(const PG8_LAS f32x2*)(tbl + (u.ui * 256 + rl) * 2); a0 = (a0 - mr[0]) * mr[1] * g0 + b0; a1 = (a1 - mr[0]) * mr[1] * g1 + b1; }
                const f32x4 v0 = a0 * ALPHA + acc[ai][bj][m][0], v1 = a1 * ALPHA + acc[ai][bj][m][1];
                v4u w; w.x = cvt_pk_bf16(v0[0], v0[1]); w.y = cvt_pk_bf16(v0[2], v0[3]); w.z = cvt_pk_bf16(v1[0], v1[1]); w.w = cvt_pk_bf16(v1[2], v1[3]);
                *(v4u*)(outb + (size_t)(row0 + ai * HALF + m * 16) * D_ + cb) = w;
                if constexpr (Q8) { q8[i].x = q8x4(v0[0], v0[1], v0[2], v0[3]); q8[i].y = q8x4(v1[0], v1[1], v1[2], v1[3]); }
                s[r] += ((v0[0] + v0[1]) + (v0[2] + v0[3])) + ((v1[0] + v1[1]) + (v1[2] + v1[3]));
                q[r] += ((v0[0] * v0[0] + v0[1] * v0[1]) + (v0[2] * v0[2] + v0[3] * v0[3])) + ((v1[0] * v1[0] + v1[1] * v1[1]) + (v1[2] * v1[2] + v1[3] * v1[3])); } }
        if constexpr (Q8) { const int pbj = 1, prb = GR == 8 ? 0 : 4;
#pragma unroll
            for (int i = 0; i < GR; ++i) { const int r = prb + i; *(v2u*)(out8 + (size_t)(row0 + (r >> 2) * HALF + (r & 3) * 16) * D_ + col0 + pbj * HALF) = q8[i]; } }
        if (stp_out) {
#pragma unroll
            for (int r = 0; r < 8; ++r) { float ss = s[r], qq = q[r]; ss += __shfl_xor(ss, 16); ss += __shfl_xor(ss, 32); qq += __shfl_xor(qq, 16); qq += __shfl_xor(qq, 32);
                if (fq == 0) { PG8_LAS float* p = P + (((r >> 2) * HALF + wr * 64 + (r & 3) * 16 + fr) * 4 + wc) * 2; p[0] = ss; p[1] = qq; } }
            asm volatile("s_waitcnt lgkmcnt(0)" ::: "memory"); __builtin_amdgcn_s_barrier(); asm volatile("" ::: "memory");
            const int t = threadIdx.x;
            if (t < 256) { const f32x4 a = *(const PG8_LAS f32x4*)(P + t * 8), b = *(const PG8_LAS f32x4*)(P + t * 8 + 4);
                f32x2 o; o[0] = ((a[0] + a[2]) + b[0]) + b[2]; o[1] = ((a[1] + a[3]) + b[1]) + b[3];
                *(f32x2*)(stp_out + (size_t)(u.pm * BM + t) * 8 + u.pn * 2) = o; } }
    }
};
struct EpiSwigluLN {
    static constexpr bool PERM = true; static constexpr int NST = 8;
    bf16_t* O; int ldc; const PG8_LAS float* tbl; const float* sv; const float* cv;
    __device__ __forceinline__ void operator()(const f32x4 (&acc)[2][2][4][2], const Unit& u, int wr, int wc, int fr, int fq) const {
        const int row0 = u.pm * BM + wr * 64 + fr, col0 = u.pn * HALF + wc * 32 + 8 * fq, n0 = u.pn * BM + wc * 32 + 8 * fq;
        f32x4 sg[2], cg[2], su[2], cu[2];
#pragma unroll
        for (int n = 0; n < 2; ++n) { sg[n] = *(const f32x4*)(sv + n0 + 4 * n); cg[n] = *(const f32x4*)(cv + n0 + 4 * n); su[n] = *(const f32x4*)(sv + n0 + HALF + 4 * n); cu[n] = *(const f32x4*)(cv + n0 + HALF + 4 * n); }
#pragma unroll
        for (int ai = 0; ai < 2; ++ai)
#pragma unroll
            for (int m = 0; m < 4; ++m) { const int row = row0 + ai * HALF + m * 16; bf16_t* rowp = O + (size_t)row * ldc + col0;
                const f32x2 mr = *(const PG8_LAS f32x2*)(tbl + (u.ui * 256 + ai * HALF + wr * 64 + m * 16 + fr) * 2); const float mu = mr[0], rr = mr[1];
                const f32x4 g0 = (acc[ai][0][m][0] - sg[0] * mu) * rr + cg[0], g1 = (acc[ai][0][m][1] - sg[1] * mu) * rr + cg[1];
                const f32x4 u0 = (acc[ai][1][m][0] - su[0] * mu) * rr + cu[0], u1 = (acc[ai][1][m][1] - su[1] * mu) * rr + cu[1];
                v4u w; w.x = cvt_pk_bf16(silu_f(g0[0]) * u0[0], silu_f(g0[1]) * u0[1]); w.y = cvt_pk_bf16(silu_f(g0[2]) * u0[2], silu_f(g0[3]) * u0[3]);
                w.z = cvt_pk_bf16(silu_f(g1[0]) * u1[0], silu_f(g1[1]) * u1[1]); w.w = cvt_pk_bf16(silu_f(g1[2]) * u1[2], silu_f(g1[3]) * u1[3]);
                *(v4u*)rowp = w; }
    }
};
struct EpiSwigluLNi8 {
    static constexpr bool PERM = true; static constexpr int NST = 8;
    bf16_t* O; int ldc; const PG8_LAS float* tbl; const float* sc; const float* sv; const float* cv;
    __device__ __forceinline__ void operator()(const f32x4 (&acc)[2][2][4][2], const Unit& u, int wr, int wc, int fr, int fq) const {
        const int row0 = u.pm * BM + wr * 64 + fr, col0 = u.pn * HALF + wc * 32 + 8 * fq, n0 = u.pn * BM + wc * 32 + 8 * fq;
        f32x4 kg[2], sg[2], cg[2], ku[2], su[2], cu[2];
#pragma unroll
        for (int n = 0; n < 2; ++n) { kg[n] = *(const f32x4*)(sc + n0 + 4 * n); sg[n] = *(const f32x4*)(sv + n0 + 4 * n); cg[n] = *(const f32x4*)(cv + n0 + 4 * n);
            ku[n] = *(const f32x4*)(sc + n0 + HALF + 4 * n); su[n] = *(const f32x4*)(sv + n0 + HALF + 4 * n); cu[n] = *(const f32x4*)(cv + n0 + HALF + 4 * n); }
#define I2F(x) __builtin_convertvector(__builtin_bit_cast(v4i, (x)), f32x4)
#pragma unroll
        for (int ai = 0; ai < 2; ++ai)
#pragma unroll
            for (int m = 0; m < 4; ++m) { const int row = row0 + ai * HALF + m * 16; bf16_t* rowp = O + (size_t)row * ldc + col0;
                const f32x2 mr = *(const PG8_LAS f32x2*)(tbl + (u.ui * 256 + ai * HALF + wr * 64 + m * 16 + fr) * 2); const float mu = mr[0], rr = mr[1];
                const f32x4 g0 = (I2F(acc[ai][0][m][0]) * kg[0] - sg[0] * mu) * rr + cg[0], g1 = (I2F(acc[ai][0][m][1]) * kg[1] - sg[1] * mu) * rr + cg[1];
                const f32x4 u0 = (I2F(acc[ai][1][m][0]) * ku[0] - su[0] * mu) * rr + cu[0], u1 = (I2F(acc[ai][1][m][1]) * ku[1] - su[1] * mu) * rr + cu[1];
                const f32x4 y0 = swiglu4(g0, u0), y1 = swiglu4(g1, u1);
                v4u w; w.x = cvt_pk_bf16(y0[0], y0[1]); w.y = cvt_pk_bf16(y0[2], y0[3]); w.z = cvt_pk_bf16(y1[0], y1[1]); w.w = cvt_pk_bf16(y1[2], y1[3]);
                *(v4u*)rowp = w; }
#undef I2F
    }
};
struct EpiL1inLN {
    static constexpr bool PERM = true; static constexpr int NST = 8;
    bf16_t* GB; bf16_t* UP; const PG8_LAS float* tbl; const float* sv; const float* cv;
    __device__ __forceinline__ void operator()(const f32x4 (&acc)[2][2][4][2], const Unit& u, int wr, int wc, int fr, int fq) const {
        const int row0 = u.pm * BM + wr * 64 + fr, n0 = u.pn * BM + wc * 32 + 8 * fq;
        f32x4 s0[2], c0[2], s1[2], c1[2];
#pragma unroll
        for (int n = 0; n < 2; ++n) { s0[n] = *(const f32x4*)(sv + n0 + 4 * n); c0[n] = *(const f32x4*)(cv + n0 + 4 * n); s1[n] = *(const f32x4*)(sv + n0 + HALF + 4 * n); c1[n] = *(const f32x4*)(cv + n0 + HALF + 4 * n); }
#pragma unroll
        for (int ai = 0; ai < 2; ++ai)
#pragma unroll
            for (int m = 0; m < 4; ++m) { const int row = row0 + ai * HALF + m * 16;
                const f32x2 mr = *(const PG8_LAS f32x2*)(tbl + (u.ui * 256 + ai * HALF + wr * 64 + m * 16 + fr) * 2); const float mu = mr[0], rr = mr[1];
                const f32x4 a0 = (acc[ai][0][m][0] - s0[0] * mu) * rr + c0[0], a1 = (acc[ai][0][m][1] - s0[1] * mu) * rr + c0[1];
                const f32x4 b0 = (acc[ai][1][m][0] - s1[0] * mu) * rr + c1[0], b1 = (acc[ai][1][m][1] - s1[1] * mu) * rr + c1[1];
                if (u.pn < 4) { bf16_t* rowp = GB + (size_t)row * D_ + n0;
                    v4u w; w.x = cvt_pk_bf16(a0[0], a0[1]); w.y = cvt_pk_bf16(a0[2], a0[3]); w.z = cvt_pk_bf16(a1[0], a1[1]); w.w = cvt_pk_bf16(a1[2], a1[3]); *(v4u*)rowp = w;
                    v4u x; x.x = cvt_pk_bf16(b0[0], b0[1]); x.y = cvt_pk_bf16(b0[2], b0[3]); x.z = cvt_pk_bf16(b1[0], b1[1]); x.w = cvt_pk_bf16(b1[2], b1[3]); *(v4u*)(rowp + HALF) = x; }
                else { bf16_t* rowp = UP + (size_t)row * D_ + (u.pn - 4) * HALF + wc * 32 + 8 * fq;
                    v4u w; w.x = cvt_pk_bf16(a0[0] * b0[0], a0[1] * b0[1]); w.y = cvt_pk_bf16(a0[2] * b0[2], a0[3] * b0[3]); w.z = cvt_pk_bf16(a1[0] * b1[0], a1[1] * b1[1]); w.w = cvt_pk_bf16(a1[2] * b1[2], a1[3] * b1[3]); *(v4u*)rowp = w; } }
    }
};
struct EpiL1inLNi8 {
    static constexpr bool PERM = true; static constexpr int NST = 8;
    bf16_t* GB; bf16_t* UP; const PG8_LAS float* tbl; const float* sc; const float* sv; const float* cv;
    __device__ __forceinline__ void operator()(const f32x4 (&acc)[2][2][4][2], const Unit& u, int wr, int wc, int fr, int fq) const {
        const int row0 = u.pm * BM + wr * 64 + fr, n0 = u.pn * BM + wc * 32 + 8 * fq;
        f32x4 k0[2], s0[2], c0[2], k1[2], s1[2], c1[2];
#pragma unroll
        for (int n = 0; n < 2; ++n) { k0[n] = *(const f32x4*)(sc + n0 + 4 * n); s0[n] = *(const f32x4*)(sv + n0 + 4 * n); c0[n] = *(const f32x4*)(cv + n0 + 4 * n);
            k1[n] = *(const f32x4*)(sc + n0 + HALF + 4 * n); s1[n] = *(const f32x4*)(sv + n0 + HALF + 4 * n); c1[n] = *(const f32x4*)(cv + n0 + HALF + 4 * n); }
#define I2F(x) __builtin_convertvector(__builtin_bit_cast(v4i, (x)), f32x4)
#pragma unroll
        for (int ai = 0; ai < 2; ++ai)
#pragma unroll
            for (int m = 0; m < 4; ++m) { const int row = row0 + ai * HALF + m * 16;
                const f32x2 mr = *(const PG8_LAS f32x2*)(tbl + (u.ui * 256 + ai * HALF + wr * 64 + m * 16 + fr) * 2); const float mu = mr[0], rr = mr[1];
                const f32x4 a0 = (I2F(acc[ai][0][m][0]) * k0[0] - s0[0] * mu) * rr + c0[0], a1 = (I2F(acc[ai][0][m][1]) * k0[1] - s0[1] * mu) * rr + c0[1];
                const f32x4 b0 = (I2F(acc[ai][1][m][0]) * k1[0] - s1[0] * mu) * rr + c1[0], b1 = (I2F(acc[ai][1][m][1]) * k1[1] - s1[1] * mu) * rr + c1[1];
                if (u.pn < 4) { bf16_t* rowp = GB + (size_t)row * D_ + n0;
                    v4u w; w.x = cvt_pk_bf16(a0[0], a0[1]); w.y = cvt_pk_bf16(a0[2], a0[3]); w.z = cvt_pk_bf16(a1[0], a1[1]); w.w = cvt_pk_bf16(a1[2], a1[3]); *(v4u*)rowp = w;
                    v4u x; x.x = cvt_pk_bf16(b0[0], b0[1]); x.y = cvt_pk_bf16(b0[2], b0[3]); x.z = cvt_pk_bf16(b1[0], b1[1]); x.w = cvt_pk_bf16(b1[2], b1[3]); *(v4u*)(rowp + HALF) = x; }
                else { bf16_t* rowp = UP + (size_t)row * D_ + (u.pn - 4) * HALF + wc * 32 + 8 * fq;
                    v4u w; w.x = cvt_pk_bf16(a0[0] * b0[0], a0[1] * b0[1]); w.y = cvt_pk_bf16(a0[2] * b0[2], a0[3] * b0[3]); w.z = cvt_pk_bf16(a1[0] * b1[0], a1[1] * b1[1]); w.w = cvt_pk_bf16(a1[2] * b1[2], a1[3] * b1[3]); *(v4u*)rowp = w; } }
#undef I2F
    }
};
struct EpiMoeDown {
    static constexpr bool PERM = true; static constexpr int NST = 0; static constexpr unsigned SCALE_W = 0x78787878u;
    float* out; bf16_t* Y2; const int* perm; const float* slotp;
    __device__ __forceinline__ void operator()(const f32x4 (&acc)[2][2][4][2], const Unit& u, int wr, int wc, int fr, int fq) const {
        const int slot0 = u.pm * BM + wr * 64 + fr, col0 = u.pn * BM + wc * 32 + 8 * fq; const int pass = u.pm >= MAXPANEL ? 1 : 0;
        int tk[8]; float pw[8];
#pragma unroll
        for (int r = 0; r < 8; ++r) { const int sl = slot0 + (r >> 2) * HALF + (r & 3) * 16; tk[r] = perm[sl]; pw[r] = slotp[sl]; }
#pragma unroll
        for (int r = 0; r < 8; ++r) { const int ai = r >> 2, m = r & 3, tok = tk[r];
            if (tok >= 0) { const float p = pw[r];
                bf16_t* dst = pass == 0 ? (bf16_t*)out + (size_t)tok * 2048 + 1024 + col0 : Y2 + (size_t)tok * D_ + col0;
#pragma unroll
                for (int bj = 0; bj < 2; ++bj) { const f32x4 v0 = acc[ai][bj][m][0] * p, v1 = acc[ai][bj][m][1] * p;
                    v4u w; w.x = cvt_pk_bf16(v0[0], v0[1]); w.y = cvt_pk_bf16(v0[2], v0[3]); w.z = cvt_pk_bf16(v1[0], v1[1]); w.w = cvt_pk_bf16(v1[2], v1[3]);
                    *(v4u*)(dst + bj * HALF) = w; } } }
    }
};
}

#define XB_TMO      128
#define XB_XCNT(j)  (256  + 64 * (j))
#define XB_XSUB(j)  (1280 + 64 * (j))
#define XB_XGEN(j)  (2304 + 64 * (j))
#define XB_TOP      3328
#define XB_TOPGEN   3392
#define XCD_BAR_WORDS 3456
#define XB_SPIN_CAP (1u << 22)
__device__ __forceinline__ unsigned xb_ld(unsigned* p)              { return __hip_atomic_load(p, __ATOMIC_RELAXED, __HIP_MEMORY_SCOPE_AGENT); }
__device__ __forceinline__ unsigned xb_add(unsigned* p, unsigned v) { return __hip_atomic_fetch_add(p, v, __ATOMIC_RELAXED, __HIP_MEMORY_SCOPE_AGENT); }
__device__ __forceinline__ unsigned xb_xcc_id() { return (unsigned)__builtin_amdgcn_s_getreg((3 << 11) | 20) & 0xFu; }
#define XB_SPIN(cond, bar) do { unsigned _sp = 0; while (cond) { __builtin_amdgcn_s_sleep(1); \
    if ((++_sp & 255u) == 0u) { if (xb_ld(&(bar)[XB_TMO])) break; if (_sp > XB_SPIN_CAP) { atomicAdd(&(bar)[XB_TMO], 1u); break; } } } } while (0)
struct XcdBarrier { unsigned* bar; unsigned x; volatile LAS unsigned* st; };
__device__ __forceinline__ XcdBarrier xcd_barrier_post(unsigned* bar, volatile LAS unsigned* st) {
    XcdBarrier b; b.bar = bar; b.x = xb_xcc_id(); b.st = st;
    if (threadIdx.x == 0) (void)xb_add(&bar[XB_XCNT(b.x)], 1u);
    return b;
}
__device__ __forceinline__ void xcd_barrier_complete(unsigned* bar, unsigned x, unsigned& nloc, unsigned& nx) {
    const unsigned G = gridDim.x * gridDim.y * gridDim.z;
    unsigned sum, cnt, mine, sp = 0u;
    for (;;) {
        sum = 0u; cnt = 0u; mine = 0u;
#pragma unroll
        for (unsigned j = 0; j < 16; ++j) { const unsigned c = xb_ld(&bar[XB_XCNT(j)]); sum += c; cnt += (c > 0u) ? 1u : 0u; mine = (j == x) ? c : mine; }
        if (sum == G) break;
        __builtin_amdgcn_s_sleep(1);
        if ((++sp & 255u) == 0u) { if (xb_ld(&bar[XB_TMO])) break; if (sp > XB_SPIN_CAP) { atomicAdd(&bar[XB_TMO], 1u); break; } }
    }
    nloc = mine > 0u ? mine : 1u; nx = cnt > 0u ? cnt : 1u;
}
__device__ __forceinline__ void xcd_barrier(const XcdBarrier& b) {
    asm volatile("s_waitcnt vmcnt(0)" ::: "memory");
    __syncthreads();
    if (threadIdx.x == 0) {
        unsigned* bar = b.bar;
        __builtin_amdgcn_s_waitcnt(0);
        unsigned nloc = b.st[0], nx = b.st[1];
        if (nloc == 0u) { xcd_barrier_complete(bar, b.x, nloc, nx); b.st[0] = nloc; b.st[1] = nx; }
        const unsigned old = xb_add(&bar[XB_XSUB(b.x)], 1u);
        const unsigned gen = old / nloc;
        if (old + 1u == (gen + 1u) * nloc) {
            __builtin_amdgcn_fence(__ATOMIC_RELEASE, "agent");
            asm volatile("s_waitcnt vmcnt(0)" ::: "memory");
            const unsigned og = xb_add(&bar[XB_TOP], 1u);
            const unsigned tg = og / nx;
            if (og + 1u == (tg + 1u) * nx) xb_add(&bar[XB_TOPGEN], 1u);
            else XB_SPIN(xb_ld(&bar[XB_TOPGEN]) == tg, bar);
            __builtin_amdgcn_fence(__ATOMIC_ACQUIRE, "agent");
            xb_add(&bar[XB_XGEN(b.x)], 1u);
            asm volatile("s_waitcnt vmcnt(0)" ::: "memory");
        } else {
            XB_SPIN(xb_ld(&bar[XB_XGEN(b.x)]) == gen, bar);
            __builtin_amdgcn_fence(__ATOMIC_ACQUIRE, "agent");
            asm volatile("s_waitcnt vmcnt(0)" ::: "memory");
        }
    }
    __syncthreads();
}

__device__ __forceinline__ unsigned f2bf(float f) { unsigned u = __builtin_bit_cast(unsigned, f); return (u + 0x7fffu + ((u >> 16) & 1u)) >> 16; }
__device__ __forceinline__ unsigned pk2(float lo, float hi) { return pg8::cvt_pk_bf16(lo, hi); }
__device__ __forceinline__ float bf2f(unsigned short b) { return __builtin_bit_cast(float, ((unsigned)b) << 16); }
__device__ __forceinline__ float bflo(unsigned w) { return __builtin_bit_cast(float, w << 16); }
__device__ __forceinline__ float bfhi(unsigned w) { return __builtin_bit_cast(float, w & 0xffff0000u); }
__device__ __forceinline__ float wave_sum(float v) {
#pragma unroll
    for (int o = 1; o < 64; o <<= 1) v += __shfl_xor(v, o);
    return v;
}
template <int CTRL> __device__ __forceinline__ float dpp_mov(float x) { return __builtin_bit_cast(float, __builtin_amdgcn_update_dpp(0, __builtin_bit_cast(int, x), CTRL, 0xf, 0xf, false)); }
__device__ __forceinline__ float row16_sum(float x) { x += dpp_mov<0x128>(x); x += dpp_mov<0x124>(x); x += dpp_mov<0x122>(x); x += dpp_mov<0x121>(x); return x; }

__device__ __forceinline__ float rl_f(float x, int l) { return __builtin_bit_cast(float, __builtin_amdgcn_readlane(__builtin_bit_cast(int, x), l)); }
template <int CTRL, int RMASK> __device__ __forceinline__ float dpp_add_rm(float x) { return x + __builtin_bit_cast(float, __builtin_amdgcn_update_dpp(0, __builtin_bit_cast(int, x), CTRL, RMASK, 0xf, true)); }
__device__ __forceinline__ float wave_sum_fast(float x) { x = row16_sum(x); x = dpp_add_rm<0x142, 0xA>(x); x = dpp_add_rm<0x143, 0xC>(x); return rl_f(x, 63); }
struct WInfo { int tid, lane, wave, vcu, G, gw, NGW; };

__device__ __forceinline__ void tr_item(const float* __restrict__ W, int Nsrc, int c0, int k0, bf16* WT, int K, int n0, LAS float* scr, int lane, const float* ksc = nullptr) {
    { float v[32], g[32];
#pragma unroll
      for (int i = 0; i < 32; ++i) { const int kk = 2 * i + (lane >> 5); v[i] = W[(size_t)(k0 + kk) * Nsrc + c0 + (lane & 31)]; g[i] = ksc ? ksc[k0 + kk] : 1.0f; }
      asm volatile("" ::: "memory");
#pragma unroll
      for (int i = 0; i < 32; ++i) { const int kk = 2 * i + (lane >> 5); scr[kk * 33 + (lane & 31)] = v[i] * g[i]; } }
    LDS_WAIT(); asm volatile("" ::: "memory");
    const int c = lane & 7;
#pragma unroll
    for (int j = 0; j < 4; ++j) { const int n = (lane >> 3) + 8 * j; const LAS float* s = scr + (8 * c) * 33 + n;
        v4u o; o.x = pk2(s[0 * 33], s[1 * 33]); o.y = pk2(s[2 * 33], s[3 * 33]); o.z = pk2(s[4 * 33], s[5 * 33]); o.w = pk2(s[6 * 33], s[7 * 33]);
        *(v4u*)(WT + (size_t)(n0 + n) * K + k0 + 8 * c) = o; }
    LDS_WAIT(); asm volatile("" ::: "memory");
}
__device__ __forceinline__ void tr_item8(const float* __restrict__ Wsrc, int Nsrc, int c0, int k0, unsigned char* WT, int K, int n0, float scale, LAS float* scr, int lane) {
#pragma unroll 32
    for (int i = 0; i < 32; ++i) { const int kk = 2 * i + (lane >> 5); scr[kk * 33 + (lane & 31)] = Wsrc[(size_t)(k0 + kk) * Nsrc + c0 + (lane & 31)] * scale; }
    LDS_WAIT(); asm volatile("" ::: "memory");
    const int n = lane & 31, kh = lane >> 5; const LAS float* s = scr + (kh * 32) * 33 + n;
    v4u o0, o1;
#pragma unroll
    for (int q = 0; q < 4; ++q) { o0[q] = pg8::pk4_fp8(s[(4 * q) * 33], s[(4 * q + 1) * 33], s[(4 * q + 2) * 33], s[(4 * q + 3) * 33]); o1[q] = pg8::pk4_fp8(s[(16 + 4 * q) * 33], s[(17 + 4 * q) * 33], s[(18 + 4 * q) * 33], s[(19 + 4 * q) * 33]); }
    unsigned char* dst = WT + (size_t)(n0 + n) * K + k0 + kh * 32; *(v4u*)dst = o0; *(v4u*)(dst + 16) = o1;
    LDS_WAIT(); asm volatile("" ::: "memory");
}
constexpr int I_WIN0 = 0  , I_WOUT = 16 * 32, I_FGU = 0  , I_FD = 44 * 32, I_IN1 = 0  , I_MGU1 = 16 * 224, I_MD1 = 56 * 32;
constexpr int NITEMS_MOE = 8 * I_MGU1 + 8 * I_MD1, NITEMS = I_WIN0 + I_WOUT + I_FGU + I_FD + I_IN1 + I_WOUT + NITEMS_MOE;
__device__ __forceinline__ void weight_item(const WInfo& W, LAS unsigned char* lds, const float* const* in, unsigned char* ws, int it) {
    LAS float* scr = (LAS float*)(lds + W.wave * 16384);
    for (int once = 0; once < 1; ++once) {
        int r = it;
        if (r < 8 * I_MGU1) { const int e = r / I_MGU1, r2 = r % I_MGU1, kb = r2 / 224, nb = r2 % 224, n0 = nb * 32, q = n0 >> 8, rr = n0 & 255;
            const float* src = (rr < 128 ? in[29] : in[30]) + (size_t)e * 1024 * FFE;
            tr_item8(src, FFE, q * 128 + (rr & 127), kb * 64, ws + WS_WMGU + (size_t)e * 7168 * 1024, 1024, n0, 32.0f * (rr < 128 ? pg8::SW_TG : pg8::SW_TU), scr, W.lane); continue; } r -= 8 * I_MGU1;
        if (r < 8 * I_MD1) { const int e = r / I_MD1, r2 = r % I_MD1, kb = r2 / 32, nb = r2 % 32;
            tr_item8(in[31] + (size_t)e * FFE * 1024, 1024, nb * 32, kb * 64, ws + WS_WMD + (size_t)e * 1024 * FFE, FFE, nb * 32, 128.0f, scr, W.lane); continue; } r -= 8 * I_MD1;
        if (r < I_WIN0) { const int kb = r / 80, nb = r % 80; tr_item(in[2], NZ, nb * 32, kb * 64, (bf16*)(ws + WS_WIN0), 1024, nb * 32, scr, W.lane); continue; } r -= I_WIN0;
        if (r < I_WOUT) { const int kb = r / 32, nb = r % 32; tr_item(in[15], 1024, nb * 32, kb * 64, (bf16*)(ws + WS_WOUT0), 1024, nb * 32, scr, W.lane); continue; } r -= I_WOUT;
        if (r < I_FGU) { const int kb = r / 176, nb = r % 176, n0 = nb * 32, q = n0 >> 8, rr = n0 & 255;
            tr_item(rr < 128 ? in[18] : in[19], FF, q * 128 + (rr & 127), kb * 64, (bf16*)(ws + WS_WFGU), 1024, n0, scr, W.lane, in[16]); continue; } r -= I_FGU;
        if (r < I_FD) { const int kb = r / 32, nb = r % 32; tr_item(in[20], 1024, nb * 32, kb * 64, (bf16*)(ws + WS_WFD), FF, nb * 32, scr, W.lane); continue; } r -= I_FD;
        if (r < I_IN1) { const int kb = r / 96, nb = r % 96, n0 = nb * 32; int c0 = n0;
            if (n0 >= 1024) { const int q = (n0 - 1024) >> 8, rr = (n0 - 1024) & 255; c0 = (rr < 128 ? 1024 : 2048) + q * 128 + (rr & 127); }
            tr_item(in[23], 3072, c0, kb * 64, (bf16*)(ws + WS_WIN1), 1024, n0, scr, W.lane, in[21]); continue; } r -= I_IN1;
        { const int kb = r / 32, nb = r % 32; tr_item(in[25], 1024, nb * 32, kb * 64, (bf16*)(ws + WS_WOUT1), 1024, nb * 32, scr, W.lane); }
    }
}
struct MoeItem { const float* src; unsigned char* dst; int Nsrc, K; float scale; };
__device__ __forceinline__ MoeItem moe_item(const float* const* in, unsigned char* ws, int it) {
    MoeItem d;
    if (it < 8 * I_MGU1) { const int e = it / I_MGU1, r2 = it % I_MGU1, kb = r2 / 224, nb = r2 % 224, n0 = nb * 32, q = n0 >> 8, rr = n0 & 255;
        d.src = (rr < 128 ? in[29] : in[30]) + (size_t)e * 1024 * FFE + (size_t)(kb * 64) * FFE + q * 128 + (rr & 127); d.Nsrc = FFE;
        d.dst = ws + WS_WMGU + (size_t)e * 7168 * 1024 + (size_t)n0 * 1024 + kb * 64; d.K = 1024; d.scale = 32.0f * (rr < 128 ? pg8::SW_TG : pg8::SW_TU); }
    else { const int r = it - 8 * I_MGU1, e = r / I_MD1, r2 = r % I_MD1, kb = r2 / 32, nb = r2 % 32;
        d.src = in[31] + (size_t)e * FFE * 1024 + (size_t)(kb * 64) * 1024 + nb * 32; d.Nsrc = 1024;
        d.dst = ws + WS_WMD + (size_t)e * 1024 * FFE + (size_t)(nb * 32) * FFE + kb * 64; d.K = FFE; d.scale = 128.0f; }
    return d;
}
__device__ __forceinline__ void moe_item_load(float (&v)[32], const MoeItem& d, int lane) {
#pragma unroll
    for (int i = 0; i < 32; ++i) v[i] = d.src[(size_t)(2 * i + (lane >> 5)) * d.Nsrc + (lane & 31)];
}
__device__ __forceinline__ void moe_item_finish(const float (&v)[32], const MoeItem& d, LAS float* scr, int lane) {
#pragma unroll
    for (int i = 0; i < 32; ++i) scr[(2 * i + (lane >> 5)) * 33 + (lane & 31)] = v[i] * d.scale;
    LDS_WAIT(); asm volatile("" ::: "memory");
    const int n = lane & 31, kh = lane >> 5; const LAS float* s = scr + (kh * 32) * 33 + n;
    v4u o0, o1;
#pragma unroll
    for (int q = 0; q < 4; ++q) { o0[q] = pg8::pk4_fp8(s[(4 * q) * 33], s[(4 * q + 1) * 33], s[(4 * q + 2) * 33], s[(4 * q + 3) * 33]); o1[q] = pg8::pk4_fp8(s[(16 + 4 * q) * 33], s[(17 + 4 * q) * 33], s[(18 + 4 * q) * 33], s[(19 + 4 * q) * 33]); }
    unsigned char* dst = d.dst + (size_t)n * d.K + kh * 32; *(v4u*)dst = o0; *(v4u*)(dst + 16) = o1;
    LDS_WAIT(); asm volatile("" ::: "memory");
}
__device__ __forceinline__ void moe_weights(const WInfo& W, LAS unsigned char* lds, const float* const* in, unsigned char* ws) {
    LAS float* scr = (LAS float*)(lds + W.wave * 16384);
    float va[32], vb[32]; MoeItem da, db;
    int it = W.gw;
    if (it < NITEMS_MOE) { da = moe_item(in, ws, it); moe_item_load(va, da, W.lane); }
    while (it < NITEMS_MOE) {
        const int i1 = it + W.NGW, i2 = it + 2 * W.NGW;
        if (i1 < NITEMS_MOE) { db = moe_item(in, ws, i1); moe_item_load(vb, db, W.lane); }
        asm volatile("" ::: "memory");
        moe_item_finish(va, da, scr, W.lane);
        if (i1 >= NITEMS_MOE) break;
        if (i2 < NITEMS_MOE) { da = moe_item(in, ws, i2); moe_item_load(va, da, W.lane); }
        asm volatile("" ::: "memory");
        moe_item_finish(vb, db, scr, W.lane);
        it = i2;
    }
}
__device__ __forceinline__ void p0_weights(const WInfo& W, LAS unsigned char* lds, const float* const* in, unsigned char* ws, int it_lo, int it_hi) {
    for (int it = it_lo + W.gw; it < it_hi; it += W.NGW) weight_item(W, lds, in, ws, it);
}
__device__ __forceinline__ void lnvec_block(const WInfo& W, LAS unsigned char* lds, const float* const* in, unsigned char* ws, int blk) {
    LAS float* red = (LAS float*)lds;
    float* SV = (float*)(ws + WS_LNV); float* CV = SV + 8704; float* SC = SV + 17408;
    {
        const bool ffn = blk < 88, plain = blk >= 136; const int n = (ffn ? blk : plain ? blk - 136 : blk - 88) * 64 + W.lane;
        const float* src; int Nsrc, col; const float* gk; const float* bk;
        if (ffn) { const int q = n >> 8, rr = n & 255; src = rr < 128 ? in[18] : in[19]; Nsrc = FF; col = q * 128 + (rr & 127); gk = in[16]; bk = in[17]; }
        else if (plain) { src = in[2]; Nsrc = NZ; col = n; gk = in[16]; bk = in[17]; }
        else { src = in[23]; Nsrc = 3072; col = n; if (n >= 1024) { const int q = (n - 1024) >> 8, rr = (n - 1024) & 255; col = (rr < 128 ? 1024 : 2048) + q * 128 + (rr & 127); } gk = in[21]; bk = in[22]; }
        const int o = (ffn ? 0 : 5632) + n;
        {
            const float* p = src + (size_t)(W.wave * 128) * Nsrc + col; const float* gw = gk + W.wave * 128; const float* bw = bk + W.wave * 128;
            float am = 0.f, c = 0.f;
#pragma unroll 1
            for (int j = 0; j < 2; ++j) { float v[64];
#pragma unroll
                for (int i = 0; i < 64; ++i) v[i] = p[(size_t)(j * 64 + i) * Nsrc];
                asm volatile("" ::: "memory");
#pragma unroll
                for (int i = 0; i < 64; ++i) { am = fmaxf(am, fabsf(v[i] * (plain ? 1.0f : gw[j * 64 + i]))); c += v[i] * bw[j * 64 + i]; } }
            __syncthreads();
            red[(W.wave * 64 + W.lane) * 2] = am; red[(W.wave * 64 + W.lane) * 2 + 1] = c;
            __syncthreads();
            float amax = 0.f, cc = 0.f;
#pragma unroll
            for (int w8 = 0; w8 < 8; ++w8) { amax = fmaxf(amax, red[(w8 * 64 + W.lane) * 2]); cc += red[(w8 * 64 + W.lane) * 2 + 1]; }
            const float sn = amax > 0.f ? amax * (1.0f / 127.0f) : 1.0f, inv = 1.0f / sn;
            __syncthreads();
            int isum = 0;
            unsigned char* dst = ws + (ffn ? WS_WFGU : plain ? WS_WIN0 : WS_WIN1) + (size_t)n * 1024 + W.wave * 128;
#pragma unroll 1
            for (int j = 0; j < 4; ++j) { float v[32];
#pragma unroll
                for (int i = 0; i < 32; ++i) v[i] = p[(size_t)(j * 32 + i) * Nsrc];
                asm volatile("" ::: "memory");
#pragma unroll
                for (int i = 0; i < 32; ++i) v[i] *= (plain ? 1.0f : gw[j * 32 + i]);
#pragma unroll
                for (int hh = 0; hh < 2; ++hh) { v4u ov;
#pragma unroll
                    for (int d = 0; d < 4; ++d) { int q[4];
#pragma unroll
                        for (int e = 0; e < 4; ++e) { q[e] = (int)__builtin_rintf(v[16 * hh + 4 * d + e] * inv); isum += q[e]; }
                        ov[d] = pg8::pack4_lo8((unsigned)q[0], (unsigned)q[1], (unsigned)q[2], (unsigned)q[3]); }
                    *(v4u*)(dst + j * 32 + hh * 16) = ov; } }
            red[W.wave * 64 + W.lane] = (float)isum;
            __syncthreads();
            if (W.wave == 0) { float tot = 0.f;
#pragma unroll
                for (int w8 = 0; w8 < 8; ++w8) tot += red[w8 * 64 + W.lane];
                const float cf = ffn ? ((n & 255) < 128 ? pg8::SW_TG : pg8::SW_TU) : 1.0f;
                if (plain) SV[26112 + n] = sn; else { SC[o] = pg8::Q8_SA * sn * cf; SV[o] = sn * tot * cf; CV[o] = cc * cf; } }
        }
    }
}
__device__ __forceinline__ void p0_xrows(const WInfo& W, const float* const* in, unsigned char* ws, int first, int stride, int end) {
    unsigned char* XQ = ws + WS_XQ; float* XS = (float*)(ws + WS_XS); bf16* XBp = (bf16*)(ws + WS_B0);
    for (int m = first; m < end; m += 2 * stride) { const bool has2 = m + stride < end; const int mm[2] = {m, has2 ? m + stride : m};
        f32x4 a[2][4];
#pragma unroll
        for (int r = 0; r < 2; ++r)
#pragma unroll
            for (int j = 0; j < 4; ++j) a[r][j] = *(const f32x4*)(in[0] + (size_t)mm[r] * D_ + 16 * W.lane + 4 * j);
        asm volatile("" ::: "memory");
#pragma unroll
        for (int r = 0; r < 2; ++r) { float am = 0.f;
#pragma unroll
            for (int j = 0; j < 4; ++j) am = fmaxf(fmaxf(am, fmaxf(fabsf(a[r][j][0]), fabsf(a[r][j][1]))), fmaxf(fabsf(a[r][j][2]), fabsf(a[r][j][3])));
#pragma unroll
            for (int o = 1; o < 64; o <<= 1) am = fmaxf(am, __shfl_xor(am, o));
            const float sc = am > 0.f ? am * (1.0f / 127.0f) : 1.0f, inv = 1.0f / sc;
            v4u q, b0, b1;
#pragma unroll
            for (int j = 0; j < 4; ++j) q[j] = pg8::pack4_lo8((unsigned)(int)__builtin_rintf(a[r][j][0] * inv), (unsigned)(int)__builtin_rintf(a[r][j][1] * inv), (unsigned)(int)__builtin_rintf(a[r][j][2] * inv), (unsigned)(int)__builtin_rintf(a[r][j][3] * inv));
            b0.x = pk2(a[r][0][0], a[r][0][1]); b0.y = pk2(a[r][0][2], a[r][0][3]); b0.z = pk2(a[r][1][0], a[r][1][1]); b0.w = pk2(a[r][1][2], a[r][1][3]);
            b1.x = pk2(a[r][2][0], a[r][2][1]); b1.y = pk2(a[r][2][2], a[r][2][3]); b1.z = pk2(a[r][3][0], a[r][3][1]); b1.w = pk2(a[r][3][2], a[r][3][3]);
            if (r == 0 || has2) { bf16* xb = XBp + (size_t)mm[r] * D_ + 16 * W.lane; *(v4u*)xb = b0; *(v4u*)(xb + 8) = b1;
                *(v4u*)(XQ + (size_t)mm[r] * D_ + 16 * W.lane) = q;
                if (W.lane == 0) XS[mm[r]] = sc; } } }
}
__device__ __forceinline__ void p0_prologue(const WInfo& W, LAS unsigned char* lds, const float* const* in, unsigned char* ws) {
    if (blockIdx.x < 40) lnvec_block(W, lds, in, ws, 136 + (int)blockIdx.x);
    __syncthreads();
    const size_t gtid = (size_t)W.gw * 64 + W.lane, NT = (size_t)W.NGW * 64;
    { bf16* WL = (bf16*)(ws + WS_WLORA);
      for (size_t i = gtid; i < (size_t)1536 * 256; i += NT) { const int n = (int)(i >> 8), k = (int)(i & 255), s = n >> 9, ch = n & 511; float v = 0.f;
          if (s == 0) { if (k < 64) v = in[6][k * 512 + ch]; } else if (s == 1) { if (k >= 64 && k < 128) v = in[8][(k - 64) * 512 + ch]; } else { if (k >= 128) v = in[9][(k - 128) * 512 + ch]; }
          WL[i] = (bf16)f2bf(v); } }
    { constexpr int NWW = 40, RPW = 17; const int bx = (int)blockIdx.x, R0 = (W.G - NWW) * 8 * RPW;
      if (W.G > NWW && R0 <= T_) { if (bx >= NWW) p0_xrows(W, in, ws, (bx - NWW) * 8 + W.wave, (W.G - NWW) * 8, R0); else p0_xrows(W, in, ws, R0 + bx * 8 + W.wave, NWW * 8, T_); }
      else p0_xrows(W, in, ws, W.gw, W.NGW, T_); }
    { int* pm = (int*)(ws + WS_PERM); for (size_t i = gtid; i < (size_t)2 * PERMLEN; i += NT) pm[i] = -1; }
}

__device__ __forceinline__ void deferred_work(const WInfo& W, LAS unsigned char* lds, const float* const* in, unsigned char* ws, unsigned* qctr) {
    constexpr int ITEM0 = NITEMS_MOE + I_WIN0, NCH = (NITEMS - ITEM0 + 7) / 8;
    LAS int* qsh = (LAS int*)(lds + RING_BYTES);
    for (;;) {
        __syncthreads();
        if (W.tid == 0) qsh[0] = (int)__hip_atomic_fetch_add(qctr, 1u, __ATOMIC_RELAXED, __HIP_MEMORY_SCOPE_AGENT);
        __syncthreads();
        const int q = qsh[0]; if (q >= 136 + NCH) break;
        if (q < 136) lnvec_block(W, lds, in, ws, q);
        else { const int it = ITEM0 + (q - 136) * 8 + W.wave; if (it < NITEMS) weight_item(W, lds, in, ws, it); }
    }
}
#define MFMA32(a, b, c) __builtin_amdgcn_mfma_f32_32x32x16_bf16((a), (b), (c), 0, 0, 0)
__device__ __forceinline__ void attn_phase(const WInfo& W, LAS unsigned char* lds, const bf16* Z, bf16* MIX, const float* sinks, const float* relb, unsigned* qctr) {
    LAS bf16* Ks = (LAS bf16*)lds;
    LAS bf16* Vt = (LAS bf16*)(lds + 36864);
    LAS float* BT = (LAS float*)(lds + 36864 + 33280);
    const int tid = W.tid, lane = W.lane, w = W.wave, r32 = lane & 31, hh = lane >> 5;
    LAS float* BB = (LAS float*)(lds + 36864 + 33280 + 16 * 388 * 4);
    for (int i = tid; i < 1024; i += 512) { const int hq = i >> 7, dist = i & 127; int bucket = dist;
        if (dist >= 16) { const float lr = logf((float)dist / 16.0f) / 2.0794415416798357f; bucket = 16 + (int)(lr * 16.0f); if (bucket > 31) bucket = 31; }
        BB[i] = relb[bucket * 8 + hq] * LOG2E; }
    int last_kvh = -1;
    LAS int* qsh = (LAS int*)(lds + RING_BYTES);
    if (tid == 0) qsh[0] = (int)__hip_atomic_fetch_add(qctr, 1u, __ATOMIC_RELAXED, __HIP_MEMORY_SCOPE_AGENT);
    for (;;) {
        __syncthreads();
        const int u = qsh[0];
        __syncthreads();
        if (u >= 512) break;
        if (tid == 0) qsh[0] = (int)__hip_atomic_fetch_add(qctr, 1u, __ATOMIC_RELAXED, __HIP_MEMORY_SCOPE_AGENT);
        const int b = u >> 6, kvh = (u >> 5) & 1, nb = u & 31;
        if (kvh != last_kvh) { last_kvh = kvh;
            for (int i = tid; i < 16 * 388; i += 512) { const int k = i / (4 * 388), g = (i / 388) & 3, y = i % 388, x = y + k - 128;
                BT[i] = (x >= 1 && x <= 128) ? BB[(kvh * 4 + g) * 128 + (128 - x)] : 0.f; } }
        { const int key = tid >> 1, half = tid & 1, s = nb * 128 - 128 + key;
          v4u kq[4], vq[4];
          if (s >= 0) { const bf16* zr = Z + (size_t)(b * SEQ + s) * NZ;
#pragma unroll
              for (int j = 0; j < 4; ++j) { kq[j] = *(const v4u*)(zr + 512 + kvh * 64 + half * 32 + 8 * j); vq[j] = *(const v4u*)(zr + 640 + kvh * 64 + half * 32 + 8 * j); } }
          else {
#pragma unroll
              for (int j = 0; j < 4; ++j) { kq[j] = (v4u){0u, 0u, 0u, 0u}; vq[j] = (v4u){0u, 0u, 0u, 0u}; } }
#pragma unroll
          for (int j = 0; j < 4; ++j) { *(LAS v4u*)(Ks + key * 72 + half * 32 + 8 * j) = kq[j];
#pragma unroll
              for (int e = 0; e < 4; ++e) { const unsigned wv = vq[j][e]; const int d = half * 32 + 8 * j + 2 * e; Vt[d * 260 + key] = (bf16)(wv & 0xffffu); Vt[(d + 1) * 260 + key] = (bf16)(wv >> 16); } } }
        __syncthreads();
        const int g = w >> 1, rh = w & 1, habs = kvh * 4 + g;
        bf16x8 qf[2][4]; int qi[2]; size_t mq[2];
#pragma unroll
        for (int qt = 0; qt < 2; ++qt) { qi[qt] = 64 * rh + 32 * qt + r32; mq[qt] = (size_t)(b * SEQ + nb * 128 + qi[qt]);
#pragma unroll
            for (int s = 0; s < 4; ++s) qf[qt][s] = *(const bf16x8*)(Z + mq[qt] * NZ + habs * 64 + 16 * s + 8 * hh); }
        const float sinkl = sinks[habs] * LOG2E;
        float mrun[2] = {sinkl, sinkl}, lsum[2] = {hh == 0 ? 1.f : 0.f, hh == 0 ? 1.f : 0.f};
        f32x16 ot[2][2];
#pragma unroll
        for (int a = 0; a < 2; ++a)
#pragma unroll
            for (int c = 0; c < 2; ++c)
#pragma unroll
                for (int i = 0; i < 16; ++i) ot[a][c][i] = 0.f;
        for (int ks = 2 * rh; ks < 2 * rh + 6; ++ks) {
            bool act[2], full[2];
#pragma unroll
            for (int qt = 0; qt < 2; ++qt) { const int q0 = 64 * rh + 32 * qt, q1 = q0 + 31, k0 = 32 * ks, k1 = k0 + 31;
                act[qt] = (k1 - q0 >= 1) && (k0 - q1 <= 128) && (nb > 0 || k1 >= 128);
                full[qt] = (k0 - q1 >= 1) && (k1 - q0 <= 128) && (nb > 0 || k0 >= 128); }
            if (!act[0] && !act[1]) continue;
            f32x16 sc[2];
#pragma unroll
            for (int qt = 0; qt < 2; ++qt)
#pragma unroll
                for (int i = 0; i < 16; ++i) sc[qt][i] = 0.f;
#pragma unroll
            for (int s = 0; s < 4; ++s) { const bf16x8 kf = *(const LAS bf16x8*)(Ks + (32 * ks + r32) * 72 + 16 * s + 8 * hh);
                if (act[0]) sc[0] = MFMA32(kf, qf[0][s], sc[0]); if (act[1]) sc[1] = MFMA32(kf, qf[1][s], sc[1]); }
            bf16x8 pf[2][2];
#pragma unroll
            for (int qt = 0; qt < 2; ++qt) if (act[qt]) {
                float mx = -1e30f;
#pragma unroll
                for (int c = 0; c < 4; ++c) { const int kbase = 32 * ks + 8 * c + 4 * hh, xbase = kbase - qi[qt], X = xbase + 128, kk = X & 3, y = X - kk;
                    const f32x4 b4 = *(const LAS f32x4*)(BT + (kk * 4 + g) * 388 + y);
                    if (full[qt]) {
#pragma unroll
                        for (int j = 0; j < 4; ++j) { const float t = sc[qt][4 * c + j] * (0.125f * LOG2E) + b4[j]; sc[qt][4 * c + j] = t; mx = fmaxf(mx, t); }
                    } else {
#pragma unroll
                        for (int j = 0; j < 4; ++j) { const int x = xbase + j; const bool valid = (x >= 1) && (x <= 128) && (nb > 0 || kbase + j >= 128);
                            const float t = valid ? (sc[qt][4 * c + j] * (0.125f * LOG2E) + b4[j]) : -1e30f; sc[qt][4 * c + j] = t; mx = fmaxf(mx, t); } } }
                mx = fmaxf(mx, __shfl_xor(mx, 32));
                const float mnew = fmaxf(mrun[qt], mx), corr = __builtin_amdgcn_exp2f(mrun[qt] - mnew); mrun[qt] = mnew;
                float ps = 0.f;
#pragma unroll
                for (int i = 0; i < 16; ++i) { const float p = __builtin_amdgcn_exp2f(sc[qt][i] - mnew); sc[qt][i] = p; ps += p; }
                lsum[qt] = lsum[qt] * corr + ps;
#pragma unroll
                for (int dt = 0; dt < 2; ++dt)
#pragma unroll
                    for (int i = 0; i < 16; ++i) ot[dt][qt][i] *= corr;
#pragma unroll
                for (int s2 = 0; s2 < 2; ++s2) { v4u pk;
#pragma unroll
                    for (int e = 0; e < 4; ++e) pk[e] = pk2(sc[qt][8 * s2 + 2 * e], sc[qt][8 * s2 + 2 * e + 1]);
                    pf[qt][s2] = __builtin_bit_cast(bf16x8, pk); } }
#pragma unroll
            for (int dt = 0; dt < 2; ++dt)
#pragma unroll
                for (int s2 = 0; s2 < 2; ++s2) { const int kb0 = 32 * ks + 16 * s2, d = 32 * dt + r32;
                    const s16x4 lo = *(const LAS s16x4*)(Vt + d * 260 + kb0 + 4 * hh), hi = *(const LAS s16x4*)(Vt + d * 260 + kb0 + 8 + 4 * hh);
                    const bf16x8 vf = __builtin_shufflevector(lo, hi, 0, 1, 2, 3, 4, 5, 6, 7);
                    if (act[0]) ot[dt][0] = MFMA32(vf, pf[0][s2], ot[dt][0]); if (act[1]) ot[dt][1] = MFMA32(vf, pf[1][s2], ot[dt][1]); }
        }
#pragma unroll
        for (int qt = 0; qt < 2; ++qt) { const float lt = lsum[qt] + __shfl_xor(lsum[qt], 32), inv = 1.0f / lt;
#pragma unroll
            for (int dt = 0; dt < 2; ++dt)
#pragma unroll
                for (int c = 0; c < 4; ++c) { const int d0 = 32 * dt + 8 * c + 4 * hh; v2u o; o.x = pk2(ot[dt][qt][4 * c] * inv, ot[dt][qt][4 * c + 1] * inv); o.y = pk2(ot[dt][qt][4 * c + 2] * inv, ot[dt][qt][4 * c + 3] * inv);
                    *(v2u*)(MIX + mq[qt] * D_ + habs * 64 + d0) = o; } }
    }
}

__device__ __forceinline__ void aprime_phase(const WInfo& W, const bf16* Z, bf16* AP, const float* mu) {
    const int c = 4 * W.lane;
    const f32x4 m4 = *(const f32x4*)(mu + 1536 + c);
    for (int mb = W.gw; mb < T_; mb += 16 * W.NGW) {
        v2u zc[16], zp[16];
#pragma unroll
        for (int k = 0; k < 16; ++k) { const int m = mb + k * W.NGW; zc[k] = (v2u){0u, 0u}; zp[k] = (v2u){0u, 0u};
            if (m < T_) { zc[k] = *(const v2u*)(Z + (size_t)m * NZ + 2304 + c); if ((m & (SEQ - 1)) != 0) zp[k] = *(const v2u*)(Z + (size_t)(m - 1) * NZ + 2304 + c); } }
#pragma unroll
        for (int k = 0; k < 16; ++k) { const int m = mb + k * W.NGW; if (m >= T_) break;
            float z[4] = {bflo(zc[k].x), bfhi(zc[k].x), bflo(zc[k].y), bfhi(zc[k].y)}, p[4] = {bflo(zp[k].x), bfhi(zp[k].x), bflo(zp[k].y), bfhi(zp[k].y)}, o[4];
#pragma unroll
            for (int j = 0; j < 4; ++j) { const float v = z[j] + (p[j] - z[j]) * m4[j]; const float e = __expf(c < 64 ? -2.0f * v : -v), r = __builtin_amdgcn_rcpf(1.0f + e);
                o[j] = c < 64 ? (2.0f * r - 1.0f) : (c < 128 ? v : r); }
            v2u w; w.x = pk2(o[0], o[1]); w.y = pk2(o[2], o[3]); *(v2u*)(AP + (size_t)m * 256 + c) = w; }
    }
}

constexpr int SL_W = 0, SL_R = 2048, SL_BKT = 4096, SL_ARBK = 8192, SL_M1 = 9216, SL_PC = 9728, SLOT_BYTES = 10240;
static_assert(WS_SLOT + (size_t)64 * 256 * SLOT_BYTES <= WS_B0, "slots end below the activation buffers");
#define MFMA16(a, b, c) __builtin_amdgcn_mfma_f32_16x16x32_bf16((a), (b), (c), 0, 0, 0)
__device__ __forceinline__ bf16x8 mk8(v2u lo, v2u hi) { v4u q; q.x = lo.x; q.y = lo.y; q.z = hi.x; q.w = hi.y; return __builtin_bit_cast(bf16x8, q); }
struct S1In { unsigned short zr[17], zk[17], av[16], wl[16]; };
__device__ __forceinline__ void s1_load(S1In& o, int unit, int lane, const bf16* Z, const bf16* WLOG, const bf16* AB) {
    const int c = 255 - (unit >> 6), bh = unit & 63, h = bh & 7, b = bh >> 3, chn = h * 64 + lane; const size_t m0 = (size_t)b * SEQ + c * 16;
    const bf16* zp = Z + (m0 - (c > 0 ? 1 : 0)) * NZ + 768 + chn; o.zr[0] = zp[0]; o.zk[0] = zp[512];
#pragma unroll
    for (int t = 0; t < 16; ++t) { const bf16* zc = Z + (m0 + t) * NZ + 768 + chn; o.zr[1 + t] = zc[0]; o.zk[1 + t] = zc[512]; o.wl[t] = WLOG[(m0 + t) * 512 + chn]; o.av[t] = AB[(m0 + t) * 512 + chn]; }
}
__device__ __forceinline__ void scan_prep_phase(const WInfo& W, LAS unsigned char* lds, const bf16* Z, const bf16* WLOG, const bf16* AB, unsigned char* slots, float* bonus,
                                                const float* mu, const float* k_k, const float* k_a, const float* r_k) {
    LAS unsigned char* sc = lds + W.wave * 16384;
    LAS bf16* RT = (LAS bf16*)sc; LAS bf16* AT = (LAS bf16*)(sc + 2304); LAS bf16* BT = (LAS bf16*)(sc + 4608); LAS bf16* KT = (LAS bf16*)(sc + 6912);
    LAS bf16* ATT = (LAS bf16*)(sc + 9216);
    LAS float* AAB = (LAS float*)(sc + 11264);
    LAS bf16* M1x = (LAS bf16*)(sc + 11264);
    LAS bf16* TT = (LAS bf16*)(sc + 12288);
    LAS bf16* WW = (LAS bf16*)(sc + 12800);
    LAS bf16* ARx = (LAS bf16*)(sc + 15104);
    const int lane = W.lane, fr = lane & 15, g = lane >> 4;
    S1In cur, nxt;
    if (W.gw < 64 * 256) s1_load(nxt, W.gw, lane, Z, WLOG, AB);
    for (int unit = W.gw; unit < 64 * 256; unit += W.NGW) {
        const int c = 255 - (unit >> 6), bh = unit & 63, h = bh & 7, b = bh >> 3;
        const int chn = h * 64 + lane; const size_t m0 = (size_t)b * SEQ + c * 16;
        unsigned char* slot = slots + (size_t)(bh * 256 + c) * SLOT_BYTES;
        const float mu_r = mu[chn], mu_k = mu[512 + chn], kkc = k_k[chn], kac = k_a[chn], rkc = r_k[chn];
        cur = nxt;
        if (unit + W.NGW < 64 * 256) s1_load(nxt, unit + W.NGW, lane, Z, WLOG, AB);
        float pr = (c > 0) ? bf2f(cur.zr[0]) : 0.f, pk = (c > 0) ? bf2f(cur.zk[0]) : 0.f;
        float lw = 0.f, Pprev = 1.f, bsave = 0.f, Pt = 1.f;
        unsigned apk[8], bpk[8], kpk[8]; float ah = 0.f, bh2 = 0.f, kh = 0.f;
#pragma unroll
        for (int t = 0; t < 16; ++t) {
            const float zr = bf2f(cur.zr[1 + t]), zk = bf2f(cur.zk[1 + t]); const float wl = bf2f(cur.wl[t]), av = bf2f(cur.av[t]);
            const float r = zr + (pr - zr) * mu_r, kz = zk + (pk - zk) * mu_k; pr = zr; pk = zk;
            float kk = kz * kkc; const float nrm = sqrtf(wave_sum_fast(kk * kk)); kk = kk * __builtin_amdgcn_rcpf(fmaxf(nrm, 1e-12f));
            const float k2 = kz * (1.0f + (av - 1.0f) * kac);
            const float bo = wave_sum_fast(r * k2 * rkc); if (lane == t) bsave = bo;
            lw += wl; Pt = __expf(lw); const float iP = __expf(-lw);
            const float rt = r * Pt, kt = k2 * iP, at = -kk * Pprev, bt = kk * av * iP; Pprev = Pt;
            { const unsigned ra = pk2(rt, at), bk = pk2(bt, kt); RT[t * 72 + lane] = (bf16)(ra & 0xffffu); AT[t * 72 + lane] = (bf16)(ra >> 16); BT[t * 72 + lane] = (bf16)(bk & 0xffffu); KT[t * 72 + lane] = (bf16)(bk >> 16); }
            if (t & 1) { apk[t >> 1] = pk2(ah, at); bpk[t >> 1] = pk2(bh2, bt); kpk[t >> 1] = pk2(kh, kt); } else { ah = at; bh2 = bt; kh = kt; }
        }
        *(LAS v4u*)(ATT + lane * 16) = (v4u){apk[0], apk[1], apk[2], apk[3]}; *(LAS v4u*)(ATT + lane * 16 + 8) = (v4u){apk[4], apk[5], apk[6], apk[7]};
#pragma unroll
        for (int gg = 0; gg < 4; ++gg) *(v4u*)(slot + SL_BKT + ((lane >> 4) * 64 + gg * 16 + (lane & 15)) * 16) = (v4u){bpk[2 * gg], bpk[2 * gg + 1], kpk[2 * gg], kpk[2 * gg + 1]};
        *(float*)(slot + SL_PC + lane * 4) = Pt;
        if (lane < 16) bonus[(m0 + lane) * 8 + h] = bsave;
        LDS_WAIT(); asm volatile("" ::: "memory");
        f32x4 Aab = (f32x4){0.f, 0.f, 0.f, 0.f}, Aak = Aab, Arb = Aab, Ark = Aab;
#pragma unroll
        for (int s = 0; s < 2; ++s) { const int o = fr * 72 + 32 * s + 8 * g;
            const bf16x8 af = *(const LAS bf16x8*)(AT + o), rf = *(const LAS bf16x8*)(RT + o), bb = *(const LAS bf16x8*)(BT + o), kb = *(const LAS bf16x8*)(KT + o);
            Aab = MFMA16(af, bb, Aab); Aak = MFMA16(af, kb, Aak); Arb = MFMA16(rf, bb, Arb); Ark = MFMA16(rf, kb, Ark); }
#pragma unroll
        for (int rg = 0; rg < 4; ++rg) { const int t = 4 * g + rg; const bool lo = fr < t, le = fr <= t;
            Aab[rg] = lo ? Aab[rg] : 0.f; Aak[rg] = lo ? Aak[rg] : 0.f; Arb[rg] = le ? Arb[rg] : 0.f; Ark[rg] = le ? Ark[rg] : 0.f;
            AAB[t * 16 + fr] = Aab[rg]; { const unsigned rk = pk2(Arb[rg], Ark[rg]); ARx[t * 16 + fr] = (bf16)(rk & 0xffffu); ARx[256 + t * 16 + fr] = (bf16)(rk >> 16); } }
        LDS_WAIT(); asm volatile("" ::: "memory");
        float Tc[16];
#pragma unroll
        for (int t = 0; t < 16; ++t) { float acc = (t == fr) ? 1.f : 0.f;
#pragma unroll
            for (int q4 = 0; q4 < (t + 3) / 4; ++q4) { const f32x4 a4 = *(const LAS f32x4*)(AAB + t * 16 + 4 * q4);
#pragma unroll
                for (int e = 0; e < 4; ++e) if (4 * q4 + e < t) acc += a4[e] * Tc[4 * q4 + e]; }
            Tc[t] = acc; }
#pragma unroll
        for (int t = 0; t < 16; t += 2) { const unsigned tt = pk2(Tc[t], Tc[t + 1]); TT[t * 16 + fr] = (bf16)(tt & 0xffffu); TT[(t + 1) * 16 + fr] = (bf16)(tt >> 16); }
        LDS_WAIT(); asm volatile("" ::: "memory");
        const v2u z2 = (v2u){0u, 0u};
        const bf16x8 Tf = mk8(*(const LAS v2u*)(TT + fr * 16 + 4 * g), z2);
        { v2u ak; ak.x = pk2(Aak[0], Aak[1]); ak.y = pk2(Aak[2], Aak[3]);
          const f32x4 M1 = MFMA16(Tf, mk8(ak, z2), ((f32x4){0.f, 0.f, 0.f, 0.f}));
          f32x4 Wt[4];
#pragma unroll
          for (int jt = 0; jt < 4; ++jt) Wt[jt] = MFMA16(Tf, mk8(*(const LAS v2u*)(ATT + (16 * jt + fr) * 16 + 4 * g), z2), ((f32x4){0.f, 0.f, 0.f, 0.f}));
#pragma unroll
          for (int rg = 0; rg < 4; ++rg) { const int t = 4 * g + rg; const unsigned w01 = pk2(Wt[0][rg], Wt[1][rg]), w23 = pk2(Wt[2][rg], Wt[3][rg]), m1 = pk2(M1[rg], 0.f); M1x[t * 16 + fr] = (bf16)(m1 & 0xffffu);
              WW[t * 72 + fr] = (bf16)(w01 & 0xffffu); WW[t * 72 + 16 + fr] = (bf16)(w01 >> 16); WW[t * 72 + 32 + fr] = (bf16)(w23 & 0xffffu); WW[t * 72 + 48 + fr] = (bf16)(w23 >> 16); } }
        LDS_WAIT(); asm volatile("" ::: "memory");
#pragma unroll
        for (int s = 0; s < 2; ++s) { const int o = fr * 72 + 32 * s + 4 * g;
            const v2u w0 = *(const LAS v2u*)(WW + o), w1 = *(const LAS v2u*)(WW + o + 16), r0 = *(const LAS v2u*)(RT + o), r1 = *(const LAS v2u*)(RT + o + 16);
            *(v4u*)(slot + SL_W + (s * 64 + lane) * 16) = (v4u){w0.x, w0.y, w1.x, w1.y}; *(v4u*)(slot + SL_R + (s * 64 + lane) * 16) = (v4u){r0.x, r0.y, r1.x, r1.y}; }
        { const v2u x0 = *(const LAS v2u*)(ARx + fr * 16 + 4 * g), x1 = *(const LAS v2u*)(ARx + 256 + fr * 16 + 4 * g), m1 = *(const LAS v2u*)(M1x + fr * 16 + 4 * g);
          *(v4u*)(slot + SL_ARBK + lane * 16) = (v4u){x0.x, x0.y, x1.x, x1.y}; *(v2u*)(slot + SL_M1 + lane * 8) = m1; }
        LDS_WAIT(); asm volatile("" ::: "memory");
    }
}
__device__ __forceinline__ void glds16(const void* gsrc, unsigned lds_dst) { unsigned keep;
    asm volatile("s_mov_b32 %0, m0\n\ts_mov_b32 m0, %2\n\ts_nop 0\n\tglobal_load_lds_dwordx4 %1, off\n\ts_mov_b32 m0, %0" : "=&s"(keep) : "v"(gsrc), "s"(lds_dst) : "memory"); }
struct ScanOps { bf16x8 Wf[2], Rf[2], Bk[4], ARBK; v2u M1; f32x4 PC[4]; unsigned vz[5]; unsigned pad; };
constexpr int S2_NS = 12, S2_D = 11, S2_VST = 2048;
__device__ __forceinline__ void scan_lds_load(ScanOps& o, const LAS unsigned char* st, const LAS unsigned char* vs, const LAS unsigned char* vprev, int lane, int g, int icol) {
#pragma unroll
    for (int s = 0; s < 2; ++s) { o.Wf[s] = *(const LAS bf16x8*)(st + SL_W + (s * 64 + lane) * 16); o.Rf[s] = *(const LAS bf16x8*)(st + SL_R + (s * 64 + lane) * 16); }
#pragma unroll
    for (int jt = 0; jt < 4; ++jt) { o.Bk[jt] = *(const LAS bf16x8*)(st + SL_BKT + (jt * 64 + lane) * 16); o.PC[jt] = *(const LAS f32x4*)(st + SL_PC + (16 * jt + 4 * g) * 4); }
    o.ARBK = *(const LAS bf16x8*)(st + SL_ARBK + lane * 16); o.M1 = *(const LAS v2u*)(st + SL_M1 + lane * 8);
    o.vz[0] = (unsigned)*(const LAS unsigned short*)((g == 0 ? vprev + 15 * 128 : vs + (4 * g - 1) * 128) + icol * 2);
#pragma unroll
    for (int j = 0; j < 4; ++j) o.vz[1 + j] = (unsigned)*(const LAS unsigned short*)(vs + (4 * g + j) * 128 + icol * 2);
    o.pad = 0u;
}
__device__ __forceinline__ void scan_issue(int cc, int lw, int lane, const unsigned char* sbase, const bf16* zvh, LAS unsigned char* ring, LAS unsigned char* vring) {
    const unsigned char* slot = sbase + (size_t)cc * SLOT_BYTES; LAS unsigned char* st = ring + (cc % S2_NS) * 10240; LAS unsigned char* vs = vring + (cc % S2_NS) * S2_VST;
#pragma unroll
    for (int k = 0; k < 3; ++k) { const int p = lw + 4 * k; if (p < 10) glds16(slot + p * 1024 + lane * 16, (unsigned)(size_t)(st + p * 1024)); }
    if (lw >= 2) { const int blk = lw - 2; const int r = cc * 16 + blk * 8 + (lane >> 3);
        glds16((const unsigned char*)(zvh + (size_t)r * NZ) + (lane & 7) * 16, (unsigned)(size_t)(vs + blk * 1024)); }
}
__device__ __forceinline__ void scan_seq_phase(const WInfo& W, LAS unsigned char* lds, const bf16* Z, const unsigned char* slots, bf16* YRAW, const float* mu) {
    const int id = blockIdx.x; if (id >= 64) return;
    const int lane = W.lane, fr = lane & 15, g = lane >> 4, w = W.wave;
    const int b = id >> 3, h = id & 7;
    LAS unsigned char* ring = lds; LAS unsigned char* vring = lds + S2_NS * 10240;
    const unsigned char* sbase = slots + (size_t)id * 256 * SLOT_BYTES;
    const bf16* zvh = Z + (size_t)b * SEQ * NZ + 1792 + h * 64;
    const bool loader = w >= 4; const int lw = w - 4;
    const int i = 16 * (w & 3) + fr;
    float mu_v = mu[1024 + h * 64 + i];
    VM_WAIT(); asm volatile("" : "+v"(mu_v));
#define S2_WAIT_AHEAD() asm volatile("s_waitcnt vmcnt(27)" ::: "memory")
    if (loader) { for (int cc = 0; cc < S2_D; ++cc) scan_issue(cc, lw, lane, sbase, zvh, ring, vring); S2_WAIT_AHEAD(); }
    __builtin_amdgcn_s_barrier();
    f32x4 st[4];
#pragma unroll
    for (int jt = 0; jt < 4; ++jt) st[jt] = (f32x4){0.f, 0.f, 0.f, 0.f};
    if (loader) {
        for (int c = 0; c < 256; ++c) {
            if (c + S2_D < 256) { scan_issue(c + S2_D, lw, lane, sbase, zvh, ring, vring); S2_WAIT_AHEAD(); } else asm volatile("s_waitcnt vmcnt(0)" ::: "memory");
            __builtin_amdgcn_s_barrier();
        }
    } else {
        ScanOps opA, opB;
        scan_lds_load(opA, ring, vring, vring, lane, g, i);
        LAS float* ybuf = (LAS float*)(lds + 147456);
        bf16* yo = YRAW + (size_t)b * SEQ * 512 + h * 64 + (size_t)(4 * w + g) * 512 + 4 * fr;
#define S2_STEP(c, CUR, NXT) do { \
            if ((c) + 1 < 256) scan_lds_load(NXT, ring + (((c) + 1) % S2_NS) * 10240, vring + (((c) + 1) % S2_NS) * S2_VST, vring + ((c) % S2_NS) * S2_VST, lane, g, i); \
            float vm[4]; const float zprev = ((c) == 0 && g == 0) ? 0.f : bf2f((unsigned short)CUR.vz[0]); \
            _Pragma("unroll") for (int j = 0; j < 4; ++j) { const float zc = bf2f((unsigned short)CUR.vz[1 + j]), zp = (j == 0) ? zprev : bf2f((unsigned short)CUR.vz[j]); vm[j] = zc + (zp - zc) * mu_v; } \
            v2u vb; vb.x = pk2(vm[0], vm[1]); vb.y = pk2(vm[2], vm[3]); const v2u z2 = (v2u){0u, 0u}; bf16x8 Sb[2]; \
            _Pragma("unroll") for (int s = 0; s < 2; ++s) { v2u lo, hi; lo.x = pk2(st[2 * s][0], st[2 * s][1]); lo.y = pk2(st[2 * s][2], st[2 * s][3]); hi.x = pk2(st[2 * s + 1][0], st[2 * s + 1][1]); hi.y = pk2(st[2 * s + 1][2], st[2 * s + 1][3]); Sb[s] = mk8(lo, hi); } \
            f32x4 U = MFMA16(CUR.Wf[0], Sb[0], ((f32x4){0.f, 0.f, 0.f, 0.f})); U = MFMA16(CUR.Wf[1], Sb[1], U); U = MFMA16(mk8(CUR.M1, z2), mk8(vb, z2), U); \
            f32x4 Y = MFMA16(CUR.Rf[0], Sb[0], ((f32x4){0.f, 0.f, 0.f, 0.f})); Y = MFMA16(CUR.Rf[1], Sb[1], Y); \
            v2u ub; ub.x = pk2(U[0], U[1]); ub.y = pk2(U[2], U[3]); const bf16x8 UV = mk8(ub, vb); \
            Y = MFMA16(CUR.ARBK, UV, Y); \
            _Pragma("unroll") for (int jt = 0; jt < 4; ++jt) { const f32x4 a = MFMA16(CUR.Bk[jt], UV, st[jt]); st[jt] = a * CUR.PC[jt]; } \
            if ((c) > 0) { const f32x4 yv = *(const LAS f32x4*)(ybuf + (((c) - 1) & 1) * 1024 + (4 * w + g) * 64 + 4 * fr); v2u yw; yw.x = pk2(yv[0], yv[1]); yw.y = pk2(yv[2], yv[3]); *(v2u*)(yo + (size_t)(((c) - 1) * 16) * 512) = yw; } \
            _Pragma("unroll") for (int rg = 0; rg < 4; ++rg) ybuf[((c) & 1) * 1024 + (4 * g + rg) * 64 + i] = Y[rg]; \
            LDS_WAIT(); \
            __builtin_amdgcn_s_barrier(); } while (0)
        for (int c = 0; c < 256; c += 2) { S2_STEP(c, opA, opB); S2_STEP(c + 1, opB, opA); }
#undef S2_STEP
        { const f32x4 yv = *(const LAS f32x4*)(ybuf + 1024 + (4 * w + g) * 64 + 4 * fr); v2u yw; yw.x = pk2(yv[0], yv[1]); yw.y = pk2(yv[2], yv[3]); *(v2u*)(yo + (size_t)(255 * 16) * 512) = yw; }
    }
    VM_WAIT();
    __builtin_amdgcn_s_barrier();
#undef S2_WAIT_AHEAD
}

__device__ __forceinline__ float sum8(float x) { x += dpp_mov<0xB1>(x); x += dpp_mov<0x4E>(x); x += dpp_mov<0x141>(x); return x; }
__device__ __forceinline__ void post_phase(const WInfo& W, const bf16* Z, const bf16* GBUF, const bf16* YRAW, const float* bonus, bf16* MIX,
                                           const float* mu, const float* gn_g, const float* gn_b) {
    const int lane = W.lane, c0 = 8 * lane, h = lane >> 3;
    float muv[8], gg[8], gb[8];
#pragma unroll
    for (int j = 0; j < 8; ++j) { muv[j] = mu[1024 + c0 + j]; gg[j] = gn_g[c0 + j]; gb[j] = gn_b[c0 + j]; }
    for (int mb = W.gw; mb < T_; mb += 4 * W.NGW) {
        v4u zc[4], zp[4], gq[4], yq[4]; float bo[4];
#pragma unroll
        for (int k = 0; k < 4; ++k) { const int m = mb + k * W.NGW; const bool first = (m & (SEQ - 1)) == 0;
            zc[k] = *(const v4u*)(Z + (size_t)m * NZ + 1792 + c0);
            zp[k] = (v4u){0u, 0u, 0u, 0u}; if (!first) zp[k] = *(const v4u*)(Z + (size_t)(m - 1) * NZ + 1792 + c0);
            gq[k] = *(const v4u*)(GBUF + (size_t)m * 512 + c0);
            yq[k] = *(const v4u*)(YRAW + (size_t)m * 512 + c0);
            bo[k] = bonus[(size_t)m * 8 + h]; }
#pragma unroll
        for (int k = 0; k < 4; ++k) { const int m = mb + k * W.NGW;
            float y[8] = {bflo(yq[k].x), bfhi(yq[k].x), bflo(yq[k].y), bfhi(yq[k].y), bflo(yq[k].z), bfhi(yq[k].z), bflo(yq[k].w), bfhi(yq[k].w)};
            float s = 0.f;
#pragma unroll
            for (int j = 0; j < 8; ++j) s += y[j];
            const float mean = sum8(s) * (1.0f / 64.0f); float q = 0.f;
#pragma unroll
            for (int j = 0; j < 8; ++j) { y[j] -= mean; q += y[j] * y[j]; }
            const float rstd = rsqrtf(sum8(q) * (1.0f / 64.0f) + GN_EPS);
            float o[8];
#pragma unroll
            for (int j = 0; j < 8; ++j) { const unsigned zw = zc[k][j >> 1], pw = zp[k][j >> 1], gw2 = gq[k][j >> 1];
                const float zv = (j & 1) ? bfhi(zw) : bflo(zw), pv = (j & 1) ? bfhi(pw) : bflo(pw), gv = (j & 1) ? bfhi(gw2) : bflo(gw2);
                const float v = zv + (pv - zv) * muv[j];
                o[j] = (y[j] * rstd * gg[j] + gb[j] + bo[k] * v) * gv; }
            v4u ov; ov.x = pk2(o[0], o[1]); ov.y = pk2(o[2], o[3]); ov.z = pk2(o[4], o[5]); ov.w = pk2(o[6], o[7]);
            *(v4u*)(MIX + (size_t)m * D_ + 512 + c0) = ov; }
    }
}

__device__ __forceinline__ void ln_compute(f32x4 (&v)[4], const f32x4 (&g)[4], const f32x4 (&bb)[4]) {
    float s = 0.f;
#pragma unroll
    for (int j = 0; j < 4; ++j) s += (v[j][0] + v[j][1]) + (v[j][2] + v[j][3]);
    const float mean = wave_sum_fast(s) * (1.f / D_); float s2 = 0.f;
#pragma unroll
    for (int j = 0; j < 4; ++j) { v[j] = v[j] - mean; s2 += (v[j][0] * v[j][0] + v[j][1] * v[j][1]) + (v[j][2] * v[j][2] + v[j][3] * v[j][3]); }
    const float rstd = rsqrtf(wave_sum_fast(s2) * (1.f / D_) + LN_EPS);
#pragma unroll
    for (int j = 0; j < 4; ++j) v[j] = v[j] * rstd * g[j] + bb[j];
}
__device__ __forceinline__ void ln_phase(const WInfo& W, float* X, bf16* XB, const float* gam, const float* bet, const bf16* ADD = nullptr) {
    f32x4 g[4], bb[4];
#pragma unroll
    for (int j = 0; j < 4; ++j) { g[j] = *(const f32x4*)(gam + 4 * W.lane + 256 * j); bb[j] = *(const f32x4*)(bet + 4 * W.lane + 256 * j); }
    for (int m = W.gw; m < T_; m += 2 * W.NGW) {
        const int m2 = m + W.NGW;
        f32x4* xr = (f32x4*)(X + (size_t)m * D_) + W.lane; f32x4* xr2 = (f32x4*)(X + (size_t)m2 * D_) + W.lane; f32x4 v[4], v2[4]; v2u a[4], a2[4];
#pragma unroll
        for (int j = 0; j < 4; ++j) { v[j] = xr[64 * j]; v2[j] = xr2[64 * j]; }
        if (ADD) { const v2u* ar = (const v2u*)(ADD + (size_t)m * D_) + W.lane; const v2u* ar2 = (const v2u*)(ADD + (size_t)m2 * D_) + W.lane;
#pragma unroll
            for (int j = 0; j < 4; ++j) { a[j] = ar[64 * j]; a2[j] = ar2[64 * j]; }
#pragma unroll
            for (int j = 0; j < 4; ++j) { v[j][0] += bflo(a[j].x); v[j][1] += bfhi(a[j].x); v[j][2] += bflo(a[j].y); v[j][3] += bfhi(a[j].y);
                                          v2[j][0] += bflo(a2[j].x); v2[j][1] += bfhi(a2[j].x); v2[j][2] += bflo(a2[j].y); v2[j][3] += bfhi(a2[j].y); } }
        ln_compute(v, g, bb); ln_compute(v2, g, bb);
#pragma unroll
        for (int j = 0; j < 4; ++j) { xr[64 * j] = v[j]; xr2[64 * j] = v2[j]; }
        if (XB) { v2u* o8 = (v2u*)(XB + (size_t)m * D_) + W.lane; v2u* o82 = (v2u*)(XB + (size_t)m2 * D_) + W.lane;
#pragma unroll
            for (int j = 0; j < 4; ++j) { v2u o; o.x = pk2(v[j][0], v[j][1]); o.y = pk2(v[j][2], v[j][3]); o8[64 * j] = o; o.x = pk2(v2[j][0], v2[j][1]); o.y = pk2(v2[j][2], v2[j][3]); o82[64 * j] = o; } }
    }
}
__device__ __forceinline__ void final_ln_pair(const WInfo& W, float* out, const bf16* Y2, const f32x4 (&g)[4], const f32x4 (&bb)[4], int m, int m2, bool do1, bool do2) {
    const v2u* hr = (const v2u*)((const bf16*)out + (size_t)m * 2048) + W.lane; const v2u* hr2 = (const v2u*)((const bf16*)out + (size_t)m2 * 2048) + W.lane;
    const v2u* yr = (const v2u*)(Y2 + (size_t)m * D_) + W.lane; const v2u* yr2 = (const v2u*)(Y2 + (size_t)m2 * D_) + W.lane;
    v2u h[4], y1[4], y2[4], hB[4], y1B[4], y2B[4];
#pragma unroll
    for (int j = 0; j < 4; ++j) { h[j] = hr[64 * j]; y1[j] = hr[256 + 64 * j]; y2[j] = yr[64 * j]; hB[j] = hr2[64 * j]; y1B[j] = hr2[256 + 64 * j]; y2B[j] = yr2[64 * j]; }
    f32x4 v[4], v2[4];
#pragma unroll
    for (int j = 0; j < 4; ++j) {
        v[j] = (f32x4){bflo(h[j].x) * ALPHA + bflo(y1[j].x) + bflo(y2[j].x), bfhi(h[j].x) * ALPHA + bfhi(y1[j].x) + bfhi(y2[j].x), bflo(h[j].y) * ALPHA + bflo(y1[j].y) + bflo(y2[j].y), bfhi(h[j].y) * ALPHA + bfhi(y1[j].y) + bfhi(y2[j].y)};
        v2[j] = (f32x4){bflo(hB[j].x) * ALPHA + bflo(y1B[j].x) + bflo(y2B[j].x), bfhi(hB[j].x) * ALPHA + bfhi(y1B[j].x) + bfhi(y2B[j].x), bflo(hB[j].y) * ALPHA + bflo(y1B[j].y) + bflo(y2B[j].y), bfhi(hB[j].y) * ALPHA + bfhi(y1B[j].y) + bfhi(y2B[j].y)}; }
    ln_compute(v, g, bb); ln_compute(v2, g, bb);
    f32x4* xr = (f32x4*)(out + (size_t)m * D_) + W.lane; f32x4* xr2 = (f32x4*)(out + (size_t)m2 * D_) + W.lane;
    if (do1) {
#pragma unroll
        for (int j = 0; j < 4; ++j) xr[64 * j] = v[j]; }
    if (do2) {
#pragma unroll
        for (int j = 0; j < 4; ++j) xr2[64 * j] = v2[j]; }
}
__device__ __forceinline__ void final_ln_phase(const WInfo& W, float* out, const bf16* Y2, const float* gam, const float* bet, const int* toke, int v, int V, bool late) {
    f32x4 g[4], bb[4];
#pragma unroll
    for (int j = 0; j < 4; ++j) { g[j] = *(const f32x4*)(gam + 4 * W.lane + 256 * j); bb[j] = *(const f32x4*)(bet + 4 * W.lane + 256 * j); }
    if (v < 0) return;
    const int nrow = (T_ - v + V - 1) / V;
    for (int i0 = 0; i0 < nrow; i0 += 64) {
        const int i = i0 + W.lane; const int fl = i < nrow ? toke[v + i * V] : (late ? 0 : (1 << 16));
        unsigned long long mask = __ballot(i < nrow && (((fl >> 16) & 1) != 0) == late);
        while (mask) { const int r0 = __builtin_ctzll(mask); mask &= mask - 1; const bool two = mask != 0; const int r1 = two ? __builtin_ctzll(mask) : r0; if (two) mask &= mask - 1;
            final_ln_pair(W, out, Y2, g, bb, v + (i0 + r0) * V, v + (i0 + r1) * V, true, two); }
    }
}
__device__ __forceinline__ void ln_router_phase(const WInfo& W, LAS unsigned char* lds, const bf16* Xin, const float* stp, bf16* H3rows, unsigned char* H3f8, const float* gam, const float* bet, const float* rw, int* toke, float* tokp, int* wgcnt) {
    constexpr int RWS = 1032;
    LAS bf16* RWT = (LAS bf16*)lds;
    LAS float* GBL = (LAS float*)(lds + 16640);
    LAS float* LG = (LAS float*)(lds + 24832);
    LAS int* CNT = (LAS int*)(lds + 28928);
    { float rv[16]; float gv[2], bv[2];
#pragma unroll
      for (int k = 0; k < 16; ++k) rv[k] = rw[W.tid + 512 * k];
#pragma unroll
      for (int k = 0; k < 2; ++k) { gv[k] = gam[W.tid + 512 * k]; bv[k] = bet[W.tid + 512 * k]; }
#pragma unroll
      for (int k = 0; k < 16; ++k) { const int idx = W.tid + 512 * k; RWT[(idx & 7) * RWS + (idx >> 3)] = (bf16)f2bf(rv[k]); }
#pragma unroll
      for (int k = 0; k < 2; ++k) { GBL[W.tid + 512 * k] = gv[k]; GBL[1024 + W.tid + 512 * k] = bv[k]; } }
    if (W.tid < 16) CNT[W.tid] = 0;
    __syncthreads();
    const int li = W.lane & 15, kq = W.lane >> 4;
    for (int wg = blockIdx.x; wg < 256; wg += W.G) {
        const int m = wg * 128 + W.wave * 16 + li;
        const bf16* xrow = Xin + (size_t)m * D_ + 16 * kq;
        float mu, rstd; pg8::row_stats(stp, m, mu, rstd);
        f32x4 lacc = (f32x4){0.f, 0.f, 0.f, 0.f};
        bf16* hrow = H3rows + (size_t)m * 2048 + 16 * kq; unsigned char* frow = H3f8 + (size_t)m * D_ + 16 * kq;
        const LAS bf16* rwl = RWT + (li & 7) * RWS + 16 * kq;
        v4u xc[4][2], xn[4][2];
#pragma unroll
        for (int t = 0; t < 4; ++t) { xc[t][0] = *(const v4u*)(xrow + 64 * t); xc[t][1] = *(const v4u*)(xrow + 64 * t + 8); }
#pragma unroll
        for (int sb = 0; sb < 4; ++sb) {
            if (sb < 3) {
#pragma unroll
                for (int t = 0; t < 4; ++t) { xn[t][0] = *(const v4u*)(xrow + 64 * (4 * sb + 4 + t)); xn[t][1] = *(const v4u*)(xrow + 64 * (4 * sb + 4 + t) + 8); } }
            asm volatile("" ::: "memory");
#pragma unroll
            for (int t4 = 0; t4 < 4; ++t4) { const int t = 4 * sb + t4, c0 = 64 * t + 16 * kq;
                float y[16];
#pragma unroll
                for (int h = 0; h < 2; ++h)
#pragma unroll
                    for (int d = 0; d < 4; ++d) { y[8 * h + 2 * d] = bflo(xc[t4][h][d]); y[8 * h + 2 * d + 1] = bfhi(xc[t4][h][d]); }
#pragma unroll
                for (int j4 = 0; j4 < 4; ++j4) { const f32x4 g = *(const LAS f32x4*)(GBL + c0 + 4 * j4), b = *(const LAS f32x4*)(GBL + 1024 + c0 + 4 * j4);
#pragma unroll
                    for (int e = 0; e < 4; ++e) y[4 * j4 + e] = (y[4 * j4 + e] - mu) * rstd * g[e] + b[e]; }
                v4u hb[2];
#pragma unroll
                for (int h = 0; h < 2; ++h) { hb[h].x = pk2(y[8 * h], y[8 * h + 1]); hb[h].y = pk2(y[8 * h + 2], y[8 * h + 3]); hb[h].z = pk2(y[8 * h + 4], y[8 * h + 5]); hb[h].w = pk2(y[8 * h + 6], y[8 * h + 7]); }
                *(v4u*)(hrow + 64 * t) = hb[0]; *(v4u*)(hrow + 64 * t + 8) = hb[1];
                v4u f8; f8.x = pg8::pk4_fp8(y[0], y[1], y[2], y[3]); f8.y = pg8::pk4_fp8(y[4], y[5], y[6], y[7]); f8.z = pg8::pk4_fp8(y[8], y[9], y[10], y[11]); f8.w = pg8::pk4_fp8(y[12], y[13], y[14], y[15]);
                *(v4u*)(frow + 64 * t) = f8;
#pragma unroll
                for (int h = 0; h < 2; ++h) { const bf16x8 bfr = *(const LAS bf16x8*)(rwl + 64 * t + 8 * h);
                    lacc = __builtin_amdgcn_mfma_f32_16x16x32_bf16(__builtin_bit_cast(bf16x8, hb[h]), bfr, lacc, 0, 0, 0); } }
#pragma unroll
            for (int t = 0; t < 4; ++t) { xc[t][0] = xn[t][0]; xc[t][1] = xn[t][1]; } }
        LAS float* lgw = LG + W.wave * 128;
        if (li < 8) {
#pragma unroll
            for (int j = 0; j < 4; ++j) lgw[(4 * kq + j) * 8 + li] = lacc[j]; }
        LDS_WAIT(); asm volatile("" ::: "memory");
        if (W.lane < 16) { const f32x4 l0 = *(const LAS f32x4*)(lgw + W.lane * 8), l1 = *(const LAS f32x4*)(lgw + W.lane * 8 + 4);
            const float lg[8] = {l0[0], l0[1], l0[2], l0[3], l1[0], l1[1], l1[2], l1[3]};
            int e1 = 0; float v1 = lg[0];
#pragma unroll
            for (int e = 1; e < 8; ++e) if (lg[e] > v1) { v1 = lg[e]; e1 = e; }
            int e2 = -1; float v2 = -3.0e38f;
#pragma unroll
            for (int e = 0; e < 8; ++e) if (e != e1 && lg[e] > v2) { v2 = lg[e]; e2 = e; }
            const float p2 = 1.0f / (1.0f + __expf(v1 - v2)), p1 = 1.0f - p2;
            const int mr = wg * 128 + W.wave * 16 + W.lane;
            toke[mr] = e1 | (e2 << 8); *(f32x2*)(tokp + 2 * mr) = (f32x2){p1, p2}; atomicAdd((int*)(CNT + e1), 1); atomicAdd((int*)(CNT + 8 + e2), 1); }
        __syncthreads();
        if (W.tid < 16) { wgcnt[wg * 16 + W.tid] = CNT[W.tid]; CNT[W.tid] = 0; }
        __syncthreads();
    }
}
__device__ __forceinline__ void route_phase(const WInfo& W, LAS unsigned char* lds, int* toke, const float* tokp, const int* wgcnt, int* perm, float* slotp, int* ptab) {
    LAS int* C = (LAS int*)lds;
    LAS int* TOT = (LAS int*)(lds + 16384);
    LAS int* PRE = TOT + 16;
    LAS int* OFF = TOT + 32;
    LAS int* CTR = TOT + 48;
    for (int wg = blockIdx.x; wg < 256; wg += W.G) {
        __syncthreads();
        { int cv[8];
#pragma unroll
          for (int k = 0; k < 8; ++k) cv[k] = wgcnt[W.tid + 512 * k];
#pragma unroll
          for (int k = 0; k < 8; ++k) C[W.tid + 512 * k] = cv[k]; }
        if (W.tid < 16) CTR[W.tid] = 0;
        __syncthreads();
        if (W.tid < 16) { int tot = 0, pre = 0; for (int k = 0; k < 256; ++k) { const int c = C[k * 16 + W.tid]; tot += c; if (k < wg) pre += c; } TOT[W.tid] = tot; PRE[W.tid] = pre; }
        __syncthreads();
        if (W.tid == 0) { int cnt = 0, npass[2];
            for (int p = 0; p < 2; ++p) { int base = 0, np = 0;
                for (int e = 0; e < 8; ++e) { OFF[p * 8 + e] = p * PERMLEN + base + PRE[p * 8 + e]; const int pn = (TOT[p * 8 + e] + 255) >> 8;
                    if (wg == 0) for (int k = 0; k < pn; ++k) ptab[2 + cnt + k] = ((p * MAXPANEL + np + k) << 8) | e;
                    cnt += pn; np += pn; base += pn * 256; }
                npass[p] = np; }
            CTR[16] = npass[0];
            if (wg == 0) { ptab[0] = npass[0]; ptab[1] = npass[1]; } }
        __syncthreads();
        if (W.tid < 128) { const int m = wg * 128 + W.tid, te = toke[m], e1 = te & 255, e2 = (te >> 8) & 255;
            const int s1 = OFF[e1] + atomicAdd((int*)(CTR + e1), 1); perm[s1] = m; slotp[s1] = tokp[2 * m];
            const int s2 = OFF[8 + e2] + atomicAdd((int*)(CTR + 8 + e2), 1); perm[s2] = m; slotp[s2] = tokp[2 * m + 1];
            if (CTR[16] + ((s2 - PERMLEN) >> 8) >= 256) ((int*)toke)[m] = te | (1 << 16); }
    }
}
__device__ __forceinline__ void conv_phase(const WInfo& W, const bf16* GB, const bf16* UP, bf16* CV, const float* cw) {
    const size_t gtid = (size_t)W.gw * 64 + W.lane, NT = (size_t)W.NGW * 64;
#pragma unroll 8
    for (size_t i = gtid; i < (size_t)T_ * D_ / 8; i += NT) {
        const int m = (int)(i >> 7), c = (int)(i & 127) * 8, t = m & (SEQ - 1);
        const v4u gv = *(const v4u*)(GB + (size_t)m * D_ + c), u2 = *(const v4u*)(UP + (size_t)m * D_ + c);
        v4u u1 = (v4u){0u, 0u, 0u, 0u}, u0 = (v4u){0u, 0u, 0u, 0u};
        if (t >= 1) u1 = *(const v4u*)(UP + (size_t)(m - 1) * D_ + c);
        if (t >= 2) u0 = *(const v4u*)(UP + (size_t)(m - 2) * D_ + c);
        float o[8];
#pragma unroll
        for (int e = 0; e < 4; ++e) {
            const f32x2 w0 = *(const f32x2*)(cw + c + 2 * e), w1 = *(const f32x2*)(cw + 1024 + c + 2 * e), w2 = *(const f32x2*)(cw + 2048 + c + 2 * e);
            o[2 * e] = bflo(gv[e]) * (bflo(u0[e]) * w0[0] + bflo(u1[e]) * w1[0] + bflo(u2[e]) * w2[0]);
            o[2 * e + 1] = bfhi(gv[e]) * (bfhi(u0[e]) * w0[1] + bfhi(u1[e]) * w1[1] + bfhi(u2[e]) * w2[1]); }
        v4u ov; ov.x = pk2(o[0], o[1]); ov.y = pk2(o[2], o[3]); ov.z = pk2(o[4], o[5]); ov.w = pk2(o[6], o[7]);
        *(v4u*)(CV + (size_t)m * D_ + c) = ov;
    }
}

constexpr int NPHASE = 19;
#ifndef PH_STOP
#define PH_STOP NPHASE
#endif
struct Args { const float* in[34]; float* out; unsigned char* ws; int ph_lo, ph_hi; };
__global__ void __launch_bounds__(512, 2) mk_fwd(Args args) {
    extern __shared__ __attribute__((aligned(16))) unsigned char lds_raw[];
    LAS unsigned char* lds = (LAS unsigned char*)lds_raw;
    WInfo W; W.tid = threadIdx.x; W.lane = W.tid & 63; W.wave = __builtin_amdgcn_readfirstlane(W.tid >> 6);
    W.G = gridDim.x; { const int bx = blockIdx.x; W.vcu = (W.G % 8 == 0) ? (bx % 8) * (W.G / 8) + bx / 8 : bx; }
    W.gw = W.vcu * 8 + W.wave; W.NGW = W.G * 8;
    unsigned char* ws = args.ws; float* out = args.out; const float* const* in = args.in;
    unsigned* ctl = (unsigned*)(ws + WS_CTL);
    volatile LAS unsigned* MISC = (volatile LAS unsigned*)(lds + MISC_OFF);
    for (int u = W.tid; u < 128; u += 512) ((LAS unsigned*)(lds + LDSCTL_OFF))[u] = 0u;
    __syncthreads();
    XcdBarrier bar; bar.bar = ctl + CW_BAR; bar.x = 0; bar.st = nullptr;
    if (MK_N_LAUNCHES == 1) bar = xcd_barrier_post(ctl + CW_BAR, MISC + 8);
    const int lo = args.ph_lo, hi = args.ph_hi;
#ifndef PH_MASK
#define PH_MASK 0x7ffff
#endif
#define IN(k) (((PH_MASK >> (k)) & 1) && lo <= (k) && (k) < hi)
#define SEAM(k) do { if (IN(k) && IN((k) + 1)) xcd_barrier(bar); } while (0)
    bf16* const B0 = (bf16*)(ws + WS_B0); bf16* const Zb = (bf16*)(ws + WS_B1); bf16* const ACT = (bf16*)(ws + WS_ACT); bf16* const CV = (bf16*)(ws + WS_CV);
    bf16* const AP = (bf16*)(ws + WS_AP); bf16* const YRAW = (bf16*)(ws + WS_YRAW); bf16* const ACTM = (bf16*)(ws + WS_ACTM);
    bf16* const WLOG = (bf16*)out; bf16* const MIX = (bf16*)out;     bf16* const ABUF = (bf16*)(out + (size_t)T_ * 512); bf16* const GBUF = ABUF + (size_t)T_ * 512;
    int* const toke = (int*)(ws + WS_TOKE); float* const tokp = (float*)(ws + WS_TOKP); int* const wgcnt = (int*)(ws + WS_WGCNT); int* const ptabg = (int*)(ws + WS_PTAB); int* const perm = (int*)(ws + WS_PERM);
    const int cblk = (int)blockIdx.x;

#ifdef DUMP_OFF
    if (lo == 100) { const bf16* s = (const bf16*)(ws + (size_t)(DUMP_OFF) * MiB);
        for (size_t i = (size_t)W.gw * 64 + W.lane; i < (size_t)T_ * D_; i += (size_t)W.NGW * 64) { const size_t m = i >> 10, c = i & 1023; out[i] = (c < DUMP_W) ? bf2f(s[m * DUMP_LD + DUMP_COL + c]) : 0.f; } return; }
#endif
    if (IN(0)) { p0_prologue(W, lds, in, ws); } SEAM(0);
    if (IN(1)) { const int K8 = 512 + (hi >> 20); pg8::DenseSched S{T_ / 256, NZ / 256, W.G, cblk, K8, (const bf16*)(ws + WS_WIN0)}; pg8::EpiBf16i8 E{Zb, NZ, (const float*)(ws + WS_XS), (const float*)(ws + WS_LNV) + 26112};
        pg8::gemm_phase<pg8::EpiBf16i8, pg8::DenseSched, 2>(lds, (const bf16*)(ws + WS_XQ), K8, S, E); } SEAM(1);
    if (IN(2)) { aprime_phase(W, Zb, AP, in[4]); } SEAM(2);
    if (IN(3)) { const int KL = 256 + (hi >> 20); pg8::DenseSched S{T_ / 256, 6, W.G, cblk, KL, (const bf16*)(ws + WS_WLORA)}; pg8::EpiLora E{WLOG, ABUF, GBUF, in[5], in[7]}; pg8::gemm_phase(lds, AP, KL, S, E); } SEAM(3);
    if (IN(4)) { scan_prep_phase(W, lds, Zb, WLOG, ABUF, ws + WS_SLOT, (float*)(ws + WS_BONUS), in[4], in[10], in[11], in[12]); } SEAM(4);
    if (IN(5)) { if (blockIdx.x < 64) scan_seq_phase(W, lds, Zb, ws + WS_SLOT, YRAW, in[4]); attn_phase(W, lds, Zb, MIX, in[3], in[1], ctl + 2048); deferred_work(W, lds, in, ws, ctl + 2112); } SEAM(5);
    if (IN(6)) { post_phase(W, Zb, GBUF, YRAW, (const float*)(ws + WS_BONUS), MIX, in[4], in[13], in[14]); moe_weights(W, lds, in, ws); } SEAM(6);
    float* const STP1 = (float*)(ws + WS_STP1); float* const STP2 = (float*)(ws + WS_STP2); const float* const SV = (const float*)(ws + WS_LNV); const float* const CVv = SV + 8704;
    LAS float* const PST = (LAS float*)(lds + PST_OFF); LAS float* const TBL = (LAS float*)(lds + STAT_OFF);
#define STAT_TABLE(S, stp) do { __syncthreads(); if (W.tid < 256) { f32x4 _a[11], _b[11]; int _n = 0; \
        _Pragma("unroll") for (int i = 0; i < 11; ++i) { pg8::Unit uu; if ((S).next(i, uu)) { _n = i + 1; const float* _p = (stp) + (size_t)(uu.pm * 256 + W.tid) * 8; _a[i] = *(const f32x4*)_p; _b[i] = *(const f32x4*)(_p + 4); } else { _a[i] = (f32x4){0.f, 0.f, 0.f, 0.f}; _b[i] = _a[i]; } } \
        _Pragma("unroll") for (int i = 0; i < 11; ++i) if (i < _n) { const float s = ((_a[i][0] + _a[i][2]) + _b[i][0]) + _b[i][2], q = ((_a[i][1] + _a[i][3]) + _b[i][1]) + _b[i][3]; const float mu = s * (1.0f / 1024.0f); \
            TBL[(i * 256 + W.tid) * 2] = mu; TBL[(i * 256 + W.tid) * 2 + 1] = rsqrtf(fmaxf(q * (1.0f / 1024.0f) - mu * mu, 0.f) + LN_EPS); } } __syncthreads(); } while (0)
    if (IN(7)) { pg8::DenseSched S{T_ / 256, 4, W.G, cblk, 1024, (const bf16*)(ws + WS_WOUT0)}; pg8::EpiRes16<false, true> E{B0, Zb, STP1, PST, TBL, nullptr, nullptr, ws + WS_A8}; pg8::gemm_phase(lds, MIX, 1024, S, E); } SEAM(7);
    if (IN(8)) { const int K8 = 512 + (hi >> 20); pg8::DenseSched S{T_ / 256, 22, W.G, cblk, K8, (const bf16*)(ws + WS_WFGU)}; STAT_TABLE(S, STP1); pg8::EpiSwigluLNi8 E{ACT, FF, TBL, SV + 17408, SV, CVv};
        pg8::gemm_phase<pg8::EpiSwigluLNi8, pg8::DenseSched, 2>(lds, (const bf16*)(ws + WS_A8), K8, S, E); } SEAM(8);
    if (IN(9)) { pg8::DenseSched S{T_ / 256, 4, W.G, cblk, FF, (const bf16*)(ws + WS_WFD)}; STAT_TABLE(S, STP1); pg8::EpiRes16<false, true> E{Zb, B0, STP2, PST, TBL, in[16], in[17], ws + WS_A8B}; pg8::gemm_phase(lds, ACT, FF, S, E); } SEAM(9);
    if (IN(10)) { const int K8 = 512 + (hi >> 20); pg8::DenseSched S{T_ / 256, 12, W.G, cblk, K8, (const bf16*)(ws + WS_WIN1)}; STAT_TABLE(S, STP2); pg8::EpiL1inLNi8 E{Zb, ACT, TBL, SV + 17408 + 5632, SV + 5632, CVv + 5632};
        pg8::gemm_phase<pg8::EpiL1inLNi8, pg8::DenseSched, 2>(lds, (const bf16*)(ws + WS_A8B), K8, S, E); } SEAM(10);
    if (IN(11)) { conv_phase(W, Zb, ACT, CV, in[24]); } SEAM(11);
    if (IN(12)) { pg8::DenseSched S{T_ / 256, 4, W.G, cblk, 1024, (const bf16*)(ws + WS_WOUT1)}; STAT_TABLE(S, STP2); pg8::EpiRes16<false> E{B0, Zb, STP1, PST, TBL, in[21], in[22]}; pg8::gemm_phase(lds, CV, 1024, S, E); } SEAM(12);
    if (IN(13)) { ln_router_phase(W, lds, Zb, STP1, (bf16*)out, (unsigned char*)B0, in[26], in[27], in[28], toke, tokp, wgcnt); } SEAM(13);
    if (IN(14)) { route_phase(W, lds, toke, tokp, wgcnt, perm, (float*)(ws + WS_SLOTP), ptabg); } SEAM(14);
#define MOE_TABLES() do { LAS int* ptl = (LAS int*)(lds + PTAB_OFF); __syncthreads(); if (W.tid < 280) ptl[W.tid] = ptabg[W.tid]; __syncthreads(); } while (0)
    if (IN(15)) { MOE_TABLES(); LAS int* ptl = (LAS int*)(lds + PTAB_OFF); LAS unsigned short* rtl = (LAS unsigned short*)(lds + RTAB_OFF);
        pg8::MoeUpSched S{ptl[0] + ptl[1], W.G, cblk, ws + WS_WMGU, ptl, rtl};
        if (W.tid < 256) { int rv[32];
#pragma unroll
            for (int i = 0; i < 32; ++i) { pg8::Unit uu; rv[i] = S.next(i, uu) ? perm[uu.pm * 256 + W.tid] : 0; }
#pragma unroll
            for (int i = 0; i < 32; ++i) rtl[i * 256 + W.tid] = (unsigned short)(rv[i] < 0 ? 0 : rv[i]); }
        __syncthreads(); pg8::EpiSwiglu8 E{(unsigned char*)ACTM, FFE}; pg8::gemm_phase<pg8::EpiSwiglu8, pg8::MoeUpSched, true>(lds, B0, 512 + (hi >> 20), S, E); } SEAM(15);
    if (IN(16)) { MOE_TABLES(); LAS int* ptl = (LAS int*)(lds + PTAB_OFF);
        pg8::MoeDownSched S{ptl[0] + ptl[1], 0, W.G, cblk, ws + WS_WMD, ptl}; pg8::EpiMoeDown E{out, (bf16*)(ws + WS_Y2), perm, (const float*)(ws + WS_SLOTP)}; pg8::gemm_phase<pg8::EpiMoeDown, pg8::MoeDownSched, true>(lds, ACTM, FFE / 2 + (hi >> 20), S, E); } SEAM(16);
    if (IN(17)) { MOE_TABLES(); LAS int* ptl = (LAS int*)(lds + PTAB_OFF); const int nP = ptl[0] + ptl[1], nlate = nP > 256 ? (nP - 256) * 4 : 0;
        if (cblk < nlate) { pg8::MoeDownSched S{nP, 1, W.G, cblk, ws + WS_WMD, ptl}; pg8::EpiMoeDown E{out, (bf16*)(ws + WS_Y2), perm, (const float*)(ws + WS_SLOTP)}; pg8::gemm_phase<pg8::EpiMoeDown, pg8::MoeDownSched, true>(lds, ACTM, FFE / 2 + (hi >> 20), S, E); }
        else final_ln_phase(W, out, (const bf16*)(ws + WS_Y2), in[32], in[33], toke, (cblk - nlate) * 8 + W.wave, (W.G - nlate) * 8, false); } SEAM(17);
    if (IN(18)) { final_ln_phase(W, out, (const bf16*)(ws + WS_Y2), in[32], in[33], toke, W.gw, W.NGW, true); }
#undef IN
#undef SEAM
}

extern "C" void kernel_launch(void* const* d_in, const int* in_sizes, int n_in, void* d_out, int out_size, void* d_ws, size_t ws_size, hipStream_t stream) {
    static int grid = 0;
    if (grid == 0) {
        if (n_in != 34 || out_size != T_ * D_ || ws_size < WS_END) { fprintf(stderr, "kernel_launch: unexpected problem (n_in %d, out %d, ws %zu)\n", n_in, out_size, ws_size); grid = -1; return; }
        int dev = 0, cus = 0, per_cu = 0;
        if (hipGetDevice(&dev) != hipSuccess || hipDeviceGetAttribute(&cus, hipDeviceAttributeMultiprocessorCount, dev) != hipSuccess) { grid = -1; return; }
        if (hipFuncSetAttribute((const void*)mk_fwd, hipFuncAttributeMaxDynamicSharedMemorySize, LDS_BYTES) != hipSuccess) { fprintf(stderr, "kernel_launch: hipFuncSetAttribute failed\n"); grid = -1; return; }
        if (hipOccupancyMaxActiveBlocksPerMultiprocessor(&per_cu, (const void*)mk_fwd, 512, LDS_BYTES) != hipSuccess || per_cu < 1) fprintf(stderr, "kernel_launch: occupancy query reports %d\n", per_cu);
        (void)hipGetLastError();
        grid = cus;
        if (grid != 256) { fprintf(stderr, "kernel_launch: built for 256 CUs, got %d\n", grid); grid = -1; return; }
    }
    if (grid < 0) return;
    (void)hipMemsetAsync((char*)d_ws + WS_CTL, 0, CTL_ZERO_BYTES, stream);
    Args a{};
    for (int i = 0; i < 34; ++i) a.in[i] = (const float*)d_in[i];
    a.out = (float*)d_out; a.ws = (unsigned char*)d_ws;
    if (MK_N_LAUNCHES == 1) { a.ph_lo = 0; a.ph_hi = NPHASE; hipLaunchKernelGGL(mk_fwd, dim3(grid), dim3(512), LDS_BYTES, stream, a); }
    else { for (int p = 0; p < PH_STOP; ++p) { a.ph_lo = p; a.ph_hi = p + 1; hipLaunchKernelGGL(mk_fwd, dim3(grid), dim3(512), LDS_BYTES, stream, a);
#ifdef DUP_PHASE
            if (p == DUP_PHASE) for (int r = 0; r < DUP_N; ++r) hipLaunchKernelGGL(mk_fwd, dim3(grid), dim3(512), LDS_BYTES, stream, a);
#endif
        }
#ifdef DUMP_OFF
        a.ph_lo = 100; a.ph_hi = 101; hipLaunchKernelGGL(mk_fwd, dim3(grid), dim3(512), LDS_BYTES, stream, a);
#endif
    }
}
```

```cpp
#include <hip/hip_runtime.h>
#include <stdio.h>

#ifndef MK_N_LAUNCHES
#define MK_N_LAUNCHES 1
#endif

#define GAS __attribute__((address_space(1)))
#define LAS __attribute__((address_space(3)))
typedef unsigned short bf16;
typedef unsigned v4u __attribute__((ext_vector_type(4)));
typedef unsigned v2u __attribute__((ext_vector_type(2)));
typedef float f32x2 __attribute__((ext_vector_type(2)));
typedef float f32x4 __attribute__((ext_vector_type(4)));
typedef float f32x16 __attribute__((ext_vector_type(16)));
typedef short bf16x8 __attribute__((ext_vector_type(8)));
typedef short s16x4 __attribute__((ext_vector_type(4)));
#define LDS_WAIT() asm volatile("s_waitcnt lgkmcnt(0)" ::: "memory")
#define VM_WAIT() asm volatile("s_waitcnt vmcnt(0)" ::: "memory")

constexpr int T_ = 32768, D_ = 1024, SEQ = 4096, NZ = 2560, FF = 2816, FFE = 3584, NEXP = 8;
constexpr int MAXPANEL = 136, PERMLEN = MAXPANEL * 256;
constexpr float ALPHA = 1.41421356237309515f, LN_EPS = 1e-5f, GN_EPS = 64e-5f, LOG2E = 1.44269504088896341f;

constexpr size_t MiB = 1u << 20;
constexpr size_t WS_CTL = 0, CTL_ZERO_BYTES = 1 * MiB;
constexpr size_t WS_TOKE = 1 * MiB, WS_TOKP = 1 * MiB + 128 * 1024, WS_WGCNT = 1 * MiB + 384 * 1024, WS_PTAB = WS_WGCNT + 16 * 1024, WS_PERM = 1 * MiB + 512 * 1024;
constexpr size_t WS_WIN0 = 2 * MiB, WS_WLORA = 7 * MiB, WS_WOUT0 = 8 * MiB, WS_WFGU = 10 * MiB, WS_WFD = 21 * MiB, WS_WIN1 = 27 * MiB, WS_WOUT1 = 33 * MiB, WS_WMGU = 35 * MiB, WS_WMD = 91 * MiB;
constexpr size_t WS_A8B = 151 * MiB;
constexpr size_t WS_A8 = 119 * MiB;
constexpr size_t WS_Y2 = 119 * MiB;
constexpr size_t WS_STP1 = 197 * MiB, WS_STP2 = 198 * MiB, WS_LNV = 196 * MiB;
constexpr size_t WS_SLOTP = 199 * MiB;
constexpr size_t WS_B0 = 204 * MiB;
constexpr size_t WS_B1 = 268 * MiB;
constexpr size_t WS_ACT = 332 * MiB;
constexpr size_t WS_CV = 396 * MiB;
constexpr size_t WS_AP = 428 * MiB;
constexpr size_t WS_YRAW = 444 * MiB;
constexpr size_t WS_XQ = 444 * MiB;
constexpr size_t WS_XS = 196 * MiB + 512 * 1024;
constexpr size_t WS_ACTM = 268 * MiB;
constexpr size_t WS_BONUS = 508 * MiB;
constexpr size_t WS_SLOT = 35 * MiB;
constexpr size_t WS_END = 510 * MiB;
static_assert(WS_ACTM + (size_t)2 * PERMLEN * FFE <= WS_END, "ACTM");
static_assert(WS_ACT + (size_t)T_ * FF * 2 <= WS_END, "ACT");
constexpr int CW_TMO = 0, CW_CODE = 1, CW_BAR = 4096;

constexpr int RING_BYTES = 131072, LDSCTL_OFF = 163328, MISC_OFF = LDSCTL_OFF, PTAB_OFF = RING_BYTES, RTAB_OFF = RING_BYTES + 2048;
constexpr int LDS_BYTES = 163840, STAT_OFF = RTAB_OFF, PST_OFF = RTAB_OFF + 8192;

namespace pg8 {
#define PG8_LAS __attribute__((address_space(3)))
typedef unsigned short bf16_t;
constexpr int BM = 256, BK = 64, HALF = 128, HTB = HALF * BK * 2, STAGE_BYTES = 8 * HTB, NXCD = 8, WGM = 8;
__host__ __device__ __forceinline__ int lds_byte(int r, int c) { const int st = (r >> 4) * 2 + (c >> 5), rr = r & 15, cc = c & 31, ob = rr * 64 + cc * 2; return st * 1024 + (ob ^ (((ob >> 9) & 1) << 5)); }
__host__ __device__ __forceinline__ void stage_rc(int b, int& R, int& C) { const int st = b / 1024, sb = b % 1024, swz = sb ^ (((sb >> 9) & 1) << 5); R = (st >> 1) * 16 + swz / 64; C = (st & 1) * 32 + (swz % 64) / 2; }
__host__ __device__ __forceinline__ int perm32(int rho) { const int n = rho >> 4, i = rho & 15; return 8 * (i >> 2) + 4 * n + (i & 3); }
struct Unit { int pm, pn, e, ui; };
__device__ __forceinline__ bool tile_order(int i, int G, int c, int nM, int nN, int& pm, int& pn) {
    const int nwg = nM * nN; const long L = (long)i * G + c; if (L >= nwg) return false;
    int wgid = (int)L; { const int q = nwg / NXCD, r = nwg % NXCD, xcd = wgid % NXCD, off = wgid / NXCD; wgid = (xcd < r ? xcd * (q + 1) : r * (q + 1) + (xcd - r) * q) + off; }
    const int nig = WGM * nN, gid = wgid / nig, fm = gid * WGM, gsz = (nM - fm) < WGM ? (nM - fm) : WGM;
    pm = fm + ((wgid % nig) % gsz); pn = (wgid % nig) / gsz; return true;
}
typedef __bf16 bf16x2_t __attribute__((ext_vector_type(2)));
__device__ __forceinline__ unsigned cvt_pk_bf16(float lo, float hi) { const f32x2 v = {lo, hi}; const bf16x2_t b = __builtin_convertvector(v, bf16x2_t); return __builtin_bit_cast(unsigned, b); }

typedef int i32x8 __attribute__((ext_vector_type(8)));
typedef int v4i __attribute__((ext_vector_type(4)));
__device__ __forceinline__ i32x8 cat8(bf16x8 lo, bf16x8 hi) { const v4u a = __builtin_bit_cast(v4u, lo), b = __builtin_bit_cast(v4u, hi); return (i32x8){(int)a.x, (int)a.y, (int)a.z, (int)a.w, (int)b.x, (int)b.y, (int)b.z, (int)b.w}; }
template <class Epi, class Sched, int F8 = 0>
__device__ __forceinline__ void gemm_phase(PG8_LAS unsigned char* lds, const bf16_t* Abase, const int K, const Sched& S, const Epi& E) {
    const int tid = threadIdx.x, wid = __builtin_amdgcn_readfirstlane(tid >> 6), lane = tid & 63, wr = wid >> 2, wc = wid & 3, fr = lane & 15, fq = lane >> 4;
    const int nt = K / BK;
    int Rr[2], Cc[2]; unsigned voffB[2];
#pragma unroll
    for (int i = 0; i < 2; ++i) { stage_rc(tid * 16 + i * 8192, Rr[i], Cc[i]); const int Rb = Epi::PERM ? ((Rr[i] & ~31) + perm32(Rr[i] & 31)) : Rr[i]; voffB[i] = (unsigned)(Rb * K + Cc[i]) * 2u; }
    const size_t kstep = (size_t)(BK * 2);
    const size_t hstep = (size_t)HALF * K * 2;
    const unsigned ldsw = (unsigned)wid * 1024u;
    const int aoff = lds_byte(wr * 64 + fr, fq * 8), boff = lds_byte(wc * 32 + fr, fq * 8);
#define PG8_SA(b, h) (((b) * 2 + (h)) * HTB)
#define PG8_SB(b, h) ((4 + (b) * 2 + (h)) * HTB)
#define PG8_STAGE(bufoff, gbase, voff) do { _Pragma("unroll") for (int _i = 0; _i < 2; ++_i) \
        __builtin_amdgcn_global_load_lds((const unsigned*)((const char*)(gbase) + (voff)[_i]), (PG8_LAS unsigned*)(lds + (bufoff) + ldsw + _i * 8192), 16, 0, 0); } while (0)
#define PG8_LDA(dst, b, h) do { _Pragma("unroll") for (int m = 0; m < 4; ++m) _Pragma("unroll") for (int k = 0; k < 2; ++k) { if constexpr (F8 == 1) { const v4u _q = *(const PG8_LAS v4u*)(lds + PG8_SA(b, h) + aoff + m * 2048 + k * 1024); \
        dst##8[m][4 * k] = (int)_q.x; dst##8[m][4 * k + 1] = (int)_q.y; dst##8[m][4 * k + 2] = (int)_q.z; dst##8[m][4 * k + 3] = (int)_q.w; } else dst[m][k] = *(const PG8_LAS bf16x8*)(lds + PG8_SA(b, h) + aoff + m * 2048 + k * 1024); } } while (0)
#define PG8_LDB(dst, b, h) do { _Pragma("unroll") for (int n = 0; n < 2; ++n) _Pragma("unroll") for (int k = 0; k < 2; ++k) { if constexpr (F8 == 1) { const v4u _q = *(const PG8_LAS v4u*)(lds + PG8_SB(b, h) + boff + n * 2048 + k * 1024); \
        dst##8[n][4 * k] = (int)_q.x; dst##8[n][4 * k + 1] = (int)_q.y; dst##8[n][4 * k + 2] = (int)_q.z; dst##8[n][4 * k + 3] = (int)_q.w; } else dst[n][k] = *(const PG8_LAS bf16x8*)(lds + PG8_SB(b, h) + boff + n * 2048 + k * 1024); } } while (0)
#define PG8_MMA(ai, bj, At, Bt) do { __builtin_amdgcn_s_setprio(1); if constexpr (F8 == 1) { _Pragma("unroll") for (int m = 0; m < 4; ++m) _Pragma("unroll") for (int n = 0; n < 2; ++n) \
        asm volatile("v_mfma_scale_f32_16x16x128_f8f6f4 %0, %1, %2, %0, %3, %4 op_sel_hi:[0,0,0]" : "+v"(acc[ai][bj][m][n]) : "v"(Bt##8[n]), "v"(At##8[m]), "v"(scl_w), "v"(scl_a)); } else if constexpr (F8 == 2) { \
        _Pragma("unroll") for (int m = 0; m < 4; ++m) _Pragma("unroll") for (int n = 0; n < 2; ++n) _Pragma("unroll") for (int k = 0; k < 2; ++k) \
        acc[ai][bj][m][n] = __builtin_bit_cast(f32x4, __builtin_amdgcn_mfma_i32_16x16x64_i8(__builtin_bit_cast(v4i, Bt[n][k]), __builtin_bit_cast(v4i, At[m][k]), __builtin_bit_cast(v4i, acc[ai][bj][m][n]), 0, 0, 0)); } else { \
        _Pragma("unroll") for (int m = 0; m < 4; ++m) _Pragma("unroll") for (int n = 0; n < 2; ++n) _Pragma("unroll") for (int k = 0; k < 2; ++k) \
        acc[ai][bj][m][n] = __builtin_amdgcn_mfma_f32_16x16x32_bf16(Bt[n][k], At[m][k], acc[ai][bj][m][n], 0, 0, 0); } __builtin_amdgcn_s_setprio(0); } while (0)
#define PG8_WAIT_V(n) asm volatile("s_waitcnt vmcnt(" #n ")" ::: "memory")
#define PG8_WAIT_L(n) asm volatile("s_waitcnt lgkmcnt(" #n ")" ::: "memory")
#define PG8_BAR __builtin_amdgcn_s_barrier()
#define PG8_SCHED __builtin_amdgcn_sched_barrier(0)
#define PG8_AOFF(dst, u) do { _Pragma("unroll") for (int _h = 0; _h < 2; ++_h) _Pragma("unroll") for (int _i = 0; _i < 2; ++_i) dst[_h][_i] = S.a_off(u, _h * HALF + Rr[_i]) + (unsigned)Cc[_i] * 2u; } while (0)
    Unit cur, nxt; int ui = 0;
    if (!S.next(0, cur)) return;
    f32x4 acc[2][2][4][2];
#pragma unroll
    for (int a = 0; a < 2; ++a)
#pragma unroll
        for (int b = 0; b < 2; ++b)
#pragma unroll
            for (int m = 0; m < 4; ++m)
#pragma unroll
                for (int n = 0; n < 2; ++n) acc[a][b][m][n] = (f32x4){0.f, 0.f, 0.f, 0.f};
    bf16x8 At[4][2], B0[2][2], B1[2][2]; i32x8 At8[4], B08[2], B18[2];
    int scl_w = 0x7f7f7f7f, scl_a = 0x7f7f7f7f; if constexpr (F8 == 1) { scl_w = (int)Epi::SCALE_W; asm volatile("" : "+v"(scl_w), "+v"(scl_a)); }
    unsigned curA[2][2], nxtA[2][2];
    PG8_AOFF(curA, cur);
    const char* const A0 = (const char*)Abase;
    const char* cB = S.b_ptr(cur);
    PG8_STAGE(PG8_SB(0, 0), cB, voffB); PG8_STAGE(PG8_SB(0, 1), cB + hstep, voffB); PG8_STAGE(PG8_SA(0, 0), A0, curA[0]); PG8_STAGE(PG8_SA(0, 1), A0, curA[1]);
    if (wr == 1) PG8_BAR;
    PG8_WAIT_V(2); PG8_BAR;
    PG8_STAGE(PG8_SB(1, 0), cB + kstep, voffB); PG8_STAGE(PG8_SA(1, 0), A0 + kstep, curA[0]); PG8_STAGE(PG8_SB(1, 1), cB + hstep + kstep, voffB);
    PG8_WAIT_V(6); PG8_BAR;
    for (;;) {
        const bool has_next = S.next(ui + 1, nxt);
        const char* nB = has_next ? S.b_ptr(nxt) : cB;
        if (has_next) { PG8_AOFF(nxtA, nxt); } else {
#pragma unroll
            for (int h = 0; h < 2; ++h)
#pragma unroll
                for (int i = 0; i < 2; ++i) nxtA[h][i] = curA[h][i]; }
        for (int t = 0; t < nt; t += 2) {
            const bool last = (t == nt - 2);
            const char* a1 = A0 + (size_t)(t + 1) * kstep;
            const char* a2 = last ? A0 : A0 + (size_t)(t + 2) * kstep; const char* b2 = last ? nB : cB + (size_t)(t + 2) * kstep;
            const char* a3 = a2 + kstep; const char* b3 = b2 + kstep;
            unsigned o2[2][2];
#pragma unroll
            for (int h = 0; h < 2; ++h)
#pragma unroll
                for (int i = 0; i < 2; ++i) o2[h][i] = last ? nxtA[h][i] : curA[h][i];
            PG8_LDB(B0, 0, 0); PG8_LDB(B1, 0, 1); PG8_SCHED; PG8_LDA(At, 0, 0); PG8_STAGE(PG8_SA(1, 1), a1, curA[1]);
            asm volatile("s_cmp_lg_u32 %0, 0\n\ts_cbranch_scc1 .Lrx%=\n\ts_cmp_eq_u32 %1, 0\n\ts_cbranch_scc1 .Lrx%=\n\ts_waitcnt vmcnt(%2)\n\ts_branch .Lry%=\n.Lrx%=:\n\ts_waitcnt vmcnt(8)\n.Lry%=:" :: "s"(t), "s"(ui), "n"(8 + Epi::NST) : "memory", "scc"); PG8_WAIT_L(0); PG8_BAR; PG8_MMA(0, 0, At, B0); PG8_MMA(0, 1, At, B1); PG8_BAR; PG8_SCHED;
            PG8_LDA(At, 0, 1); PG8_STAGE(PG8_SB(0, 0), b2, voffB); PG8_STAGE(PG8_SB(0, 1), b2 + hstep, voffB); PG8_STAGE(PG8_SA(0, 0), a2, o2[0]);
            asm volatile("s_cmp_lg_u32 %0, 0\n\ts_cbranch_scc1 .Lrx%=\n\ts_cmp_eq_u32 %1, 0\n\ts_cbranch_scc1 .Lrx%=\n\ts_waitcnt vmcnt(%2)\n\ts_branch .Lry%=\n.Lrx%=:\n\ts_waitcnt vmcnt(8)\n.Lry%=:" :: "s"(t), "s"(ui), "n"(8 + Epi::NST) : "memory", "scc"); PG8_WAIT_L(0); PG8_BAR; PG8_MMA(1, 0, At, B0); PG8_MMA(1, 1, At, B1); PG8_BAR; PG8_SCHED;
            PG8_LDB(B0, 1, 0); PG8_LDB(B1, 1, 1); PG8_SCHED; PG8_LDA(At, 1, 0); PG8_STAGE(PG8_SA(0, 1), a2, o2[1]);
            PG8_WAIT_V(8); PG8_WAIT_L(0); PG8_BAR; PG8_MMA(0, 0, At, B0); PG8_MMA(0, 1, At, B1); PG8_BAR; PG8_SCHED;
            PG8_LDA(At, 1, 1); PG8_STAGE(PG8_SB(1, 0), b3, voffB); PG8_STAGE(PG8_SB(1, 1), b3 + hstep, voffB); PG8_STAGE(PG8_SA(1, 0), a3, o2[0]);
            PG8_WAIT_V(8); PG8_WAIT_L(0); PG8_BAR; PG8_MMA(1, 0, At, B0); PG8_MMA(1, 1, At, B1); PG8_BAR; PG8_SCHED;
        }
        if (wr == 0) PG8_BAR;
        if constexpr (F8 == 1) asm volatile("s_nop 15\n\ts_nop 7" ::: "memory");
        E(acc, cur, wr, wc, fr, fq);
        if (!has_next) break;
#pragma unroll
        for (int a = 0; a < 2; ++a)
#pragma unroll
            for (int b = 0; b < 2; ++b)
#pragma unroll
                for (int m = 0; m < 4; ++m)
#pragma unroll
                    for (int n = 0; n < 2; ++n) acc[a][b][m][n] = (f32x4){0.f, 0.f, 0.f, 0.f};
        cur = nxt; cB = nB; ++ui;
#pragma unroll
        for (int h = 0; h < 2; ++h)
#pragma unroll
            for (int i = 0; i < 2; ++i) curA[h][i] = nxtA[h][i];
        if (wr == 1) PG8_BAR;
    }
    PG8_WAIT_V(0);
    PG8_BAR;
#undef PG8_SA
#undef PG8_SB
#undef PG8_STAGE
#undef PG8_LDA
#undef PG8_LDB
#undef PG8_MMA
#undef PG8_WAIT_V
#undef PG8_WAIT_L
#undef PG8_BAR
#undef PG8_SCHED
#undef PG8_AOFF
}

struct DenseSched {
    int nM, nN, G, c, K; const bf16_t* Bt;
    __device__ __forceinline__ bool next(int i, Unit& u) const { u.e = 0; u.ui = i; return tile_order(i, G, c, nM, nN, u.pm, u.pn); }
    __device__ __forceinline__ unsigned a_off(const Unit& u, int rr) const { return (unsigned)((u.pm * BM + rr) * K) * 2u; }
    __device__ __forceinline__ const char* b_ptr(const Unit& u) const { return (const char*)Bt + (size_t)u.pn * BM * K * 2; }
};
struct MoeUpSched {
    int nP, G, c; const unsigned char* Bt; const PG8_LAS int* ptab; const PG8_LAS unsigned short* rtab;
    __device__ __forceinline__ bool next(int i, Unit& u) const { u.ui = i; int pi; if (!tile_order(i, G, c, nP, 28, pi, u.pn)) return false; const int en = ptab[2 + pi]; u.pm = en >> 8; u.e = en & 255; return true; }
    __device__ __forceinline__ unsigned a_off(const Unit& u, int rr) const { return (unsigned)rtab[u.ui * 256 + rr] * 1024u; }
    __device__ __forceinline__ const char* b_ptr(const Unit& u) const { return (const char*)Bt + ((size_t)u.e * 7168 + (size_t)u.pn * BM) * 1024; }
};
struct MoeDownSched {
    int nP, part, G, c; const unsigned char* Bt; const PG8_LAS int* ptab;
    __device__ __forceinline__ bool next(int i, Unit& u) const { u.ui = i; int pi;
        if (part == 0) { if (!tile_order(i, G, c, nP < 256 ? nP : 256, 4, pi, u.pn)) return false; }
        else { const long L = (long)i * G + c; if (L >= (long)(nP - 256) * 4) return false; pi = 256 + (int)(L >> 2); u.pn = (int)(L & 3); }
        const int en = ptab[2 + pi]; u.pm = en >> 8; u.e = en & 255; return true; }
    __device__ __forceinline__ unsigned a_off(const Unit& u, int rr) const { return (unsigned)(u.pm * BM + rr) * (unsigned)FFE; }
    __device__ __forceinline__ const char* b_ptr(const Unit& u) const { return (const char*)Bt + ((size_t)u.e * 1024 + (size_t)u.pn * BM) * FFE; }
};

struct EpiBf16 {
    static constexpr bool PERM = true; static constexpr int NST = 16;
    bf16_t* O; int ldc;
    __device__ __forceinline__ void operator()(const f32x4 (&acc)[2][2][4][2], const Unit& u, int wr, int wc, int fr, int fq) const {
        const int row0 = u.pm * BM + wr * 64 + fr, col0 = u.pn * BM + wc * 32 + 8 * fq;
#pragma unroll
        for (int ai = 0; ai < 2; ++ai)
#pragma unroll
            for (int m = 0; m < 4; ++m) { bf16_t* rowp = O + (size_t)(row0 + ai * HALF + m * 16) * ldc + col0;
#pragma unroll
                for (int bj = 0; bj < 2; ++bj) { const f32x4 v0 = acc[ai][bj][m][0], v1 = acc[ai][bj][m][1];
                    v4u w; w.x = cvt_pk_bf16(v0[0], v0[1]); w.y = cvt_pk_bf16(v0[2], v0[3]); w.z = cvt_pk_bf16(v1[0], v1[1]); w.w = cvt_pk_bf16(v1[2], v1[3]);
                    *(v4u*)(rowp + bj * HALF) = w; } }
    }
};
struct EpiBf16i8 {
    static constexpr bool PERM = true; static constexpr int NST = 16;
    bf16_t* O; int ldc; const float* xs; const float* sn;
    __device__ __forceinline__ void operator()(const f32x4 (&acc)[2][2][4][2], const Unit& u, int wr, int wc, int fr, int fq) const {
        const int row0 = u.pm * BM + wr * 64 + fr, col0 = u.pn * BM + wc * 32 + 8 * fq;
        float rs[8]; f32x4 cs[2][2];
#pragma unroll
        for (int r = 0; r < 8; ++r) rs[r] = xs[row0 + (r >> 2) * HALF + (r & 3) * 16];
#pragma unroll
        for (int bj = 0; bj < 2; ++bj)
#pragma unroll
            for (int n = 0; n < 2; ++n) cs[bj][n] = *(const f32x4*)(sn + col0 + bj * HALF + 4 * n);
#pragma unroll
        for (int ai = 0; ai < 2; ++ai)
#pragma unroll
            for (int m = 0; m < 4; ++m) { bf16_t* rowp = O + (size_t)(row0 + ai * HALF + m * 16) * ldc + col0; const float r = rs[ai * 4 + m];
#pragma unroll
                for (int bj = 0; bj < 2; ++bj) { const f32x4 v0 = __builtin_convertvector(__builtin_bit_cast(v4i, acc[ai][bj][m][0]), f32x4) * (cs[bj][0] * r), v1 = __builtin_convertvector(__builtin_bit_cast(v4i, acc[ai][bj][m][1]), f32x4) * (cs[bj][1] * r);
                    v4u w; w.x = cvt_pk_bf16(v0[0], v0[1]); w.y = cvt_pk_bf16(v0[2], v0[3]); w.z = cvt_pk_bf16(v1[0], v1[1]); w.w = cvt_pk_bf16(v1[2], v1[3]);
                    *(v4u*)(rowp + bj * HALF) = w; } }
    }
};
__device__ __forceinline__ float silu_f(float g) { return g * __builtin_amdgcn_rcpf(1.0f + __expf(-g)); }
constexpr float SW_TG = -1.44269504088896341f, SW_TU = -0.69314718055994531f;
__device__ __forceinline__ f32x4 swiglu4(f32x4 t, f32x4 up) {
    f32x4 e, r;
#pragma unroll
    for (int j = 0; j < 4; ++j) e[j] = __builtin_amdgcn_exp2f(t[j]);
    const f32x4 d = e + 1.0f;
#pragma unroll
    for (int j = 0; j < 4; ++j) r[j] = __builtin_amdgcn_rcpf(d[j]);
    return (t * r) * up;
}
__device__ __forceinline__ unsigned pk4_fp8(float a, float b, float c, float d) { int p = 0; p = __builtin_amdgcn_cvt_pk_fp8_f32(a, b, p, false); p = __builtin_amdgcn_cvt_pk_fp8_f32(c, d, p, true); return (unsigned)p; }
__device__ __forceinline__ float sat8(float x) { return __builtin_amdgcn_fmed3f(x, -448.0f, 448.0f); }
constexpr float Q8_CLIP = 6.5f, Q8_SA = Q8_CLIP / 127.0f, Q8_INV = 127.0f / Q8_CLIP;
__device__ __forceinline__ unsigned pack4_lo8(unsigned a, unsigned b, unsigned c, unsigned d) { return __builtin_amdgcn_perm(__builtin_amdgcn_perm(d, c, 0x0c0c0400u), __builtin_amdgcn_perm(b, a, 0x0c0c0400u), 0x05040100u); }
__device__ __forceinline__ unsigned q8_1(float v) { const float M = 12582912.0f; return __builtin_bit_cast(unsigned, __builtin_amdgcn_fmed3f(__builtin_fmaf(v, Q8_INV, M), M - 127.0f, M + 127.0f)); }
__device__ __forceinline__ unsigned q8x4(float a, float b, float c, float d) { return pack4_lo8(q8_1(a), q8_1(b), q8_1(c), q8_1(d)); }
struct EpiSwiglu8 {
    static constexpr bool PERM = true; static constexpr int NST = 8; static constexpr unsigned SCALE_W = 0x7a7a7a7au;
    unsigned char* O; int ldc;
    __device__ __forceinline__ void operator()(const f32x4 (&acc)[2][2][4][2], const Unit& u, int wr, int wc, int fr, int fq) const {
        const int row0 = u.pm * BM + wr * 64 + fr, col0 = u.pn * HALF + wc * 32 + 8 * fq;
#pragma unroll
        for (int ai = 0; ai < 2; ++ai)
#pragma unroll
            for (int m = 0; m < 4; ++m) { unsigned char* rowp = O + (size_t)(row0 + ai * HALF + m * 16) * ldc + col0;
                const f32x4 g0 = acc[ai][0][m][0], g1 = acc[ai][0][m][1], u0 = acc[ai][1][m][0], u1 = acc[ai][1][m][1];
                const f32x4 y0 = swiglu4(g0, u0), y1 = swiglu4(g1, u1);
                v2u w; w.x = pk4_fp8(sat8(y0[0]), sat8(y0[1]), sat8(y0[2]), sat8(y0[3])); w.y = pk4_fp8(sat8(y1[0]), sat8(y1[1]), sat8(y1[2]), sat8(y1[3]));
                *(v2u*)rowp = w; }
    }
};
struct EpiL1in {
    static constexpr bool PERM = true; static constexpr int NST = 8;
    bf16_t* GB; bf16_t* UP;
    __device__ __forceinline__ void operator()(const f32x4 (&acc)[2][2][4][2], const Unit& u, int wr, int wc, int fr, int fq) const {
        const int row0 = u.pm * BM + wr * 64 + fr;
        if (u.pn < 4) {
            const int col0 = u.pn * BM + wc * 32 + 8 * fq;
#pragma unroll
            for (int ai = 0; ai < 2; ++ai)
#pragma unroll
                for (int m = 0; m < 4; ++m) { bf16_t* rowp = GB + (size_t)(row0 + ai * HALF + m * 16) * D_ + col0;
#pragma unroll
                    for (int bj = 0; bj < 2; ++bj) { const f32x4 v0 = acc[ai][bj][m][0], v1 = acc[ai][bj][m][1];
                        v4u w; w.x = cvt_pk_bf16(v0[0], v0[1]); w.y = cvt_pk_bf16(v0[2], v0[3]); w.z = cvt_pk_bf16(v1[0], v1[1]); w.w = cvt_pk_bf16(v1[2], v1[3]);
                        *(v4u*)(rowp + bj * HALF) = w; } }
        } else {
            const int col0 = (u.pn - 4) * HALF + wc * 32 + 8 * fq;
#pragma unroll
            for (int ai = 0; ai < 2; ++ai)
#pragma unroll
                for (int m = 0; m < 4; ++m) { bf16_t* rowp = UP + (size_t)(row0 + ai * HALF + m * 16) * D_ + col0;
                    const f32x4 g0 = acc[ai][0][m][0], g1 = acc[ai][0][m][1], u0 = acc[ai][1][m][0], u1 = acc[ai][1][m][1];
                    v4u w; w.x = cvt_pk_bf16(g0[0] * u0[0], g0[1] * u0[1]); w.y = cvt_pk_bf16(g0[2] * u0[2], g0[3] * u0[3]);
                    w.z = cvt_pk_bf16(g1[0] * u1[0], g1[1] * u1[1]); w.w = cvt_pk_bf16(g1[2] * u1[2], g1[3] * u1[3]);
                    *(v4u*)rowp = w; }
        }
    }
};
struct EpiLora {
    static constexpr bool PERM = true; static constexpr int NST = 16;
    bf16_t* WLOG; bf16_t* AB; bf16_t* GBUF; const float* w0; const float* a0;
    __device__ __forceinline__ void operator()(const f32x4 (&acc)[2][2][4][2], const Unit& u, int wr, int wc, int fr, int fq) const {
        const int row0 = u.pm * BM + wr * 64 + fr, sec = u.pn >> 1, chb = (u.pn & 1) * BM + wc * 32 + 8 * fq;
        f32x4 bia[2][2];
#pragma unroll
        for (int bj = 0; bj < 2; ++bj)
#pragma unroll
            for (int n = 0; n < 2; ++n) { const int ch = chb + bj * HALF + n * 4; bia[bj][n] = sec == 0 ? *(const f32x4*)(w0 + ch) : (sec == 1 ? *(const f32x4*)(a0 + ch) : (f32x4){0.f, 0.f, 0.f, 0.f}); }
        if (sec == 0) {
#pragma unroll
            for (int bj = 0; bj < 2; ++bj)
#pragma unroll
                for (int ai = 0; ai < 2; ++ai)
#pragma unroll
                    for (int m = 0; m < 4; ++m) { const size_t ro = (size_t)(row0 + ai * HALF + m * 16) * 512 + chb + bj * HALF; const f32x4 v0 = acc[ai][bj][m][0] + bia[bj][0], v1 = acc[ai][bj][m][1] + bia[bj][1]; f32x4 o0, o1;
#pragma unroll
                        for (int j = 0; j < 4; ++j) { o0[j] = -0.60653065971263342f * __builtin_amdgcn_rcpf(1.0f + __expf(-v0[j])); o1[j] = -0.60653065971263342f * __builtin_amdgcn_rcpf(1.0f + __expf(-v1[j])); }
                        v4u w; w.x = cvt_pk_bf16(o0[0], o0[1]); w.y = cvt_pk_bf16(o0[2], o0[3]); w.z = cvt_pk_bf16(o1[0], o1[1]); w.w = cvt_pk_bf16(o1[2], o1[3]); *(v4u*)(WLOG + ro) = w; }
        } else if (sec == 1) {
#pragma unroll
            for (int bj = 0; bj < 2; ++bj)
#pragma unroll
                for (int ai = 0; ai < 2; ++ai)
#pragma unroll
                    for (int m = 0; m < 4; ++m) { const size_t ro = (size_t)(row0 + ai * HALF + m * 16) * 512 + chb + bj * HALF; const f32x4 v0 = acc[ai][bj][m][0] + bia[bj][0], v1 = acc[ai][bj][m][1] + bia[bj][1]; f32x4 o0, o1;
#pragma unroll
                        for (int j = 0; j < 4; ++j) { o0[j] = __builtin_amdgcn_rcpf(1.0f + __expf(-v0[j])); o1[j] = __builtin_amdgcn_rcpf(1.0f + __expf(-v1[j])); }
                        v4u w; w.x = cvt_pk_bf16(o0[0], o0[1]); w.y = cvt_pk_bf16(o0[2], o0[3]); w.z = cvt_pk_bf16(o1[0], o1[1]); w.w = cvt_pk_bf16(o1[2], o1[3]); *(v4u*)(AB + ro) = w; }
        } else {
#pragma unroll
            for (int bj = 0; bj < 2; ++bj)
#pragma unroll
                for (int ai = 0; ai < 2; ++ai)
#pragma unroll
                    for (int m = 0; m < 4; ++m) { const size_t ro = (size_t)(row0 + ai * HALF + m * 16) * 512 + chb + bj * HALF; const f32x4 v0 = acc[ai][bj][m][0], v1 = acc[ai][bj][m][1];
                        v4u w; w.x = cvt_pk_bf16(v0[0], v0[1]); w.y = cvt_pk_bf16(v0[2], v0[3]); w.z = cvt_pk_bf16(v1[0], v1[1]); w.w = cvt_pk_bf16(v1[2], v1[3]); *(v4u*)(GBUF + ro) = w; }
        }
    }
};
__device__ __forceinline__ void row_stats(const float* stp, int row, float& mu, float& r) {
    const f32x4 a = *(const f32x4*)(stp + (size_t)row * 8), b = *(const f32x4*)(stp + (size_t)row * 8 + 4);
    const float s = ((a[0] + a[2]) + b[0]) + b[2], q = ((a[1] + a[3]) + b[1]) + b[3];
    mu = s * (1.0f / 1024.0f); r = rsqrtf(fmaxf(q * (1.0f / 1024.0f) - mu * mu, 0.f) + LN_EPS);
}
struct EpiResStats {
    static constexpr bool PERM = false; static constexpr int NST = 32;
    const float* base; float* out; bf16_t* outb; float* stp_out; PG8_LAS float* P; const PG8_LAS float* tbl; const float* stp_in; const float* gin; const float* bin;
    __device__ __forceinline__ void operator()(const f32x4 (&acc)[2][2][4][2], const Unit& u, int wr, int wc, int fr, int fq) const {
        const int row0 = u.pm * BM + wr * 64 + fr, col0 = u.pn * BM + wc * 32 + 4 * fq;
        f32x4 gv[2][2], bv[2][2];
        if (stp_in) {
#pragma unroll
            for (int bj = 0; bj < 2; ++bj)
#pragma unroll
                for (int n = 0; n < 2; ++n) { gv[bj][n] = *(const f32x4*)(gin + col0 + bj * HALF + n * 16); bv[bj][n] = *(const f32x4*)(bin + col0 + bj * HALF + n * 16); } }
#pragma unroll
        for (int ai = 0; ai < 2; ++ai)
#pragma unroll
            for (int m = 0; m < 4; ++m) { const int row = row0 + ai * HALF + m * 16; const size_t off = (size_t)row * D_ + col0;
                float mu = 0.f, rr = 1.f; if (stp_in) { const f32x2 mr = *(const PG8_LAS f32x2*)(tbl + (u.ui * 256 + ai * HALF + wr * 64 + m * 16 + fr) * 2); mu = mr[0]; rr = mr[1]; }
                float s = 0.f, q = 0.f;
#pragma unroll
                for (int bj = 0; bj < 2; ++bj)
#pragma unroll
                    for (int n = 0; n < 2; ++n) { f32x4 h = *(const f32x4*)(base + off + bj * HALF + n * 16);
                        if (stp_in) h = (h - mu) * rr * gv[bj][n] + bv[bj][n];
                        const f32x4 v = h * ALPHA + acc[ai][bj][m][n];
                        *(f32x4*)(out + off + bj * HALF + n * 16) = v;
                        if (outb) { v2u w; w.x = cvt_pk_bf16(v[0], v[1]); w.y = cvt_pk_bf16(v[2], v[3]); *(v2u*)(outb + off + bj * HALF + n * 16) = w; }
                        s += (v[0] + v[1]) + (v[2] + v[3]); q += (v[0] * v[0] + v[1] * v[1]) + (v[2] * v[2] + v[3] * v[3]); }
                if (stp_out) { s += __shfl_xor(s, 16); s += __shfl_xor(s, 32); q += __shfl_xor(q, 16); q += __shfl_xor(q, 32);
                    if (fq == 0) { PG8_LAS float* p = P + ((ai * HALF + wr * 64 + m * 16 + fr) * 4 + wc) * 2; p[0] = s; p[1] = q; } } }
        if (stp_out) {
            asm volatile("s_waitcnt lgkmcnt(0)" ::: "memory"); __builtin_amdgcn_s_barrier(); asm volatile("" ::: "memory");
            const int t = threadIdx.x;
            if (t < 256) { const f32x4 a = *(const PG8_LAS f32x4*)(P + t * 8), b = *(const PG8_LAS f32x4*)(P + t * 8 + 4);
                f32x2 o; o[0] = ((a[0] + a[2]) + b[0]) + b[2]; o[1] = ((a[1] + a[3]) + b[1]) + b[3];
                *(f32x2*)(stp_out + (size_t)(u.pm * BM + t) * 8 + u.pn * 2) = o; } }
    }
};
template <bool BASEF32, bool Q8 = false> struct EpiRes16 {
    static constexpr bool PERM = true; static constexpr int NST = 16; static constexpr int GR = 4, NG = 16 / GR;
    const void* base; bf16_t* outb; float* stp_out; PG8_LAS float* P; const PG8_LAS float* tbl; const float* gin; const float* bin; unsigned char* out8;
    __device__ __forceinline__ void operator()(const f32x4 (&acc)[2][2][4][2], const Unit& u, int wr, int wc, int fr, int fq) const {
        const int row0 = u.pm * BM + wr * 64 + fr, col0 = u.pn * BM + wc * 32 + 8 * fq;
        float s[8], q[8]; v2u q8[Q8 ? GR : 1];
#pragma unroll
        for (int r = 0; r < 8; ++r) { s[r] = 0.f; q[r] = 0.f; }
#pragma unroll
        for (int g = 0; g < NG; ++g) { const int bj = GR == 8 ? g : (g & 1), rb = GR == 8 ? 0 : (g >> 1) * 4, cb = col0 + bj * HALF;
            f32x4 g0 = (f32x4){1.f, 1.f, 1.f, 1.f}, g1 = g0, b0 = (f32x4){0.f, 0.f, 0.f, 0.f}, b1 = b0;
            if (gin) { g0 = *(const f32x4*)(gin + cb); g1 = *(const f32x4*)(gin + cb + 4); b0 = *(const f32x4*)(bin + cb); b1 = *(const f32x4*)(bin + cb + 4); }
            f32x4 hf0[BASEF32 ? GR : 1], hf1[BASEF32 ? GR : 1]; v4u hb[BASEF32 ? 1 : GR];
#pragma unroll
            for (int i = 0; i < GR; ++i) { const int r = rb + i; const size_t off = (size_t)(row0 + (r >> 2) * HALF + (r & 3) * 16) * D_ + cb;
                if constexpr (BASEF32) { hf0[i] = *(const f32x4*)((const float*)base + off); hf1[i] = *(const f32x4*)((const float*)base + off + 4); }
                else hb[i] = *(const v4u*)((const bf16_t*)base + off); }
            if constexpr (Q8) { if (g > 0) { const int pbj = GR == 8 ? g - 1 : ((g - 1) & 1), prb = GR == 8 ? 0 : ((g - 1) >> 1) * 4;
#pragma unroll
                for (int i = 0; i < GR; ++i) { const int r = prb + i; *(v2u*)(out8 + (size_t)(row0 + (r >> 2) * HALF + (r & 3) * 16) * D_ + col0 + pbj * HALF) = q8[i]; } } }
#pragma unroll
            for (int i = 0; i < GR; ++i) { const int r = rb + i, ai = r >> 2, m = r & 3, rl = ai * HALF + wr * 64 + m * 16 + fr;
                f32x4 a0, a1;
                if constexpr (BASEF32) { a0 = hf0[i]; a1 = hf1[i]; }
                else { const v4u w = hb[i];
                    a0 = (f32x4){__builtin_bit_cast(float, w.x << 16), __builtin_bit_cast(float, w.x & 0xffff0000u), __builtin_bit_cast(float, w.y << 16), __builtin_bit_cast(float, w.y & 0xffff0000u)};
                    a1 = (f32x4){__builtin_bit_cast(float, w.z << 16), __builtin_bit_cast(float, w.z & 0xffff0000u), __builtin_bit_cast(float, w.w << 16), __builtin_bit_cast(float, w.w & 0xffff0000u)}; }
                if (gin) { const f32x2 mr = *(const PG8_LAS f32x2*)(tbl + (u.ui * 256 + rl) * 2); a0 = (a0 - mr[0]) * mr[1] * g0 + b0; a1 = (a1 - mr[0]) * mr[1] * g1 + b1; }
                const f32x4 v0 = a0 * ALPHA + acc[ai][bj][m][0], v1 = a1 * ALPHA + acc[ai][bj][m][1];
                v4u w; w.x = cvt_pk_bf16(v0[0], v0[1]); w.y = cvt_pk_bf16(v0[2], v0[3]); w.z = cvt_pk_bf16(v1[0], v1[1]); w.w = cvt_pk_bf16(v1[2], v1[3]);
                *(v4u*)(outb + (size_t)(row0 + ai * HALF + m * 16) * D_ + cb) = w;
                if constexpr (Q8) { q8[i].x = q8x4(v0[0], v0[1], v0[2], v0[3]); q8[i].y = q8x4(v1[0], v1[1], v1[2], v1[3]); }
                s[r] += ((v0[0] + v0[1]) + (v0[2] + v0[3])) + ((v1[0] + v1[1]) + (v1[2] + v1[3]));
                q[r] += ((v0[0] * v0[0] + v0[1] * v0[1]) + (v0[2] * v0[2] + v0[3] * v0[3])) + ((v1[0] * v1[0] + v1[1] * v1[1]) + (v1[2] * v1[2] + v1[3] * v1[3])); } }
        if constexpr (Q8) { const int pbj = 1, prb = GR == 8 ? 0 : 4;
#pragma unroll
            for (int i = 0; i < GR; ++i) { const int r = prb + i; *(v2u*)(out8 + (size_t)(row0 + (r >> 2) * HALF + (r & 3) * 16) * D_ + col0 + pbj * HALF) = q8[i]; } }
        if (stp_out) {
#pragma unroll
            for (int r = 0; r < 8; ++r) { float ss = s[r], qq = q[r]; ss += __shfl_xor(ss, 16); ss += __shfl_xor(ss, 32); qq += __shfl_xor(qq, 16); qq += __shfl_xor(qq, 32);
                if (fq == 0) { PG8_LAS float* p = P + (((r >> 2) * HALF + wr * 64 + (r & 3) * 16 + fr) * 4 + wc) * 2; p[0] = ss; p[1] = qq; } }
            asm volatile("s_waitcnt lgkmcnt(0)" ::: "memory"); __builtin_amdgcn_s_barrier(); asm volatile("" ::: "memory");
            const int t = threadIdx.x;
            if (t < 256) { const f32x4 a = *(const PG8_LAS f32x4*)(P + t * 8), b = *(const PG8_LAS f32x4*)(P + t * 8 + 4);
                f32x2 o; o[0] = ((a[0] + a[2]) + b[0]) + b[2]; o[1] = ((a[1] + a[3]) + b[1]) + b[3];
                *(f32x2*)(stp_out + (size_t)(u.pm * BM + t) * 8 + u.pn * 2) = o; } }
    }
};
struct EpiSwigluLN {
    static constexpr bool PERM = true; static constexpr int NST = 8;
    bf16_t* O; int ldc; const PG8_LAS float* tbl; const float* sv; const float* cv;
    __device__ __forceinline__ void operator()(const f32x4 (&acc)[2][2][4][2], const Unit& u, int wr, int wc, int fr, int fq) const {
        const int row0 = u.pm * BM + wr * 64 + fr, col0 = u.pn * HALF + wc * 32 + 8 * fq, n0 = u.pn * BM + wc * 32 + 8 * fq;
        f32x4 sg[2], cg[2], su[2], cu[2];
#pragma unroll
        for (int n = 0; n < 2; ++n) { sg[n] = *(const f32x4*)(sv + n0 + 4 * n); cg[n] = *(const f32x4*)(cv + n0 + 4 * n); su[n] = *(const f32x4*)(sv + n0 + HALF + 4 * n); cu[n] = *(const f32x4*)(cv + n0 + HALF + 4 * n); }
#pragma unroll
        for (int ai = 0; ai < 2; ++ai)
#pragma unroll
            for (int m = 0; m < 4; ++m) { const int row = row0 + ai * HALF + m * 16; bf16_t* rowp = O + (size_t)row * ldc + col0;
                const f32x2 mr = *(const PG8_LAS f32x2*)(tbl + (u.ui * 256 + ai * HALF + wr * 64 + m * 16 + fr) * 2); const float mu = mr[0], rr = mr[1];
                const f32x4 g0 = (acc[ai][0][m][0] - sg[0] * mu) * rr + cg[0], g1 = (acc[ai][0][m][1] - sg[1] * mu) * rr + cg[1];
                const f32x4 u0 = (acc[ai][1][m][0] - su[0] * mu) * rr + cu[0], u1 = (acc[ai][1][m][1] - su[1] * mu) * rr + cu[1];
                v4u w; w.x = cvt_pk_bf16(silu_f(g0[0]) * u0[0], silu_f(g0[1]) * u0[1]); w.y = cvt_pk_bf16(silu_f(g0[2]) * u0[2], silu_f(g0[3]) * u0[3]);
                w.z = cvt_pk_bf16(silu_f(g1[0]) * u1[0], silu_f(g1[1]) * u1[1]); w.w = cvt_pk_bf16(silu_f(g1[2]) * u1[2], silu_f(g1[3]) * u1[3]);
                *(v4u*)rowp = w; }
    }
};
struct EpiSwigluLNi8 {
    static constexpr bool PERM = true; static constexpr int NST = 8;
    bf16_t* O; int ldc; const PG8_LAS float* tbl; const float* sc; const float* sv; const float* cv;
    __device__ __forceinline__ void operator()(const f32x4 (&acc)[2][2][4][2], const Unit& u, int wr, int wc, int fr, int fq) const {
        const int row0 = u.pm * BM + wr * 64 + fr, col0 = u.pn * HALF + wc * 32 + 8 * fq, n0 = u.pn * BM + wc * 32 + 8 * fq;
        f32x4 kg[2], sg[2], cg[2], ku[2], su[2], cu[2];
#pragma unroll
        for (int n = 0; n < 2; ++n) { kg[n] = *(const f32x4*)(sc + n0 + 4 * n); sg[n] = *(const f32x4*)(sv + n0 + 4 * n); cg[n] = *(const f32x4*)(cv + n0 + 4 * n);
            ku[n] = *(const f32x4*)(sc + n0 + HALF + 4 * n); su[n] = *(const f32x4*)(sv + n0 + HALF + 4 * n); cu[n] = *(const f32x4*)(cv + n0 + HALF + 4 * n); }
#define I2F(x) __builtin_convertvector(__builtin_bit_cast(v4i, (x)), f32x4)
#pragma unroll
        for (int ai = 0; ai < 2; ++ai)
#pragma unroll
            for (int m = 0; m < 4; ++m) { const int row = row0 + ai * HALF + m * 16; bf16_t* rowp = O + (size_t)row * ldc + col0;
                const f32x2 mr = *(const PG8_LAS f32x2*)(tbl + (u.ui * 256 + ai * HALF + wr * 64 + m * 16 + fr) * 2); const float mu = mr[0], rr = mr[1];
                const f32x4 g0 = (I2F(acc[ai][0][m][0]) * kg[0] - sg[0] * mu) * rr + cg[0], g1 = (I2F(acc[ai][0][m][1]) * kg[1] - sg[1] * mu) * rr + cg[1];
                const f32x4 u0 = (I2F(acc[ai][1][m][0]) * ku[0] - su[0] * mu) * rr + cu[0], u1 = (I2F(acc[ai][1][m][1]) * ku[1] - su[1] * mu) * rr + cu[1];
                const f32x4 y0 = swiglu4(g0, u0), y1 = swiglu4(g1, u1);
                v4u w; w.x = cvt_pk_bf16(y0[0], y0[1]); w.y = cvt_pk_bf16(y0[2], y0[3]); w.z = cvt_pk_bf16(y1[0], y1[1]); w.w = cvt_pk_bf16(y1[2], y1[3]);
                *(v4u*)rowp = w; }
#undef I2F
    }
};
struct EpiL1inLN {
    static constexpr bool PERM = true; static constexpr int NST = 8;
    bf16_t* GB; bf16_t* UP; const PG8_LAS float* tbl; const float* sv; const float* cv;
    __device__ __forceinline__ void operator()(const f32x4 (&acc)[2][2][4][2], const Unit& u, int wr, int wc, int fr, int fq) const {
        const int row0 = u.pm * BM + wr * 64 + fr, n0 = u.pn * BM + wc * 32 + 8 * fq;
        f32x4 s0[2], c0[2], s1[2], c1[2];
#pragma unroll
        for (int n = 0; n < 2; ++n) { s0[n] = *(const f32x4*)(sv + n0 + 4 * n); c0[n] = *(const f32x4*)(cv + n0 + 4 * n); s1[n] = *(const f32x4*)(sv + n0 + HALF + 4 * n); c1[n] = *(const f32x4*)(cv + n0 + HALF + 4 * n); }
#pragma unroll
        for (int ai = 0; ai < 2; ++ai)
#pragma unroll
            for (int m = 0; m < 4; ++m) { const int row = row0 + ai * HALF + m * 16;
                const f32x2 mr = *(const PG8_LAS f32x2*)(tbl + (u.ui * 256 + ai * HALF + wr * 64 + m * 16 + fr) * 2); const float mu = mr[0], rr = mr[1];
                const f32x4 a0 = (acc[ai][0][m][0] - s0[0] * mu) * rr + c0[0], a1 = (acc[ai][0][m][1] - s0[1] * mu) * rr + c0[1];
                const f32x4 b0 = (acc[ai][1][m][0] - s1[0] * mu) * rr + c1[0], b1 = (acc[ai][1][m][1] - s1[1] * mu) * rr + c1[1];
                if (u.pn < 4) { bf16_t* rowp = GB + (size_t)row * D_ + n0;
                    v4u w; w.x = cvt_pk_bf16(a0[0], a0[1]); w.y = cvt_pk_bf16(a0[2], a0[3]); w.z = cvt_pk_bf16(a1[0], a1[1]); w.w = cvt_pk_bf16(a1[2], a1[3]); *(v4u*)rowp = w;
                    v4u x; x.x = cvt_pk_bf16(b0[0], b0[1]); x.y = cvt_pk_bf16(b0[2], b0[3]); x.z = cvt_pk_bf16(b1[0], b1[1]); x.w = cvt_pk_bf16(b1[2], b1[3]); *(v4u*)(rowp + HALF) = x; }
                else { bf16_t* rowp = UP + (size_t)row * D_ + (u.pn - 4) * HALF + wc * 32 + 8 * fq;
                    v4u w; w.x = cvt_pk_bf16(a0[0] * b0[0], a0[1] * b0[1]); w.y = cvt_pk_bf16(a0[2] * b0[2], a0[3] * b0[3]); w.z = cvt_pk_bf16(a1[0] * b1[0], a1[1] * b1[1]); w.w = cvt_pk_bf16(a1[2] * b1[2], a1[3] * b1[3]); *(v4u*)rowp = w; } }
    }
};
struct EpiL1inLNi8 {
    static constexpr bool PERM = true; static constexpr int NST = 8;
    bf16_t* GB; bf16_t* UP; const PG8_LAS float* tbl; const float* sc; const float* sv; const float* cv;
    __device__ __forceinline__ void operator()(const f32x4 (&acc)[2][2][4][2], const Unit& u, int wr, int wc, int fr, int fq) const {
        const int row0 = u.pm * BM + wr * 64 + fr, n0 = u.pn * BM + wc * 32 + 8 * fq;
        f32x4 k0[2], s0[2], c0[2], k1[2], s1[2], c1[2];
#pragma unroll
        for (int n = 0; n < 2; ++n) { k0[n] = *(const f32x4*)(sc + n0 + 4 * n); s0[n] = *(const f32x4*)(sv + n0 + 4 * n); c0[n] = *(const f32x4*)(cv + n0 + 4 * n);
            k1[n] = *(const f32x4*)(sc + n0 + HALF + 4 * n); s1[n] = *(const f32x4*)(sv + n0 + HALF + 4 * n); c1[n] = *(const f32x4*)(cv + n0 + HALF + 4 * n); }
#define I2F(x) __builtin_convertvector(__builtin_bit_cast(v4i, (x)), f32x4)
#pragma unroll
        for (int ai = 0; ai < 2; ++ai)
#pragma unroll
            for (int m = 0; m < 4; ++m) { const int row = row0 + ai * HALF + m * 16;
                const f32x2 mr = *(const PG8_LAS f32x2*)(tbl + (u.ui * 256 + ai * HALF + wr * 64 + m * 16 + fr) * 2); const float mu = mr[0], rr = mr[1];
                const f32x4 a0 = (I2F(acc[ai][0][m][0]) * k0[0] - s0[0] * mu) * rr + c0[0], a1 = (I2F(acc[ai][0][m][1]) * k0[1] - s0[1] * mu) * rr + c0[1];
                const f32x4 b0 = (I2F(acc[ai][1][m][0]) * k1[0] - s1[0] * mu) * rr + c1[0], b1 = (I2F(acc[ai][1][m][1]) * k1[1] - s1[1] * mu) * rr + c1[1];
                if (u.pn < 4) { bf16_t* rowp = GB + (size_t)row * D_ + n0;
                    v4u w; w.x = cvt_pk_bf16(a0[0], a0[1]); w.y = cvt_pk_bf16(a0[2], a0[3]); w.z = cvt_pk_bf16(a1[0], a1[1]); w.w = cvt_pk_bf16(a1[2], a1[3]); *(v4u*)rowp = w;
                    v4u x; x.x = cvt_pk_bf16(b0[0], b0[1]); x.y = cvt_pk_bf16(b0[2], b0[3]); x.z = cvt_pk_bf16(b1[0], b1[1]); x.w = cvt_pk_bf16(b1[2], b1[3]); *(v4u*)(rowp + HALF) = x; }
                else { bf16_t* rowp = UP + (size_t)row * D_ + (u.pn - 4) * HALF + wc * 32 + 8 * fq;
                    v4u w; w.x = cvt_pk_bf16(a0[0] * b0[0], a0[1] * b0[1]); w.y = cvt_pk_bf16(a0[2] * b0[2], a0[3] * b0[3]); w.z = cvt_pk_bf16(a1[0] * b1[0], a1[1] * b1[1]); w.w = cvt_pk_bf16(a1[2] * b1[2], a1[3] * b1[3]); *(v4u*)rowp = w; } }
#undef I2F
    }
};
struct EpiMoeDown {
    static constexpr bool PERM = true; static constexpr int NST = 0; static constexpr unsigned SCALE_W = 0x78787878u;
    float* out; bf16_t* Y2; const int* perm; const float* slotp;
    __device__ __forceinline__ void operator()(const f32x4 (&acc)[2][2][4][2], const Unit& u, int wr, int wc, int fr, int fq) const {
        const int slot0 = u.pm * BM + wr * 64 + fr, col0 = u.pn * BM + wc * 32 + 8 * fq;
        int tk[8]; float pw[8];
#pragma unroll
        for (int r = 0; r < 8; ++r) { const int sl = slot0 + (r >> 2) * HALF + (r & 3) * 16; tk[r] = perm[sl]; pw[r] = slotp[sl]; }
#pragma unroll
        for (int r = 0; r < 8; ++r) { const int ai = r >> 2, m = r & 3, tok = tk[r] & 0xffffff;
            if (tk[r] >= 0) { const float p = pw[r];
                bf16_t* dst = ((tk[r] >> 30) & 1) == 0 ? (bf16_t*)out + (size_t)tok * 2048 + 1024 + col0 : Y2 + (size_t)tok * D_ + col0;
#pragma unroll
                for (int bj = 0; bj < 2; ++bj) { const f32x4 v0 = acc[ai][bj][m][0] * p, v1 = acc[ai][bj][m][1] * p;
                    v4u w; w.x = cvt_pk_bf16(v0[0], v0[1]); w.y = cvt_pk_bf16(v0[2], v0[3]); w.z = cvt_pk_bf16(v1[0], v1[1]); w.w = cvt_pk_bf16(v1[2], v1[3]);
                    *(v4u*)(dst + bj * HALF) = w; } } }
    }
};
}

#define XB_TMO      128
#define XB_XCNT(j)  (256  + 64 * (j))
#define XB_XSUB(j)  (1280 + 64 * (j))
#define XB_XGEN(j)  (2304 + 64 * (j))
#define XB_TOP      3328
#define XB_TOPGEN   3392
#define XCD_BAR_WORDS 3456
#define XB_SPIN_CAP (1u << 22)
__device__ __forceinline__ unsigned xb_ld(unsigned* p)              { return __hip_atomic_load(p, __ATOMIC_RELAXED, __HIP_MEMORY_SCOPE_AGENT); }
__device__ __forceinline__ unsigned xb_add(unsigned* p, unsigned v) { return __hip_atomic_fetch_add(p, v, __ATOMIC_RELAXED, __HIP_MEMORY_SCOPE_AGENT); }
__device__ __forceinline__ unsigned xb_xcc_id() { return (unsigned)__builtin_amdgcn_s_getreg((3 << 11) | 20) & 0xFu; }
#define XB_SPIN(cond, bar) do { unsigned _sp = 0; while (cond) { __builtin_amdgcn_s_sleep(1); \
    if ((++_sp & 255u) == 0u) { if (xb_ld(&(bar)[XB_TMO])) break; if (_sp > XB_SPIN_CAP) { atomicAdd(&(bar)[XB_TMO], 1u); break; } } } } while (0)
struct XcdBarrier { unsigned* bar; unsigned x; volatile LAS unsigned* st; };
__device__ __forceinline__ XcdBarrier xcd_barrier_post(unsigned* bar, volatile LAS unsigned* st) {
    XcdBarrier b; b.bar = bar; b.x = xb_xcc_id(); b.st = st;
    if (threadIdx.x == 0) (void)xb_add(&bar[XB_XCNT(b.x)], 1u);
    return b;
}
__device__ __forceinline__ void xcd_barrier_complete(unsigned* bar, unsigned x, unsigned& nloc, unsigned& nx) {
    const unsigned G = gridDim.x * gridDim.y * gridDim.z;
    unsigned sum, cnt, mine, sp = 0u;
    for (;;) {
        sum = 0u; cnt = 0u; mine = 0u;
#pragma unroll
        for (unsigned j = 0; j < 16; ++j) { const unsigned c = xb_ld(&bar[XB_XCNT(j)]); sum += c; cnt += (c > 0u) ? 1u : 0u; mine = (j == x) ? c : mine; }
        if (sum == G) break;
        __builtin_amdgcn_s_sleep(1);
        if ((++sp & 255u) == 0u) { if (xb_ld(&bar[XB_TMO])) break; if (sp > XB_SPIN_CAP) { atomicAdd(&bar[XB_TMO], 1u); break; } }
    }
    nloc = mine > 0u ? mine : 1u; nx = cnt > 0u ? cnt : 1u;
}
__device__ __forceinline__ void xcd_barrier(const XcdBarrier& b) {
    asm volatile("s_waitcnt vmcnt(0)" ::: "memory");
    __syncthreads();
    if (threadIdx.x == 0) {
        unsigned* bar = b.bar;
        __builtin_amdgcn_s_waitcnt(0);
        unsigned nloc = b.st[0], nx = b.st[1];
        if (nloc == 0u) { xcd_barrier_complete(bar, b.x, nloc, nx); b.st[0] = nloc; b.st[1] = nx; }
        const unsigned old = xb_add(&bar[XB_XSUB(b.x)], 1u);
        const unsigned gen = old / nloc;
        if (old + 1u == (gen + 1u) * nloc) {
            __builtin_amdgcn_fence(__ATOMIC_RELEASE, "agent");
            asm volatile("s_waitcnt vmcnt(0)" ::: "memory");
            const unsigned og = xb_add(&bar[XB_TOP], 1u);
            const unsigned tg = og / nx;
            if (og + 1u == (tg + 1u) * nx) xb_add(&bar[XB_TOPGEN], 1u);
            else XB_SPIN(xb_ld(&bar[XB_TOPGEN]) == tg, bar);
            __builtin_amdgcn_fence(__ATOMIC_ACQUIRE, "agent");
            xb_add(&bar[XB_XGEN(b.x)], 1u);
            asm volatile("s_waitcnt vmcnt(0)" ::: "memory");
        } else {
            XB_SPIN(xb_ld(&bar[XB_XGEN(b.x)]) == gen, bar);
            __builtin_amdgcn_fence(__ATOMIC_ACQUIRE, "agent");
            asm volatile("s_waitcnt vmcnt(0)" ::: "memory");
        }
    }
    __syncthreads();
}

__device__ __forceinline__ unsigned f2bf(float f) { unsigned u = __builtin_bit_cast(unsigned, f); return (u + 0x7fffu + ((u >> 16) & 1u)) >> 16; }
__device__ __forceinline__ unsigned pk2(float lo, float hi) { return pg8::cvt_pk_bf16(lo, hi); }
__device__ __forceinline__ float bf2f(unsigned short b) { return __builtin_bit_cast(float, ((unsigned)b) << 16); }
__device__ __forceinline__ float bflo(unsigned w) { return __builtin_bit_cast(float, w << 16); }
__device__ __forceinline__ float bfhi(unsigned w) { return __builtin_bit_cast(float, w & 0xffff0000u); }
__device__ __forceinline__ float wave_sum(float v) {
#pragma unroll
    for (int o = 1; o < 64; o <<= 1) v += __shfl_xor(v, o);
    return v;
}
template <int CTRL> __device__ __forceinline__ float dpp_mov(float x) { return __builtin_bit_cast(float, __builtin_amdgcn_update_dpp(0, __builtin_bit_cast(int, x), CTRL, 0xf, 0xf, false)); }
__device__ __forceinline__ float row16_sum(float x) { x += dpp_mov<0x128>(x); x += dpp_mov<0x124>(x); x += dpp_mov<0x122>(x); x += dpp_mov<0x121>(x); return x; }

__device__ __forceinline__ float rl_f(float x, int l) { return __builtin_bit_cast(float, __builtin_amdgcn_readlane(__builtin_bit_cast(int, x), l)); }
template <int CTRL, int RMASK> __device__ __forceinline__ float dpp_add_rm(float x) { return x + __builtin_bit_cast(float, __builtin_amdgcn_update_dpp(0, __builtin_bit_cast(int, x), CTRL, RMASK, 0xf, true)); }
__device__ __forceinline__ float wave_sum_fast(float x) { x = row16_sum(x); x = dpp_add_rm<0x142, 0xA>(x); x = dpp_add_rm<0x143, 0xC>(x); return rl_f(x, 63); }
struct WInfo { int tid, lane, wave, vcu, G, gw, NGW; };

__device__ __forceinline__ void tr_item(const float* __restrict__ W, int Nsrc, int c0, int k0, bf16* WT, int K, int n0, LAS float* scr, int lane, const float* ksc = nullptr) {
    { float v[32], g[32];
#pragma unroll
      for (int i = 0; i < 32; ++i) { const int kk = 2 * i + (lane >> 5); v[i] = W[(size_t)(k0 + kk) * Nsrc + c0 + (lane & 31)]; g[i] = ksc ? ksc[k0 + kk] : 1.0f; }
      asm volatile("" ::: "memory");
#pragma unroll
      for (int i = 0; i < 32; ++i) { const int kk = 2 * i + (lane >> 5); scr[kk * 33 + (lane & 31)] = v[i] * g[i]; } }
    LDS_WAIT(); asm volatile("" ::: "memory");
    const int c = lane & 7;
#pragma unroll
    for (int j = 0; j < 4; ++j) { const int n = (lane >> 3) + 8 * j; const LAS float* s = scr + (8 * c) * 33 + n;
        v4u o; o.x = pk2(s[0 * 33], s[1 * 33]); o.y = pk2(s[2 * 33], s[3 * 33]); o.z = pk2(s[4 * 33], s[5 * 33]); o.w = pk2(s[6 * 33], s[7 * 33]);
        *(v4u*)(WT + (size_t)(n0 + n) * K + k0 + 8 * c) = o; }
    LDS_WAIT(); asm volatile("" ::: "memory");
}
__device__ __forceinline__ void tr_item8(const float* __restrict__ Wsrc, int Nsrc, int c0, int k0, unsigned char* WT, int K, int n0, float scale, LAS float* scr, int lane) {
#pragma unroll 32
    for (int i = 0; i < 32; ++i) { const int kk = 2 * i + (lane >> 5); scr[kk * 33 + (lane & 31)] = Wsrc[(size_t)(k0 + kk) * Nsrc + c0 + (lane & 31)] * scale; }
    LDS_WAIT(); asm volatile("" ::: "memory");
    const int n = lane & 31, kh = lane >> 5; const LAS float* s = scr + (kh * 32) * 33 + n;
    v4u o0, o1;
#pragma unroll
    for (int q = 0; q < 4; ++q) { o0[q] = pg8::pk4_fp8(s[(4 * q) * 33], s[(4 * q + 1) * 33], s[(4 * q + 2) * 33], s[(4 * q + 3) * 33]); o1[q] = pg8::pk4_fp8(s[(16 + 4 * q) * 33], s[(17 + 4 * q) * 33], s[(18 + 4 * q) * 33], s[(19 + 4 * q) * 33]); }
    unsigned char* dst = WT + (size_t)(n0 + n) * K + k0 + kh * 32; *(v4u*)dst = o0; *(v4u*)(dst + 16) = o1;
    LDS_WAIT(); asm volatile("" ::: "memory");
}
constexpr int I_WIN0 = 0  , I_WOUT = 16 * 32, I_FGU = 0  , I_FD = 44 * 32, I_IN1 = 0  , I_MGU1 = 16 * 224, I_MD1 = 56 * 32;
constexpr int NITEMS_MOE = 8 * I_MGU1 + 8 * I_MD1, NITEMS = I_WIN0 + I_WOUT + I_FGU + I_FD + I_IN1 + I_WOUT + NITEMS_MOE;
__device__ __forceinline__ void weight_item(const WInfo& W, LAS unsigned char* lds, const float* const* in, unsigned char* ws, int it) {
    LAS float* scr = (LAS float*)(lds + W.wave * 16384);
    for (int once = 0; once < 1; ++once) {
        int r = it;
        if (r < 8 * I_MGU1) { const int e = r / I_MGU1, r2 = r % I_MGU1, kb = r2 / 224, nb = r2 % 224, n0 = nb * 32, q = n0 >> 8, rr = n0 & 255;
            const float* src = (rr < 128 ? in[29] : in[30]) + (size_t)e * 1024 * FFE;
            tr_item8(src, FFE, q * 128 + (rr & 127), kb * 64, ws + WS_WMGU + (size_t)e * 7168 * 1024, 1024, n0, 32.0f * (rr < 128 ? pg8::SW_TG : pg8::SW_TU), scr, W.lane); continue; } r -= 8 * I_MGU1;
        if (r < 8 * I_MD1) { const int e = r / I_MD1, r2 = r % I_MD1, kb = r2 / 32, nb = r2 % 32;
            tr_item8(in[31] + (size_t)e * FFE * 1024, 1024, nb * 32, kb * 64, ws + WS_WMD + (size_t)e * 1024 * FFE, FFE, nb * 32, 128.0f, scr, W.lane); continue; } r -= 8 * I_MD1;
        if (r < I_WIN0) { const int kb = r / 80, nb = r % 80; tr_item(in[2], NZ, nb * 32, kb * 64, (bf16*)(ws + WS_WIN0), 1024, nb * 32, scr, W.lane); continue; } r -= I_WIN0;
        if (r < I_WOUT) { const int kb = r / 32, nb = r % 32; tr_item(in[15], 1024, nb * 32, kb * 64, (bf16*)(ws + WS_WOUT0), 1024, nb * 32, scr, W.lane); continue; } r -= I_WOUT;
        if (r < I_FGU) { const int kb = r / 176, nb = r % 176, n0 = nb * 32, q = n0 >> 8, rr = n0 & 255;
            tr_item(rr < 128 ? in[18] : in[19], FF, q * 128 + (rr & 127), kb * 64, (bf16*)(ws + WS_WFGU), 1024, n0, scr, W.lane, in[16]); continue; } r -= I_FGU;
        if (r < I_FD) { const int kb = r / 32, nb = r % 32; tr_item(in[20], 1024, nb * 32, kb * 64, (bf16*)(ws + WS_WFD), FF, nb * 32, scr, W.lane); continue; } r -= I_FD;
        if (r < I_IN1) { const int kb = r / 96, nb = r % 96, n0 = nb * 32; int c0 = n0;
            if (n0 >= 1024) { const int q = (n0 - 1024) >> 8, rr = (n0 - 1024) & 255; c0 = (rr < 128 ? 1024 : 2048) + q * 128 + (rr & 127); }
            tr_item(in[23], 3072, c0, kb * 64, (bf16*)(ws + WS_WIN1), 1024, n0, scr, W.lane, in[21]); continue; } r -= I_IN1;
        { const int kb = r / 32, nb = r % 32; tr_item(in[25], 1024, nb * 32, kb * 64, (bf16*)(ws + WS_WOUT1), 1024, nb * 32, scr, W.lane); }
    }
}
struct MoeItem { const float* src; unsigned char* dst; int Nsrc, K; float scale; };
__device__ __forceinline__ MoeItem moe_item(const float* const* in, unsigned char* ws, int it) {
    MoeItem d;
    if (it < 8 * I_MGU1) { const int e = it / I_MGU1, r2 = it % I_MGU1, kb = r2 / 224, nb = r2 % 224, n0 = nb * 32, q = n0 >> 8, rr = n0 & 255;
        d.src = (rr < 128 ? in[29] : in[30]) + (size_t)e * 1024 * FFE + (size_t)(kb * 64) * FFE + q * 128 + (rr & 127); d.Nsrc = FFE;
        d.dst = ws + WS_WMGU + (size_t)e * 7168 * 1024 + (size_t)n0 * 1024 + kb * 64; d.K = 1024; d.scale = 32.0f * (rr < 128 ? pg8::SW_TG : pg8::SW_TU); }
    else { const int r = it - 8 * I_MGU1, e = r / I_MD1, r2 = r % I_MD1, kb = r2 / 32, nb = r2 % 32;
        d.src = in[31] + (size_t)e * FFE * 1024 + (size_t)(kb * 64) * 1024 + nb * 32; d.Nsrc = 1024;
        d.dst = ws + WS_WMD + (size_t)e * 1024 * FFE + (size_t)(nb * 32) * FFE + kb * 64; d.K = FFE; d.scale = 128.0f; }
    return d;
}
__device__ __forceinline__ void moe_item_load(float (&v)[32], const MoeItem& d, int lane) {
#pragma unroll
    for (int i = 0; i < 32; ++i) v[i] = __builtin_nontemporal_load(&d.src[(size_t)(2 * i + (lane >> 5)) * d.Nsrc + (lane & 31)]);
}
__device__ __forceinline__ void moe_item_finish(const float (&v)[32], const MoeItem& d, LAS float* scr, int lane) {
#pragma unroll
    for (int i = 0; i < 32; ++i) scr[(2 * i + (lane >> 5)) * 33 + (lane & 31)] = v[i] * d.scale;
    LDS_WAIT(); asm volatile("" ::: "memory");
    const int n = lane & 31, kh = lane >> 5; const LAS float* s = scr + (kh * 32) * 33 + n;
    v4u o0, o1;
#pragma unroll
    for (int q = 0; q < 4; ++q) { o0[q] = pg8::pk4_fp8(s[(4 * q) * 33], s[(4 * q + 1) * 33], s[(4 * q + 2) * 33], s[(4 * q + 3) * 33]); o1[q] = pg8::pk4_fp8(s[(16 + 4 * q) * 33], s[(17 + 4 * q) * 33], s[(18 + 4 * q) * 33], s[(19 + 4 * q) * 33]); }
    unsigned char* dst = d.dst + (size_t)n * d.K + kh * 32; *(v4u*)dst = o0; *(v4u*)(dst + 16) = o1;
    LDS_WAIT(); asm volatile("" ::: "memory");
}
__device__ __forceinline__ unsigned wave_min_u(unsigned v) {
#pragma unroll
    for (int o = 1; o < 64; o <<= 1) { const unsigned t = (unsigned)__shfl_xor((int)v, o); v = t < v ? t : v; }
    return v;
}
__device__ __forceinline__ void moe_weights(const WInfo& W, LAS unsigned char* lds, const float* const* in, unsigned char* ws, int lo, int hi, int v, int V, unsigned* prog) {
    static_assert(WS_WMGU == WS_SLOT, "MoE copies overlay the chunk slots");
    if (prog) { const int qe = hi - 1; const unsigned long long dend = qe < 8 * I_MGU1 ? (unsigned long long)(qe / I_MGU1 + 1) * 7168ull * 1024ull : (unsigned long long)8 * 7168ull * 1024ull + (unsigned long long)((qe - 8 * I_MGU1) / I_MD1 + 1) * 1024ull * FFE;
        for (;;) { const unsigned pmin = wave_min_u(__hip_atomic_load(prog + W.lane, __ATOMIC_RELAXED, __HIP_MEMORY_SCOPE_AGENT)); if ((unsigned long long)pmin * (64ull * 10240ull) >= dend) break; __builtin_amdgcn_s_sleep(32); }
        asm volatile("" ::: "memory"); }
    LAS float* scr = (LAS float*)(lds + W.wave * 16384);
    float va[32], vb[32]; MoeItem da, db;
    int it = lo + v;
    if (it < hi) { da = moe_item(in, ws, it); moe_item_load(va, da, W.lane); }
    while (it < hi) {
        const int i1 = it + V, i2 = it + 2 * V;
        if (i1 < hi) { db = moe_item(in, ws, i1); moe_item_load(vb, db, W.lane); }
        asm volatile("" ::: "memory");
        moe_item_finish(va, da, scr, W.lane);
        if (i1 >= hi) break;
        if (i2 < hi) { da = moe_item(in, ws, i2); moe_item_load(va, da, W.lane); }
        asm volatile("" ::: "memory");
        moe_item_finish(vb, db, scr, W.lane);
        it = i2;
    }
}
__device__ __forceinline__ void p0_weights(const WInfo& W, LAS unsigned char* lds, const float* const* in, unsigned char* ws, int it_lo, int it_hi) {
    for (int it = it_lo + W.gw; it < it_hi; it += W.NGW) weight_item(W, lds, in, ws, it);
}
__device__ __forceinline__ void lnvec_block(const WInfo& W, LAS unsigned char* lds, const float* const* in, unsigned char* ws, int blk) {
    LAS float* red = (LAS float*)lds;
    float* SV = (float*)(ws + WS_LNV); float* CV = SV + 8704; float* SC = SV + 17408;
    {
        const bool ffn = blk < 88, plain = blk >= 136; const int n = (ffn ? blk : plain ? blk - 136 : blk - 88) * 64 + W.lane;
        const float* src; int Nsrc, col; const float* gk; const float* bk;
        if (ffn) { const int q = n >> 8, rr = n & 255; src = rr < 128 ? in[18] : in[19]; Nsrc = FF; col = q * 128 + (rr & 127); gk = in[16]; bk = in[17]; }
        else if (plain) { src = in[2]; Nsrc = NZ; col = n; gk = in[16]; bk = in[17]; }
        else { src = in[23]; Nsrc = 3072; col = n; if (n >= 1024) { const int q = (n - 1024) >> 8, rr = (n - 1024) & 255; col = (rr < 128 ? 1024 : 2048) + q * 128 + (rr & 127); } gk = in[21]; bk = in[22]; }
        const int o = (ffn ? 0 : 5632) + n;
        {
            const float* p = src + (size_t)(W.wave * 128) * Nsrc + col; const float* gw = gk + W.wave * 128; const float* bw = bk + W.wave * 128;
            float am = 0.f, c = 0.f;
#pragma unroll 1
            for (int j = 0; j < 2; ++j) { float v[64];
#pragma unroll
                for (int i = 0; i < 64; ++i) v[i] = p[(size_t)(j * 64 + i) * Nsrc];
                asm volatile("" ::: "memory");
#pragma unroll
                for (int i = 0; i < 64; ++i) { am = fmaxf(am, fabsf(v[i] * (plain ? 1.0f : gw[j * 64 + i]))); c += v[i] * bw[j * 64 + i]; } }
            __syncthreads();
            red[(W.wave * 64 + W.lane) * 2] = am; red[(W.wave * 64 + W.lane) * 2 + 1] = c;
            __syncthreads();
            float amax = 0.f, cc = 0.f;
#pragma unroll
            for (int w8 = 0; w8 < 8; ++w8) { amax = fmaxf(amax, red[(w8 * 64 + W.lane) * 2]); cc += red[(w8 * 64 + W.lane) * 2 + 1]; }
            const float sn = amax > 0.f ? amax * (1.0f / 127.0f) : 1.0f, inv = 1.0f / sn;
            __syncthreads();
            int isum = 0;
            unsigned char* dst = ws + (ffn ? WS_WFGU : plain ? WS_WIN0 : WS_WIN1) + (size_t)n * 1024 + W.wave * 128;
#pragma unroll 1
            for (int j = 0; j < 4; ++j) { float v[32];
#pragma unroll
                for (int i = 0; i < 32; ++i) v[i] = p[(size_t)(j * 32 + i) * Nsrc];
                asm volatile("" ::: "memory");
#pragma unroll
                for (int i = 0; i < 32; ++i) v[i] *= (plain ? 1.0f : gw[j * 32 + i]);
#pragma unroll
                for (int hh = 0; hh < 2; ++hh) { v4u ov;
#pragma unroll
                    for (int d = 0; d < 4; ++d) { int q[4];
#pragma unroll
                        for (int e = 0; e < 4; ++e) { q[e] = (int)__builtin_rintf(v[16 * hh + 4 * d + e] * inv); isum += q[e]; }
                        ov[d] = pg8::pack4_lo8((unsigned)q[0], (unsigned)q[1], (unsigned)q[2], (unsigned)q[3]); }
                    *(v4u*)(dst + j * 32 + hh * 16) = ov; } }
            red[W.wave * 64 + W.lane] = (float)isum;
            __syncthreads();
            if (W.wave == 0) { float tot = 0.f;
#pragma unroll
                for (int w8 = 0; w8 < 8; ++w8) tot += red[w8 * 64 + W.lane];
                const float cf = ffn ? ((n & 255) < 128 ? pg8::SW_TG : pg8::SW_TU) : 1.0f;
                if (plain) SV[26112 + n] = sn; else { SC[o] = pg8::Q8_SA * sn * cf; SV[o] = sn * tot * cf; CV[o] = cc * cf; } }
        }
    }
}
__device__ __forceinline__ void p0_xrows(const WInfo& W, const float* const* in, unsigned char* ws, int first, int stride, int end) {
    unsigned char* XQ = ws + WS_XQ; float* XS = (float*)(ws + WS_XS); bf16* XBp = (bf16*)(ws + WS_B0);
    for (int m = first; m < end; m += 2 * stride) { const bool has2 = m + stride < end; const int mm[2] = {m, has2 ? m + stride : m};
        f32x4 a[2][4];
#pragma unroll
        for (int r = 0; r < 2; ++r)
#pragma unroll
            for (int j = 0; j < 4; ++j) a[r][j] = *(const f32x4*)(in[0] + (size_t)mm[r] * D_ + 16 * W.lane + 4 * j);
        asm volatile("" ::: "memory");
#pragma unroll
        for (int r = 0; r < 2; ++r) { float am = 0.f;
#pragma unroll
            for (int j = 0; j < 4; ++j) am = fmaxf(fmaxf(am, fmaxf(fabsf(a[r][j][0]), fabsf(a[r][j][1]))), fmaxf(fabsf(a[r][j][2]), fabsf(a[r][j][3])));
#pragma unroll
            for (int o = 1; o < 64; o <<= 1) am = fmaxf(am, __shfl_xor(am, o));
            const float sc = am > 0.f ? am * (1.0f / 127.0f) : 1.0f, inv = 1.0f / sc;
            v4u q, b0, b1;
#pragma unroll
            for (int j = 0; j < 4; ++j) q[j] = pg8::pack4_lo8((unsigned)(int)__builtin_rintf(a[r][j][0] * inv), (unsigned)(int)__builtin_rintf(a[r][j][1] * inv), (unsigned)(int)__builtin_rintf(a[r][j][2] * inv), (unsigned)(int)__builtin_rintf(a[r][j][3] * inv));
            b0.x = pk2(a[r][0][0], a[r][0][1]); b0.y = pk2(a[r][0][2], a[r][0][3]); b0.z = pk2(a[r][1][0], a[r][1][1]); b0.w = pk2(a[r][1][2], a[r][1][3]);
            b1.x = pk2(a[r][2][0], a[r][2][1]); b1.y = pk2(a[r][2][2], a[r][2][3]); b1.z = pk2(a[r][3][0], a[r][3][1]); b1.w = pk2(a[r][3][2], a[r][3][3]);
            if (r == 0 || has2) { bf16* xb = XBp + (size_t)mm[r] * D_ + 16 * W.lane; *(v4u*)xb = b0; *(v4u*)(xb + 8) = b1;
                *(v4u*)(XQ + (size_t)mm[r] * D_ + 16 * W.lane) = q;
                if (W.lane == 0) XS[mm[r]] = sc; } } }
}
__device__ __forceinline__ void p0_prologue(const WInfo& W, LAS unsigned char* lds, const float* const* in, unsigned char* ws) {
    if (blockIdx.x < 40) lnvec_block(W, lds, in, ws, 136 + (int)blockIdx.x);
    __syncthreads();
    const size_t gtid = (size_t)W.gw * 64 + W.lane, NT = (size_t)W.NGW * 64;
    { bf16* WL = (bf16*)(ws + WS_WLORA);
      for (size_t i = gtid; i < (size_t)1536 * 256; i += NT) { const int n = (int)(i >> 8), k = (int)(i & 255), s = n >> 9, ch = n & 511; float v = 0.f;
          if (s == 0) { if (k < 64) v = in[6][k * 512 + ch]; } else if (s == 1) { if (k >= 64 && k < 128) v = in[8][(k - 64) * 512 + ch]; } else { if (k >= 128) v = in[9][(k - 128) * 512 + ch]; }
          WL[i] = (bf16)f2bf(v); } }
    { constexpr int NWW = 40, RPW = 17; const int bx = (int)blockIdx.x, R0 = (W.G - NWW) * 8 * RPW;
      if (W.G > NWW && R0 <= T_) { if (bx >= NWW) p0_xrows(W, in, ws, (bx - NWW) * 8 + W.wave, (W.G - NWW) * 8, R0); else p0_xrows(W, in, ws, R0 + bx * 8 + W.wave, NWW * 8, T_); }
      else p0_xrows(W, in, ws, W.gw, W.NGW, T_); }
    { int* pm = (int*)(ws + WS_PERM); for (size_t i = gtid; i < (size_t)2 * PERMLEN; i += NT) pm[i] = -1; }
}

__device__ __forceinline__ void deferred_work(const WInfo& W, LAS unsigned char* lds, const float* const* in, unsigned char* ws, unsigned* qctr) {
    constexpr int ITEM0 = NITEMS_MOE + I_WIN0, NCH = (NITEMS - ITEM0 + 7) / 8;
    LAS int* qsh = (LAS int*)(lds + RING_BYTES);
    for (;;) {
        __syncthreads();
        if (W.tid == 0) qsh[0] = (int)__hip_atomic_fetch_add(qctr, 1u, __ATOMIC_RELAXED, __HIP_MEMORY_SCOPE_AGENT);
        __syncthreads();
        const int q = qsh[0]; if (q >= 136 + NCH) break;
        if (q < 136) lnvec_block(W, lds, in, ws, q);
        else { const int it = ITEM0 + (q - 136) * 8 + W.wave; if (it < NITEMS) weight_item(W, lds, in, ws, it); }
    }
}
#define MFMA32(a, b, c) __builtin_amdgcn_mfma_f32_32x32x16_bf16((a), (b), (c), 0, 0, 0)
__device__ __forceinline__ void attn_phase(const WInfo& W, LAS unsigned char* lds, const bf16* Z, bf16* MIX, const float* sinks, const float* relb, unsigned* qctr) {
    LAS bf16* Ks = (LAS bf16*)lds;
    LAS bf16* Vt = (LAS bf16*)(lds + 36864);
    LAS float* BT = (LAS float*)(lds + 36864 + 33280);
    const int tid = W.tid, lane = W.lane, w = W.wave, r32 = lane & 31, hh = lane >> 5;
    LAS float* BB = (LAS float*)(lds + 36864 + 33280 + 16 * 388 * 4);
    for (int i = tid; i < 1024; i += 512) { const int hq = i >> 7, dist = i & 127; int bucket = dist;
        if (dist >= 16) { const float lr = logf((float)dist / 16.0f) / 2.0794415416798357f; bucket = 16 + (int)(lr * 16.0f); if (bucket > 31) bucket = 31; }
        BB[i] = relb[bucket * 8 + hq] * LOG2E; }
    int last_kvh = -1;
    LAS int* qsh = (LAS int*)(lds + RING_BYTES);
    if (tid == 0) qsh[0] = (int)__hip_atomic_fetch_add(qctr, 1u, __ATOMIC_RELAXED, __HIP_MEMORY_SCOPE_AGENT);
    for (;;) {
        __syncthreads();
        const int u = qsh[0];
        __syncthreads();
        if (u >= 512) break;
        if (tid == 0) qsh[0] = (int)__hip_atomic_fetch_add(qctr, 1u, __ATOMIC_RELAXED, __HIP_MEMORY_SCOPE_AGENT);
        const int b = u >> 6, kvh = (u >> 5) & 1, nb = u & 31;
        if (kvh != last_kvh) { last_kvh = kvh;
            for (int i = tid; i < 16 * 388; i += 512) { const int k = i / (4 * 388), g = (i / 388) & 3, y = i % 388, x = y + k - 128;
                BT[i] = (x >= 1 && x <= 128) ? BB[(kvh * 4 + g) * 128 + (128 - x)] : 0.f; } }
        { const int key = tid >> 1, half = tid & 1, s = nb * 128 - 128 + key;
          v4u kq[4], vq[4];
          if (s >= 0) { const bf16* zr = Z + (size_t)(b * SEQ + s) * NZ;
#pragma unroll
              for (int j = 0; j < 4; ++j) { kq[j] = *(const v4u*)(zr + 512 + kvh * 64 + half * 32 + 8 * j); vq[j] = *(const v4u*)(zr + 640 + kvh * 64 + half * 32 + 8 * j); } }
          else {
#pragma unroll
              for (int j = 0; j < 4; ++j) { kq[j] = (v4u){0u, 0u, 0u, 0u}; vq[j] = (v4u){0u, 0u, 0u, 0u}; } }
#pragma unroll
          for (int j = 0; j < 4; ++j) { *(LAS v4u*)(Ks + key * 72 + half * 32 + 8 * j) = kq[j];
#pragma unroll
              for (int e = 0; e < 4; ++e) { const unsigned wv = vq[j][e]; const int d = half * 32 + 8 * j + 2 * e; Vt[d * 260 + key] = (bf16)(wv & 0xffffu); Vt[(d + 1) * 260 + key] = (bf16)(wv >> 16); } } }
        __syncthreads();
        const int g = w >> 1, rh = w & 1, habs = kvh * 4 + g;
        bf16x8 qf[2][4]; int qi[2]; size_t mq[2];
#pragma unroll
        for (int qt = 0; qt < 2; ++qt) { qi[qt] = 64 * rh + 32 * qt + r32; mq[qt] = (size_t)(b * SEQ + nb * 128 + qi[qt]);
#pragma unroll
            for (int s = 0; s < 4; ++s) qf[qt][s] = *(const bf16x8*)(Z + mq[qt] * NZ + habs * 64 + 16 * s + 8 * hh); }
        const float sinkl = sinks[habs] * LOG2E;
        float mrun[2] = {sinkl, sinkl}, lsum[2] = {hh == 0 ? 1.f : 0.f, hh == 0 ? 1.f : 0.f};
        f32x16 ot[2][2];
#pragma unroll
        for (int a = 0; a < 2; ++a)
#pragma unroll
            for (int c = 0; c < 2; ++c)
#pragma unroll
                for (int i = 0; i < 16; ++i) ot[a][c][i] = 0.f;
        for (int ks = 2 * rh; ks < 2 * rh + 6; ++ks) {
            bool act[2], full[2];
#pragma unroll
            for (int qt = 0; qt < 2; ++qt) { const int q0 = 64 * rh + 32 * qt, q1 = q0 + 31, k0 = 32 * ks, k1 = k0 + 31;
                act[qt] = (k1 - q0 >= 1) && (k0 - q1 <= 128) && (nb > 0 || k1 >= 128);
                full[qt] = (k0 - q1 >= 1) && (k1 - q0 <= 128) && (nb > 0 || k0 >= 128); }
            if (!act[0] && !act[1]) continue;
            f32x16 sc[2];
#pragma unroll
            for (int qt = 0; qt < 2; ++qt)
#pragma unroll
                for (int i = 0; i < 16; ++i) sc[qt][i] = 0.f;
#pragma unroll
            for (int s = 0; s < 4; ++s) { const bf16x8 kf = *(const LAS bf16x8*)(Ks + (32 * ks + r32) * 72 + 16 * s + 8 * hh);
                if (act[0]) sc[0] = MFMA32(kf, qf[0][s], sc[0]); if (act[1]) sc[1] = MFMA32(kf, qf[1][s], sc[1]); }
            bf16x8 pf[2][2];
#pragma unroll
            for (int qt = 0; qt < 2; ++qt) if (act[qt]) {
                float mx = -1e30f;
#pragma unroll
                for (int c = 0; c < 4; ++c) { const int kbase = 32 * ks + 8 * c + 4 * hh, xbase = kbase - qi[qt], X = xbase + 128, kk = X & 3, y = X - kk;
                    const f32x4 b4 = *(const LAS f32x4*)(BT + (kk * 4 + g) * 388 + y);
                    if (full[qt]) {
#pragma unroll
                        for (int j = 0; j < 4; ++j) { const float t = sc[qt][4 * c + j] * (0.125f * LOG2E) + b4[j]; sc[qt][4 * c + j] = t; mx = fmaxf(mx, t); }
                    } else {
#pragma unroll
                        for (int j = 0; j < 4; ++j) { const int x = xbase + j; const bool valid = (x >= 1) && (x <= 128) && (nb > 0 || kbase + j >= 128);
                            const float t = valid ? (sc[qt][4 * c + j] * (0.125f * LOG2E) + b4[j]) : -1e30f; sc[qt][4 * c + j] = t; mx = fmaxf(mx, t); } } }
                mx = fmaxf(mx, __shfl_xor(mx, 32));
                const float mnew = fmaxf(mrun[qt], mx), corr = __builtin_amdgcn_exp2f(mrun[qt] - mnew); mrun[qt] = mnew;
                float ps = 0.f;
#pragma unroll
                for (int i = 0; i < 16; ++i) { const float p = __builtin_amdgcn_exp2f(sc[qt][i] - mnew); sc[qt][i] = p; ps += p; }
                lsum[qt] = lsum[qt] * corr + ps;
#pragma unroll
                for (int dt = 0; dt < 2; ++dt)
#pragma unroll
                    for (int i = 0; i < 16; ++i) ot[dt][qt][i] *= corr;
#pragma unroll
                for (int s2 = 0; s2 < 2; ++s2) { v4u pk;
#pragma unroll
                    for (int e = 0; e < 4; ++e) pk[e] = pk2(sc[qt][8 * s2 + 2 * e], sc[qt][8 * s2 + 2 * e + 1]);
                    pf[qt][s2] = __builtin_bit_cast(bf16x8, pk); } }
#pragma unroll
            for (int dt = 0; dt < 2; ++dt)
#pragma unroll
                for (int s2 = 0; s2 < 2; ++s2) { const int kb0 = 32 * ks + 16 * s2, d = 32 * dt + r32;
                    const s16x4 lo = *(const LAS s16x4*)(Vt + d * 260 + kb0 + 4 * hh), hi = *(const LAS s16x4*)(Vt + d * 260 + kb0 + 8 + 4 * hh);
                    const bf16x8 vf = __builtin_shufflevector(lo, hi, 0, 1, 2, 3, 4, 5, 6, 7);
                    if (act[0]) ot[dt][0] = MFMA32(vf, pf[0][s2], ot[dt][0]); if (act[1]) ot[dt][1] = MFMA32(vf, pf[1][s2], ot[dt][1]); }
        }
#pragma unroll
        for (int qt = 0; qt < 2; ++qt) { const float lt = lsum[qt] + __shfl_xor(lsum[qt], 32), inv = 1.0f / lt;
#pragma unroll
            for (int dt = 0; dt < 2; ++dt)
#pragma unroll
                for (int c = 0; c < 4; ++c) { const int d0 = 32 * dt + 8 * c + 4 * hh; v2u o; o.x = pk2(ot[dt][qt][4 * c] * inv, ot[dt][qt][4 * c + 1] * inv); o.y = pk2(ot[dt][qt][4 * c + 2] * inv, ot[dt][qt][4 * c + 3] * inv);
                    *(v2u*)(MIX + mq[qt] * D_ + habs * 64 + d0) = o; } }
    }
}

__device__ __forceinline__ void aprime_phase(const WInfo& W, const bf16* Z, bf16* AP, const float* mu) {
    const int c = 4 * W.lane;
    const f32x4 m4 = *(const f32x4*)(mu + 1536 + c);
    for (int mb = W.gw; mb < T_; mb += 16 * W.NGW) {
        v2u zc[16], zp[16];
#pragma unroll
        for (int k = 0; k < 16; ++k) { const int m = mb + k * W.NGW; zc[k] = (v2u){0u, 0u}; zp[k] = (v2u){0u, 0u};
            if (m < T_) { zc[k] = *(const v2u*)(Z + (size_t)m * NZ + 2304 + c); if ((m & (SEQ - 1)) != 0) zp[k] = *(const v2u*)(Z + (size_t)(m - 1) * NZ + 2304 + c); } }
#pragma unroll
        for (int k = 0; k < 16; ++k) { const int m = mb + k * W.NGW; if (m >= T_) break;
            float z[4] = {bflo(zc[k].x), bfhi(zc[k].x), bflo(zc[k].y), bfhi(zc[k].y)}, p[4] = {bflo(zp[k].x), bfhi(zp[k].x), bflo(zp[k].y), bfhi(zp[k].y)}, o[4];
#pragma unroll
            for (int j = 0; j < 4; ++j) { const float v = z[j] + (p[j] - z[j]) * m4[j]; const float e = __expf(c < 64 ? -2.0f * v : -v), r = __builtin_amdgcn_rcpf(1.0f + e);
                o[j] = c < 64 ? (2.0f * r - 1.0f) : (c < 128 ? v : r); }
            v2u w; w.x = pk2(o[0], o[1]); w.y = pk2(o[2], o[3]); *(v2u*)(AP + (size_t)m * 256 + c) = w; }
    }
}

constexpr int SL_W = 0, SL_R = 2048, SL_BKT = 4096, SL_ARBK = 8192, SL_M1 = 9216, SL_PC = 9728, SLOT_BYTES = 10240;
static_assert(WS_SLOT + (size_t)64 * 256 * SLOT_BYTES <= WS_B0, "slots end below the activation buffers");
#define MFMA16(a, b, c) __builtin_amdgcn_mfma_f32_16x16x32_bf16((a), (b), (c), 0, 0, 0)
__device__ __forceinline__ bf16x8 mk8(v2u lo, v2u hi) { v4u q; q.x = lo.x; q.y = lo.y; q.z = hi.x; q.w = hi.y; return __builtin_bit_cast(bf16x8, q); }
struct S1In { unsigned short zr[17], zk[17], av[16], wl[16]; };
__device__ __forceinline__ void s1_load(S1In& o, int unit, int lane, const bf16* Z, const bf16* WLOG, const bf16* AB) {
    const int c = 255 - (unit >> 6), bh = unit & 63, h = bh & 7, b = bh >> 3, chn = h * 64 + lane; const size_t m0 = (size_t)b * SEQ + c * 16;
    const bf16* zp = Z + (m0 - (c > 0 ? 1 : 0)) * NZ + 768 + chn; o.zr[0] = zp[0]; o.zk[0] = zp[512];
#pragma unroll
    for (int t = 0; t < 16; ++t) { const bf16* zc = Z + (m0 + t) * NZ + 768 + chn; o.zr[1 + t] = zc[0]; o.zk[1 + t] = zc[512]; o.wl[t] = WLOG[(m0 + t) * 512 + chn]; o.av[t] = AB[(m0 + t) * 512 + chn]; }
}
__device__ __forceinline__ void scan_prep_phase(const WInfo& W, LAS unsigned char* lds, const bf16* Z, const bf16* WLOG, const bf16* AB, unsigned char* slots, float* bonus,
                                                const float* mu, const float* k_k, const float* k_a, const float* r_k) {
    LAS unsigned char* sc = lds + W.wave * 16384;
    LAS bf16* RT = (LAS bf16*)sc; LAS bf16* AT = (LAS bf16*)(sc + 2304); LAS bf16* BT = (LAS bf16*)(sc + 4608); LAS bf16* KT = (LAS bf16*)(sc + 6912);
    LAS bf16* ATT = (LAS bf16*)(sc + 9216);
    LAS float* AAB = (LAS float*)(sc + 11264);
    LAS bf16* M1x = (LAS bf16*)(sc + 11264);
    LAS bf16* TT = (LAS bf16*)(sc + 12288);
    LAS bf16* WW = (LAS bf16*)(sc + 12800);
    LAS bf16* ARx = (LAS bf16*)(sc + 15104);
    const int lane = W.lane, fr = lane & 15, g = lane >> 4;
    S1In cur, nxt;
    if (W.gw < 64 * 256) s1_load(nxt, W.gw, lane, Z, WLOG, AB);
    for (int unit = W.gw; unit < 64 * 256; unit += W.NGW) {
        const int c = 255 - (unit >> 6), bh = unit & 63, h = bh & 7, b = bh >> 3;
        const int chn = h * 64 + lane; const size_t m0 = (size_t)b * SEQ + c * 16;
        unsigned char* slot = slots + (size_t)(c * 64 + bh) * SLOT_BYTES;
        const float mu_r = mu[chn], mu_k = mu[512 + chn], kkc = k_k[chn], kac = k_a[chn], rkc = r_k[chn];
        cur = nxt;
        if (unit + W.NGW < 64 * 256) s1_load(nxt, unit + W.NGW, lane, Z, WLOG, AB);
        float pr = (c > 0) ? bf2f(cur.zr[0]) : 0.f, pk = (c > 0) ? bf2f(cur.zk[0]) : 0.f;
        float lw = 0.f, Pprev = 1.f, bsave = 0.f, Pt = 1.f;
        unsigned apk[8], bpk[8], kpk[8]; float ah = 0.f, bh2 = 0.f, kh = 0.f;
#pragma unroll
        for (int t = 0; t < 16; ++t) {
            const float zr = bf2f(cur.zr[1 + t]), zk = bf2f(cur.zk[1 + t]); const float wl = bf2f(cur.wl[t]), av = bf2f(cur.av[t]);
            const float r = zr + (pr - zr) * mu_r, kz = zk + (pk - zk) * mu_k; pr = zr; pk = zk;
            float kk = kz * kkc; const float nrm = sqrtf(wave_sum_fast(kk * kk)); kk = kk * __builtin_amdgcn_rcpf(fmaxf(nrm, 1e-12f));
            const float k2 = kz * (1.0f + (av - 1.0f) * kac);
            const float bo = wave_sum_fast(r * k2 * rkc); if (lane == t) bsave = bo;
            lw += wl; Pt = __expf(lw); const float iP = __expf(-lw);
            const float rt = r * Pt, kt = k2 * iP, at = -kk * Pprev, bt = kk * av * iP; Pprev = Pt;
            { const unsigned ra = pk2(rt, at), bk = pk2(bt, kt); RT[t * 72 + lane] = (bf16)(ra & 0xffffu); AT[t * 72 + lane] = (bf16)(ra >> 16); BT[t * 72 + lane] = (bf16)(bk & 0xffffu); KT[t * 72 + lane] = (bf16)(bk >> 16); }
            if (t & 1) { apk[t >> 1] = pk2(ah, at); bpk[t >> 1] = pk2(bh2, bt); kpk[t >> 1] = pk2(kh, kt); } else { ah = at; bh2 = bt; kh = kt; }
        }
        *(LAS v4u*)(ATT + lane * 16) = (v4u){apk[0], apk[1], apk[2], apk[3]}; *(LAS v4u*)(ATT + lane * 16 + 8) = (v4u){apk[4], apk[5], apk[6], apk[7]};
#pragma unroll
        for (int gg = 0; gg < 4; ++gg) *(v4u*)(slot + SL_BKT + ((lane >> 4) * 64 + gg * 16 + (lane & 15)) * 16) = (v4u){bpk[2 * gg], bpk[2 * gg + 1], kpk[2 * gg], kpk[2 * gg + 1]};
        *(float*)(slot + SL_PC + lane * 4) = Pt;
        if (lane < 16) bonus[(m0 + lane) * 8 + h] = bsave;
        LDS_WAIT(); asm volatile("" ::: "memory");
        f32x4 Aab = (f32x4){0.f, 0.f, 0.f, 0.f}, Aak = Aab, Arb = Aab, Ark = Aab;
#pragma unroll
        for (int s = 0; s < 2; ++s) { const int o = fr * 72 + 32 * s + 8 * g;
            const bf16x8 af = *(const LAS bf16x8*)(AT + o), rf = *(const LAS bf16x8*)(RT + o), bb = *(const LAS bf16x8*)(BT + o), kb = *(const LAS bf16x8*)(KT + o);
            Aab = MFMA16(af, bb, Aab); Aak = MFMA16(af, kb, Aak); Arb = MFMA16(rf, bb, Arb); Ark = MFMA16(rf, kb, Ark); }
#pragma unroll
        for (int rg = 0; rg < 4; ++rg) { const int t = 4 * g + rg; const bool lo = fr < t, le = fr <= t;
            Aab[rg] = lo ? Aab[rg] : 0.f; Aak[rg] = lo ? Aak[rg] : 0.f; Arb[rg] = le ? Arb[rg] : 0.f; Ark[rg] = le ? Ark[rg] : 0.f;
            AAB[t * 16 + fr] = Aab[rg]; { const unsigned rk = pk2(Arb[rg], Ark[rg]); ARx[t * 16 + fr] = (bf16)(rk & 0xffffu); ARx[256 + t * 16 + fr] = (bf16)(rk >> 16); } }
        LDS_WAIT(); asm volatile("" ::: "memory");
        float Tc[16];
#pragma unroll
        for (int t = 0; t < 16; ++t) { float acc = (t == fr) ? 1.f : 0.f;
#pragma unroll
            for (int q4 = 0; q4 < (t + 3) / 4; ++q4) { const f32x4 a4 = *(const LAS f32x4*)(AAB + t * 16 + 4 * q4);
#pragma unroll
                for (int e = 0; e < 4; ++e) if (4 * q4 + e < t) acc += a4[e] * Tc[4 * q4 + e]; }
            Tc[t] = acc; }
#pragma unroll
        for (int t = 0; t < 16; t += 2) { const unsigned tt = pk2(Tc[t], Tc[t + 1]); TT[t * 16 + fr] = (bf16)(tt & 0xffffu); TT[(t + 1) * 16 + fr] = (bf16)(tt >> 16); }
        LDS_WAIT(); asm volatile("" ::: "memory");
        const v2u z2 = (v2u){0u, 0u};
        const bf16x8 Tf = mk8(*(const LAS v2u*)(TT + fr * 16 + 4 * g), z2);
        { v2u ak; ak.x = pk2(Aak[0], Aak[1]); ak.y = pk2(Aak[2], Aak[3]);
          const f32x4 M1 = MFMA16(Tf, mk8(ak, z2), ((f32x4){0.f, 0.f, 0.f, 0.f}));
          f32x4 Wt[4];
#pragma unroll
          for (int jt = 0; jt < 4; ++jt) Wt[jt] = MFMA16(Tf, mk8(*(const LAS v2u*)(ATT + (16 * jt + fr) * 16 + 4 * g), z2), ((f32x4){0.f, 0.f, 0.f, 0.f}));
#pragma unroll
          for (int rg = 0; rg < 4; ++rg) { const int t = 4 * g + rg; const unsigned w01 = pk2(Wt[0][rg], Wt[1][rg]), w23 = pk2(Wt[2][rg], Wt[3][rg]), m1 = pk2(M1[rg], 0.f); M1x[t * 16 + fr] = (bf16)(m1 & 0xffffu);
              WW[t * 72 + fr] = (bf16)(w01 & 0xffffu); WW[t * 72 + 16 + fr] = (bf16)(w01 >> 16); WW[t * 72 + 32 + fr] = (bf16)(w23 & 0xffffu); WW[t * 72 + 48 + fr] = (bf16)(w23 >> 16); } }
        LDS_WAIT(); asm volatile("" ::: "memory");
#pragma unroll
        for (int s = 0; s < 2; ++s) { const int o = fr * 72 + 32 * s + 4 * g;
            const v2u w0 = *(const LAS v2u*)(WW + o), w1 = *(const LAS v2u*)(WW + o + 16), r0 = *(const LAS v2u*)(RT + o), r1 = *(const LAS v2u*)(RT + o + 16);
            *(v4u*)(slot + SL_W + (s * 64 + lane) * 16) = (v4u){w0.x, w0.y, w1.x, w1.y}; *(v4u*)(slot + SL_R + (s * 64 + lane) * 16) = (v4u){r0.x, r0.y, r1.x, r1.y}; }
        { const v2u x0 = *(const LAS v2u*)(ARx + fr * 16 + 4 * g), x1 = *(const LAS v2u*)(ARx + 256 + fr * 16 + 4 * g), m1 = *(const LAS v2u*)(M1x + fr * 16 + 4 * g);
          *(v4u*)(slot + SL_ARBK + lane * 16) = (v4u){x0.x, x0.y, x1.x, x1.y}; *(v2u*)(slot + SL_M1 + lane * 8) = m1; }
        LDS_WAIT(); asm volatile("" ::: "memory");
    }
}
__device__ __forceinline__ void glds16(const void* gsrc, unsigned lds_dst) { unsigned keep;
    asm volatile("s_mov_b32 %0, m0\n\ts_mov_b32 m0, %2\n\ts_nop 0\n\tglobal_load_lds_dwordx4 %1, off\n\ts_mov_b32 m0, %0" : "=&s"(keep) : "v"(gsrc), "s"(lds_dst) : "memory"); }
struct ScanOps { bf16x8 Wf[2], Rf[2], Bk[4], ARBK; v2u M1; f32x4 PC[4]; unsigned vz[5]; unsigned pad; };
constexpr int S2_NS = 12, S2_D = 11, S2_VST = 2048;
__device__ __forceinline__ void scan_lds_load(ScanOps& o, const LAS unsigned char* st, const LAS unsigned char* vs, const LAS unsigned char* vprev, int lane, int g, int icol) {
#pragma unroll
    for (int s = 0; s < 2; ++s) { o.Wf[s] = *(const LAS bf16x8*)(st + SL_W + (s * 64 + lane) * 16); o.Rf[s] = *(const LAS bf16x8*)(st + SL_R + (s * 64 + lane) * 16); }
#pragma unroll
    for (int jt = 0; jt < 4; ++jt) { o.Bk[jt] = *(const LAS bf16x8*)(st + SL_BKT + (jt * 64 + lane) * 16); o.PC[jt] = *(const LAS f32x4*)(st + SL_PC + (16 * jt + 4 * g) * 4); }
    o.ARBK = *(const LAS bf16x8*)(st + SL_ARBK + lane * 16); o.M1 = *(const LAS v2u*)(st + SL_M1 + lane * 8);
    o.vz[0] = (unsigned)*(const LAS unsigned short*)((g == 0 ? vprev + 15 * 128 : vs + (4 * g - 1) * 128) + icol * 2);
#pragma unroll
    for (int j = 0; j < 4; ++j) o.vz[1 + j] = (unsigned)*(const LAS unsigned short*)(vs + (4 * g + j) * 128 + icol * 2);
    o.pad = 0u;
}
__device__ __forceinline__ void scan_issue(int cc, int lw, int lane, const unsigned char* sbase, const bf16* zvh, LAS unsigned char* ring, LAS unsigned char* vring) {
    const unsigned char* slot = sbase + (size_t)cc * 64 * SLOT_BYTES; LAS unsigned char* st = ring + (cc % S2_NS) * 10240; LAS unsigned char* vs = vring + (cc % S2_NS) * S2_VST;
#pragma unroll
    for (int k = 0; k < 3; ++k) { const int p = lw + 4 * k; if (p < 10) glds16(slot + p * 1024 + lane * 16, (unsigned)(size_t)(st + p * 1024)); }
    if (lw >= 2) { const int blk = lw - 2; const int r = cc * 16 + blk * 8 + (lane >> 3);
        glds16((const unsigned char*)(zvh + (size_t)r * NZ) + (lane & 7) * 16, (unsigned)(size_t)(vs + blk * 1024)); }
}
__device__ __forceinline__ void scan_seq_phase(const WInfo& W, LAS unsigned char* lds, const bf16* Z, const unsigned char* slots, bf16* YRAW, const float* mu, unsigned* prog) {
    const int id = blockIdx.x; if (id >= 64) return;
    const int lane = W.lane, fr = lane & 15, g = lane >> 4, w = W.wave;
    const int b = id >> 3, h = id & 7;
    LAS unsigned char* ring = lds; LAS unsigned char* vring = lds + S2_NS * 10240;
    const unsigned char* sbase = slots + (size_t)id * SLOT_BYTES;
    const bf16* zvh = Z + (size_t)b * SEQ * NZ + 1792 + h * 64;
    const bool loader = w >= 4; const int lw = w - 4;
    const int i = 16 * (w & 3) + fr;
    float mu_v = mu[1024 + h * 64 + i];
    VM_WAIT(); asm volatile("" : "+v"(mu_v));
#define S2_WAIT_AHEAD() asm volatile("s_waitcnt vmcnt(27)" ::: "memory")
    if (loader) { for (int cc = 0; cc < S2_D; ++cc) scan_issue(cc, lw, lane, sbase, zvh, ring, vring); S2_WAIT_AHEAD(); }
    __builtin_amdgcn_s_barrier();
    f32x4 st[4];
#pragma unroll
    for (int jt = 0; jt < 4; ++jt) st[jt] = (f32x4){0.f, 0.f, 0.f, 0.f};
    if (loader) {
        for (int c = 0; c < 256; ++c) {
            if (c + S2_D < 256) { scan_issue(c + S2_D, lw, lane, sbase, zvh, ring, vring); S2_WAIT_AHEAD(); } else asm volatile("s_waitcnt vmcnt(0)" ::: "memory");
            __builtin_amdgcn_s_barrier();
        }
    } else {
        ScanOps opA, opB;
        scan_lds_load(opA, ring, vring, vring, lane, g, i);
        LAS float* ybuf = (LAS float*)(lds + 147456);
        bf16* yo = YRAW + (size_t)b * SEQ * 512 + h * 64 + (size_t)(4 * w + g) * 512 + 4 * fr;
#define S2_STEP(c, CUR, NXT) do { \
            if ((((c) & 3) == 0) && w == 0 && lane == 0) __hip_atomic_store(prog + id, (unsigned)((c) + 2), __ATOMIC_RELAXED, __HIP_MEMORY_SCOPE_AGENT);     \
            if ((c) + 1 < 256) scan_lds_load(NXT, ring + (((c) + 1) % S2_NS) * 10240, vring + (((c) + 1) % S2_NS) * S2_VST, vring + ((c) % S2_NS) * S2_VST, lane, g, i); \
            float vm[4]; const float zprev = ((c) == 0 && g == 0) ? 0.f : bf2f((unsigned short)CUR.vz[0]); \
            _Pragma("unroll") for (int j = 0; j < 4; ++j) { const float zc = bf2f((unsigned short)CUR.vz[1 + j]), zp = (j == 0) ? zprev : bf2f((unsigned short)CUR.vz[j]); vm[j] = zc + (zp - zc) * mu_v; } \
            v2u vb; vb.x = pk2(vm[0], vm[1]); vb.y = pk2(vm[2], vm[3]); const v2u z2 = (v2u){0u, 0u}; bf16x8 Sb[2]; \
            _Pragma("unroll") for (int s = 0; s < 2; ++s) { v2u lo, hi; lo.x = pk2(st[2 * s][0], st[2 * s][1]); lo.y = pk2(st[2 * s][2], st[2 * s][3]); hi.x = pk2(st[2 * s + 1][0], st[2 * s + 1][1]); hi.y = pk2(st[2 * s + 1][2], st[2 * s + 1][3]); Sb[s] = mk8(lo, hi); } \
            f32x4 U = MFMA16(CUR.Wf[0], Sb[0], ((f32x4){0.f, 0.f, 0.f, 0.f})); U = MFMA16(CUR.Wf[1], Sb[1], U); U = MFMA16(mk8(CUR.M1, z2), mk8(vb, z2), U); \
            f32x4 Y = MFMA16(CUR.Rf[0], Sb[0], ((f32x4){0.f, 0.f, 0.f, 0.f})); Y = MFMA16(CUR.Rf[1], Sb[1], Y); \
            v2u ub; ub.x = pk2(U[0], U[1]); ub.y = pk2(U[2], U[3]); const bf16x8 UV = mk8(ub, vb); \
            Y = MFMA16(CUR.ARBK, UV, Y); \
            _Pragma("unroll") for (int jt = 0; jt < 4; ++jt) { const f32x4 a = MFMA16(CUR.Bk[jt], UV, st[jt]); st[jt] = a * CUR.PC[jt]; } \
            if ((c) > 0) { const f32x4 yv = *(const LAS f32x4*)(ybuf + (((c) - 1) & 1) * 1024 + (4 * w + g) * 64 + 4 * fr); v2u yw; yw.x = pk2(yv[0], yv[1]); yw.y = pk2(yv[2], yv[3]); *(v2u*)(yo + (size_t)(((c) - 1) * 16) * 512) = yw; } \
            _Pragma("unroll") for (int rg = 0; rg < 4; ++rg) ybuf[((c) & 1) * 1024 + (4 * g + rg) * 64 + i] = Y[rg]; \
            LDS_WAIT(); \
            __builtin_amdgcn_s_barrier(); } while (0)
        for (int c = 0; c < 256; c += 2) { S2_STEP(c, opA, opB); S2_STEP(c + 1, opB, opA); }
#undef S2_STEP
        { const f32x4 yv = *(const LAS f32x4*)(ybuf + 1024 + (4 * w + g) * 64 + 4 * fr); v2u yw; yw.x = pk2(yv[0], yv[1]); yw.y = pk2(yv[2], yv[3]); *(v2u*)(yo + (size_t)(255 * 16) * 512) = yw; }
        if (w == 0 && lane == 0) __hip_atomic_store(prog + id, 256u, __ATOMIC_RELAXED, __HIP_MEMORY_SCOPE_AGENT);
    }
    VM_WAIT();
    __builtin_amdgcn_s_barrier();
#undef S2_WAIT_AHEAD
}

__device__ __forceinline__ float sum8(float x) { x += dpp_mov<0xB1>(x); x += dpp_mov<0x4E>(x); x += dpp_mov<0x141>(x); return x; }
__device__ __forceinline__ void post_phase(const WInfo& W, const bf16* Z, const bf16* GBUF, const bf16* YRAW, const float* bonus, bf16* MIX,
                                           const float* mu, const float* gn_g, const float* gn_b) {
    const int lane = W.lane, c0 = 8 * lane, h = lane >> 3;
    float muv[8], gg[8], gb[8];
#pragma unroll
    for (int j = 0; j < 8; ++j) { muv[j] = mu[1024 + c0 + j]; gg[j] = gn_g[c0 + j]; gb[j] = gn_b[c0 + j]; }
    for (int mb = W.gw; mb < T_; mb += 4 * W.NGW) {
        v4u zc[4], zp[4], gq[4], yq[4]; float bo[4];
#pragma unroll
        for (int k = 0; k < 4; ++k) { const int m = mb + k * W.NGW; const bool first = (m & (SEQ - 1)) == 0;
            zc[k] = *(const v4u*)(Z + (size_t)m * NZ + 1792 + c0);
            zp[k] = (v4u){0u, 0u, 0u, 0u}; if (!first) zp[k] = *(const v4u*)(Z + (size_t)(m - 1) * NZ + 1792 + c0);
            gq[k] = *(const v4u*)(GBUF + (size_t)m * 512 + c0);
            yq[k] = *(const v4u*)(YRAW + (size_t)m * 512 + c0);
            bo[k] = bonus[(size_t)m * 8 + h]; }
#pragma unroll
        for (int k = 0; k < 4; ++k) { const int m = mb + k * W.NGW;
            float y[8] = {bflo(yq[k].x), bfhi(yq[k].x), bflo(yq[k].y), bfhi(yq[k].y), bflo(yq[k].z), bfhi(yq[k].z), bflo(yq[k].w), bfhi(yq[k].w)};
            float s = 0.f;
#pragma unroll
            for (int j = 0; j < 8; ++j) s += y[j];
            const float mean = sum8(s) * (1.0f / 64.0f); float q = 0.f;
#pragma unroll
            for (int j = 0; j < 8; ++j) { y[j] -= mean; q += y[j] * y[j]; }
            const float rstd = rsqrtf(sum8(q) * (1.0f / 64.0f) + GN_EPS);
            float o[8];
#pragma unroll
            for (int j = 0; j < 8; ++j) { const unsigned zw = zc[k][j >> 1], pw = zp[k][j >> 1], gw2 = gq[k][j >> 1];
                const float zv = (j & 1) ? bfhi(zw) : bflo(zw), pv = (j & 1) ? bfhi(pw) : bflo(pw), gv = (j & 1) ? bfhi(gw2) : bflo(gw2);
                const float v = zv + (pv - zv) * muv[j];
                o[j] = (y[j] * rstd * gg[j] + gb[j] + bo[k] * v) * gv; }
            v4u ov; ov.x = pk2(o[0], o[1]); ov.y = pk2(o[2], o[3]); ov.z = pk2(o[4], o[5]); ov.w = pk2(o[6], o[7]);
            *(v4u*)(MIX + (size_t)m * D_ + 512 + c0) = ov; }
    }
}

__device__ __forceinline__ void ln_compute(f32x4 (&v)[4], const f32x4 (&g)[4], const f32x4 (&bb)[4]) {
    float s = 0.f;
#pragma unroll
    for (int j = 0; j < 4; ++j) s += (v[j][0] + v[j][1]) + (v[j][2] + v[j][3]);
    const float mean = wave_sum_fast(s) * (1.f / D_); float s2 = 0.f;
#pragma unroll
    for (int j = 0; j < 4; ++j) { v[j] = v[j] - mean; s2 += (v[j][0] * v[j][0] + v[j][1] * v[j][1]) + (v[j][2] * v[j][2] + v[j][3] * v[j][3]); }
    const float rstd = rsqrtf(wave_sum_fast(s2) * (1.f / D_) + LN_EPS);
#pragma unroll
    for (int j = 0; j < 4; ++j) v[j] = v[j] * rstd * g[j] + bb[j];
}
__device__ __forceinline__ void ln_phase(const WInfo& W, float* X, bf16* XB, const float* gam, const float* bet, const bf16* ADD = nullptr) {
    f32x4 g[4], bb[4];
#pragma unroll
    for (int j = 0; j < 4; ++j) { g[j] = *(const f32x4*)(gam + 4 * W.lane + 256 * j); bb[j] = *(const f32x4*)(bet + 4 * W.lane + 256 * j); }
    for (int m = W.gw; m < T_; m += 2 * W.NGW) {
        const int m2 = m + W.NGW;
        f32x4* xr = (f32x4*)(X + (size_t)m * D_) + W.lane; f32x4* xr2 = (f32x4*)(X + (size_t)m2 * D_) + W.lane; f32x4 v[4], v2[4]; v2u a[4], a2[4];
#pragma unroll
        for (int j = 0; j < 4; ++j) { v[j] = xr[64 * j]; v2[j] = xr2[64 * j]; }
        if (ADD) { const v2u* ar = (const v2u*)(ADD + (size_t)m * D_) + W.lane; const v2u* ar2 = (const v2u*)(ADD + (size_t)m2 * D_) + W.lane;
#pragma unroll
            for (int j = 0; j < 4; ++j) { a[j] = ar[64 * j]; a2[j] = ar2[64 * j]; }
#pragma unroll
            for (int j = 0; j < 4; ++j) { v[j][0] += bflo(a[j].x); v[j][1] += bfhi(a[j].x); v[j][2] += bflo(a[j].y); v[j][3] += bfhi(a[j].y);
                                          v2[j][0] += bflo(a2[j].x); v2[j][1] += bfhi(a2[j].x); v2[j][2] += bflo(a2[j].y); v2[j][3] += bfhi(a2[j].y); } }
        ln_compute(v, g, bb); ln_compute(v2, g, bb);
#pragma unroll
        for (int j = 0; j < 4; ++j) { xr[64 * j] = v[j]; xr2[64 * j] = v2[j]; }
        if (XB) { v2u* o8 = (v2u*)(XB + (size_t)m * D_) + W.lane; v2u* o82 = (v2u*)(XB + (size_t)m2 * D_) + W.lane;
#pragma unroll
            for (int j = 0; j < 4; ++j) { v2u o; o.x = pk2(v[j][0], v[j][1]); o.y = pk2(v[j][2], v[j][3]); o8[64 * j] = o; o.x = pk2(v2[j][0], v2[j][1]); o.y = pk2(v2[j][2], v2[j][3]); o82[64 * j] = o; } }
    }
}
__device__ __forceinline__ void final_ln_pair(const WInfo& W, float* out, const bf16* Y2, const f32x4 (&g)[4], const f32x4 (&bb)[4], int m, int m2, bool do1, bool do2) {
    const v2u* hr = (const v2u*)((const bf16*)out + (size_t)m * 2048) + W.lane; const v2u* hr2 = (const v2u*)((const bf16*)out + (size_t)m2 * 2048) + W.lane;
    const v2u* yr = (const v2u*)(Y2 + (size_t)m * D_) + W.lane; const v2u* yr2 = (const v2u*)(Y2 + (size_t)m2 * D_) + W.lane;
    v2u h[4], y1[4], y2[4], hB[4], y1B[4], y2B[4];
#pragma unroll
    for (int j = 0; j < 4; ++j) { h[j] = hr[64 * j]; y1[j] = hr[256 + 64 * j]; y2[j] = yr[64 * j]; hB[j] = hr2[64 * j]; y1B[j] = hr2[256 + 64 * j]; y2B[j] = yr2[64 * j]; }
    f32x4 v[4], v2[4];
#pragma unroll
    for (int j = 0; j < 4; ++j) {
        v[j] = (f32x4){bflo(h[j].x) * ALPHA + bflo(y1[j].x) + bflo(y2[j].x), bfhi(h[j].x) * ALPHA + bfhi(y1[j].x) + bfhi(y2[j].x), bflo(h[j].y) * ALPHA + bflo(y1[j].y) + bflo(y2[j].y), bfhi(h[j].y) * ALPHA + bfhi(y1[j].y) + bfhi(y2[j].y)};
        v2[j] = (f32x4){bflo(hB[j].x) * ALPHA + bflo(y1B[j].x) + bflo(y2B[j].x), bfhi(hB[j].x) * ALPHA + bfhi(y1B[j].x) + bfhi(y2B[j].x), bflo(hB[j].y) * ALPHA + bflo(y1B[j].y) + bflo(y2B[j].y), bfhi(hB[j].y) * ALPHA + bfhi(y1B[j].y) + bfhi(y2B[j].y)}; }
    ln_compute(v, g, bb); ln_compute(v2, g, bb);
    f32x4* xr = (f32x4*)(out + (size_t)m * D_) + W.lane; f32x4* xr2 = (f32x4*)(out + (size_t)m2 * D_) + W.lane;
    if (do1) {
#pragma unroll
        for (int j = 0; j < 4; ++j) xr[64 * j] = v[j]; }
    if (do2) {
#pragma unroll
        for (int j = 0; j < 4; ++j) xr2[64 * j] = v2[j]; }
}
__device__ __forceinline__ void final_ln_phase(const WInfo& W, float* out, const bf16* Y2, const float* gam, const float* bet, const int* toke, int v, int V, bool late) {
    f32x4 g[4], bb[4];
#pragma unroll
    for (int j = 0; j < 4; ++j) { g[j] = *(const f32x4*)(gam + 4 * W.lane + 256 * j); bb[j] = *(const f32x4*)(bet + 4 * W.lane + 256 * j); }
    if (v < 0) return;
    const int nrow = (T_ - v + V - 1) / V;
    for (int i0 = 0; i0 < nrow; i0 += 64) {
        const int i = i0 + W.lane; const int fl = i < nrow ? toke[v + i * V] : (late ? 0 : (1 << 16));
        unsigned long long mask = __ballot(i < nrow && (((fl >> 16) & 1) != 0) == late);
        while (mask) { const int r0 = __builtin_ctzll(mask); mask &= mask - 1; const bool two = mask != 0; const int r1 = two ? __builtin_ctzll(mask) : r0; if (two) mask &= mask - 1;
            final_ln_pair(W, out, Y2, g, bb, v + (i0 + r0) * V, v + (i0 + r1) * V, true, two); }
    }
}
__device__ __forceinline__ void ln_router_phase(const WInfo& W, LAS unsigned char* lds, const bf16* Xin, const float* stp, bf16* H3rows, unsigned char* H3f8, const float* gam, const float* bet, const float* rw, int* toke, float* tokp, int* wgcnt) {
    constexpr int RWS = 1032;
    LAS bf16* RWT = (LAS bf16*)lds;
    LAS float* GBL = (LAS float*)(lds + 16640);
    LAS float* LG = (LAS float*)(lds + 24832);
    LAS int* CNT = (LAS int*)(lds + 28928);
    { float rv[16]; float gv[2], bv[2];
#pragma unroll
      for (int k = 0; k < 16; ++k) rv[k] = rw[W.tid + 512 * k];
#pragma unroll
      for (int k = 0; k < 2; ++k) { gv[k] = gam[W.tid + 512 * k]; bv[k] = bet[W.tid + 512 * k]; }
#pragma unroll
      for (int k = 0; k < 16; ++k) { const int idx = W.tid + 512 * k; RWT[(idx & 7) * RWS + (idx >> 3)] = (bf16)f2bf(rv[k]); }
#pragma unroll
      for (int k = 0; k < 2; ++k) { GBL[W.tid + 512 * k] = gv[k]; GBL[1024 + W.tid + 512 * k] = bv[k]; } }
    if (W.tid < 16) CNT[W.tid] = 0;
    __syncthreads();
    const int li = W.lane & 15, kq = W.lane >> 4;
    for (int wg = blockIdx.x; wg < 256; wg += W.G) {
        const int m = wg * 128 + W.wave * 16 + li;
        const bf16* xrow = Xin + (size_t)m * D_ + 16 * kq;
        float mu, rstd; pg8::row_stats(stp, m, mu, rstd);
        f32x4 lacc = (f32x4){0.f, 0.f, 0.f, 0.f};
        bf16* hrow = H3rows + (size_t)m * 2048 + 16 * kq; unsigned char* frow = H3f8 + (size_t)m * D_ + 16 * kq;
        const LAS bf16* rwl = RWT + (li & 7) * RWS + 16 * kq;
        v4u xc[4][2], xn[4][2];
#pragma unroll
        for (int t = 0; t < 4; ++t) { xc[t][0] = *(const v4u*)(xrow + 64 * t); xc[t][1] = *(const v4u*)(xrow + 64 * t + 8); }
#pragma unroll
        for (int sb = 0; sb < 4; ++sb) {
            if (sb < 3) {
#pragma unroll
                for (int t = 0; t < 4; ++t) { xn[t][0] = *(const v4u*)(xrow + 64 * (4 * sb + 4 + t)); xn[t][1] = *(const v4u*)(xrow + 64 * (4 * sb + 4 + t) + 8); } }
            asm volatile("" ::: "memory");
#pragma unroll
            for (int t4 = 0; t4 < 4; ++t4) { const int t = 4 * sb + t4, c0 = 64 * t + 16 * kq;
                float y[16];
#pragma unroll
                for (int h = 0; h < 2; ++h)
#pragma unroll
                    for (int d = 0; d < 4; ++d) { y[8 * h + 2 * d] = bflo(xc[t4][h][d]); y[8 * h + 2 * d + 1] = bfhi(xc[t4][h][d]); }
#pragma unroll
                for (int j4 = 0; j4 < 4; ++j4) { const f32x4 g = *(const LAS f32x4*)(GBL + c0 + 4 * j4), b = *(const LAS f32x4*)(GBL + 1024 + c0 + 4 * j4);
#pragma unroll
                    for (int e = 0; e < 4; ++e) y[4 * j4 + e] = (y[4 * j4 + e] - mu) * rstd * g[e] + b[e]; }
                v4u hb[2];
#pragma unroll
                for (int h = 0; h < 2; ++h) { hb[h].x = pk2(y[8 * h], y[8 * h + 1]); hb[h].y = pk2(y[8 * h + 2], y[8 * h + 3]); hb[h].z = pk2(y[8 * h + 4], y[8 * h + 5]); hb[h].w = pk2(y[8 * h + 6], y[8 * h + 7]); }
                *(v4u*)(hrow + 64 * t) = hb[0]; *(v4u*)(hrow + 64 * t + 8) = hb[1];
                v4u f8; f8.x = pg8::pk4_fp8(y[0], y[1], y[2], y[3]); f8.y = pg8::pk4_fp8(y[4], y[5], y[6], y[7]); f8.z = pg8::pk4_fp8(y[8], y[9], y[10], y[11]); f8.w = pg8::pk4_fp8(y[12], y[13], y[14], y[15]);
                *(v4u*)(frow + 64 * t) = f8;
#pragma unroll
                for (int h = 0; h < 2; ++h) { const bf16x8 bfr = *(const LAS bf16x8*)(rwl + 64 * t + 8 * h);
                    lacc = __builtin_amdgcn_mfma_f32_16x16x32_bf16(__builtin_bit_cast(bf16x8, hb[h]), bfr, lacc, 0, 0, 0); } }
#pragma unroll
            for (int t = 0; t < 4; ++t) { xc[t][0] = xn[t][0]; xc[t][1] = xn[t][1]; } }
        LAS float* lgw = LG + W.wave * 128;
        if (li < 8) {
#pragma unroll
            for (int j = 0; j < 4; ++j) lgw[(4 * kq + j) * 8 + li] = lacc[j]; }
        LDS_WAIT(); asm volatile("" ::: "memory");
        if (W.lane < 16) { const f32x4 l0 = *(const LAS f32x4*)(lgw + W.lane * 8), l1 = *(const LAS f32x4*)(lgw + W.lane * 8 + 4);
            const float lg[8] = {l0[0], l0[1], l0[2], l0[3], l1[0], l1[1], l1[2], l1[3]};
            int e1 = 0; float v1 = lg[0];
#pragma unroll
            for (int e = 1; e < 8; ++e) if (lg[e] > v1) { v1 = lg[e]; e1 = e; }
            int e2 = -1; float v2 = -3.0e38f;
#pragma unroll
            for (int e = 0; e < 8; ++e) if (e != e1 && lg[e] > v2) { v2 = lg[e]; e2 = e; }
            const float p2 = 1.0f / (1.0f + __expf(v1 - v2)), p1 = 1.0f - p2;
            const int mr = wg * 128 + W.wave * 16 + W.lane;
            toke[mr] = e1 | (e2 << 8); *(f32x2*)(tokp + 2 * mr) = (f32x2){p1, p2}; atomicAdd((int*)(CNT + e1), 1); atomicAdd((int*)(CNT + 8 + e2), 1); }
        __syncthreads();
        if (W.tid < 16) { wgcnt[wg * 16 + W.tid] = CNT[W.tid]; CNT[W.tid] = 0; }
        __syncthreads();
    }
}
__device__ __forceinline__ void route_phase(const WInfo& W, LAS unsigned char* lds, int* toke, const float* tokp, const int* wgcnt, int* perm, float* slotp, int* ptab) {
    LAS int* C = (LAS int*)lds;
    LAS int* TOT = (LAS int*)(lds + 16384);
    LAS int* PRE = TOT + 16;
    LAS int* OFF = TOT + 32;
    LAS int* CTR = TOT + 48;
    for (int wg = blockIdx.x; wg < 256; wg += W.G) {
        __syncthreads();
        { int cv[8];
#pragma unroll
          for (int k = 0; k < 8; ++k) cv[k] = wgcnt[W.tid + 512 * k];
#pragma unroll
          for (int k = 0; k < 8; ++k) C[W.tid + 512 * k] = cv[k]; }
        if (W.tid < 16) CTR[W.tid] = 0;
        __syncthreads();
        if (W.tid < 16) { int tot = 0, pre = 0; for (int k = 0; k < 256; ++k) { const int c = C[k * 16 + W.tid]; tot += c; if (k < wg) pre += c; } TOT[W.tid] = tot; PRE[W.tid] = pre; }
        __syncthreads();
        if (W.tid == 0) { int np = 0;
            for (int e = 0; e < 8; ++e) { const int base = np * 256, tot = TOT[e] + TOT[8 + e], pn = (tot + 255) >> 8;
                OFF[e] = base + PRE[e]; OFF[8 + e] = base + TOT[e] + PRE[8 + e];
                if (wg == 0) for (int k = 0; k < pn; ++k) ptab[2 + np + k] = ((np + k) << 8) | e;
                np += pn; }
            if (wg == 0) { ptab[0] = np; ptab[1] = 0; } }
        __syncthreads();
        if (W.tid < 128) { const int m = wg * 128 + W.tid, te = toke[m], e1 = te & 255, e2 = (te >> 8) & 255;
            const int s1 = OFF[e1] + atomicAdd((int*)(CTR + e1), 1); perm[s1] = m; slotp[s1] = tokp[2 * m];
            const int s2 = OFF[8 + e2] + atomicAdd((int*)(CTR + 8 + e2), 1); perm[s2] = m | (1 << 30); slotp[s2] = tokp[2 * m + 1];
            if ((s1 >> 8) >= 256 || (s2 >> 8) >= 256) ((int*)toke)[m] = te | (1 << 16); }
    }
}
__device__ __forceinline__ void conv_phase(const WInfo& W, const bf16* GB, const bf16* UP, bf16* CV, const float* cw) {
    const size_t gtid = (size_t)W.gw * 64 + W.lane, NT = (size_t)W.NGW * 64;
#pragma unroll 8
    for (size_t i = gtid; i < (size_t)T_ * D_ / 8; i += NT) {
        const int m = (int)(i >> 7), c = (int)(i & 127) * 8, t = m & (SEQ - 1);
        const v4u gv = *(const v4u*)(GB + (size_t)m * D_ + c), u2 = *(const v4u*)(UP + (size_t)m * D_ + c);
        v4u u1 = (v4u){0u, 0u, 0u, 0u}, u0 = (v4u){0u, 0u, 0u, 0u};
        if (t >= 1) u1 = *(const v4u*)(UP + (size_t)(m - 1) * D_ + c);
        if (t >= 2) u0 = *(const v4u*)(UP + (size_t)(m - 2) * D_ + c);
        float o[8];
#pragma unroll
        for (int e = 0; e < 4; ++e) {
            const f32x2 w0 = *(const f32x2*)(cw + c + 2 * e), w1 = *(const f32x2*)(cw + 1024 + c + 2 * e), w2 = *(const f32x2*)(cw + 2048 + c + 2 * e);
            o[2 * e] = bflo(gv[e]) * (bflo(u0[e]) * w0[0] + bflo(u1[e]) * w1[0] + bflo(u2[e]) * w2[0]);
            o[2 * e + 1] = bfhi(gv[e]) * (bfhi(u0[e]) * w0[1] + bfhi(u1[e]) * w1[1] + bfhi(u2[e]) * w2[1]); }
        v4u ov; ov.x = pk2(o[0], o[1]); ov.y = pk2(o[2], o[3]); ov.z = pk2(o[4], o[5]); ov.w = pk2(o[6], o[7]);
        *(v4u*)(CV + (size_t)m * D_ + c) = ov;
    }
}

constexpr int NPHASE = 19;
constexpr int MOE_EARLY = 6 * I_MGU1;
#ifndef PH_STOP
#define PH_STOP NPHASE
#endif
struct Args { const float* in[34]; float* out; unsigned char* ws; int ph_lo, ph_hi; };
__global__ void __launch_bounds__(512, 2) mk_fwd(Args args) {
    extern __shared__ __attribute__((aligned(16))) unsigned char lds_raw[];
    LAS unsigned char* lds = (LAS unsigned char*)lds_raw;
    WInfo W; W.tid = threadIdx.x; W.lane = W.tid & 63; W.wave = __builtin_amdgcn_readfirstlane(W.tid >> 6);
    W.G = gridDim.x; { const int bx = blockIdx.x; W.vcu = (W.G % 8 == 0) ? (bx % 8) * (W.G / 8) + bx / 8 : bx; }
    W.gw = W.vcu * 8 + W.wave; W.NGW = W.G * 8;
    unsigned char* ws = args.ws; float* out = args.out; const float* const* in = args.in;
    unsigned* ctl = (unsigned*)(ws + WS_CTL);
    volatile LAS unsigned* MISC = (volatile LAS unsigned*)(lds + MISC_OFF);
    for (int u = W.tid; u < 128; u += 512) ((LAS unsigned*)(lds + LDSCTL_OFF))[u] = 0u;
    __syncthreads();
    XcdBarrier bar; bar.bar = ctl + CW_BAR; bar.x = 0; bar.st = nullptr;
    if (MK_N_LAUNCHES == 1) bar = xcd_barrier_post(ctl + CW_BAR, MISC + 8);
    const int lo = args.ph_lo, hi = args.ph_hi;
#ifndef PH_MASK
#define PH_MASK 0x7ffff
#endif
#define IN(k) (((PH_MASK >> (k)) & 1) && lo <= (k) && (k) < hi)
#define SEAM(k) do { if (IN(k) && IN((k) + 1)) xcd_barrier(bar); } while (0)
    bf16* const B0 = (bf16*)(ws + WS_B0); bf16* const Zb = (bf16*)(ws + WS_B1); bf16* const ACT = (bf16*)(ws + WS_ACT); bf16* const CV = (bf16*)(ws + WS_CV);
    bf16* const AP = (bf16*)(ws + WS_AP); bf16* const YRAW = (bf16*)(ws + WS_YRAW); bf16* const ACTM = (bf16*)(ws + WS_ACTM);
    bf16* const WLOG = (bf16*)out; bf16* const MIX = (bf16*)out;     bf16* const ABUF = (bf16*)(out + (size_t)T_ * 512); bf16* const GBUF = ABUF + (size_t)T_ * 512;
    int* const toke = (int*)(ws + WS_TOKE); float* const tokp = (float*)(ws + WS_TOKP); int* const wgcnt = (int*)(ws + WS_WGCNT); int* const ptabg = (int*)(ws + WS_PTAB); int* const perm = (int*)(ws + WS_PERM);
    const int cblk = (int)blockIdx.x;

#ifdef DUMP_OFF
    if (lo == 100) { const bf16* s = (const bf16*)(ws + (size_t)(DUMP_OFF) * MiB);
        for (size_t i = (size_t)W.gw * 64 + W.lane; i < (size_t)T_ * D_; i += (size_t)W.NGW * 64) { const size_t m = i >> 10, c = i & 1023; out[i] = (c < DUMP_W) ? bf2f(s[m * DUMP_LD + DUMP_COL + c]) : 0.f; } return; }
#endif
    if (IN(0)) { p0_prologue(W, lds, in, ws); } SEAM(0);
    if (IN(1)) { const int K8 = 512 + (hi >> 20); pg8::DenseSched S{T_ / 256, NZ / 256, W.G, cblk, K8, (const bf16*)(ws + WS_WIN0)}; pg8::EpiBf16i8 E{Zb, NZ, (const float*)(ws + WS_XS), (const float*)(ws + WS_LNV) + 26112};
        pg8::gemm_phase<pg8::EpiBf16i8, pg8::DenseSched, 2>(lds, (const bf16*)(ws + WS_XQ), K8, S, E); } SEAM(1);
    if (IN(2)) { aprime_phase(W, Zb, AP, in[4]); } SEAM(2);
    if (IN(3)) { const int KL = 256 + (hi >> 20); pg8::DenseSched S{T_ / 256, 6, W.G, cblk, KL, (const bf16*)(ws + WS_WLORA)}; pg8::EpiLora E{WLOG, ABUF, GBUF, in[5], in[7]}; pg8::gemm_phase(lds, AP, KL, S, E); } SEAM(3);
    if (IN(4)) { scan_prep_phase(W, lds, Zb, WLOG, ABUF, ws + WS_SLOT, (float*)(ws + WS_BONUS), in[4], in[10], in[11], in[12]); } SEAM(4);
    if (IN(5)) { if (blockIdx.x < 64) scan_seq_phase(W, lds, Zb, ws + WS_SLOT, YRAW, in[4], ctl + 2304); attn_phase(W, lds, Zb, MIX, in[3], in[1], ctl + 2048); deferred_work(W, lds, in, ws, ctl + 2112);
        __syncthreads(); if (blockIdx.x >= 64 && W.G > 64) moe_weights(W, lds, in, ws, 0, MOE_EARLY, ((int)blockIdx.x - 64) * 8 + W.wave, (W.G - 64) * 8, ctl + 2304); } SEAM(5);
    if (IN(6)) { post_phase(W, Zb, GBUF, YRAW, (const float*)(ws + WS_BONUS), MIX, in[4], in[13], in[14]); __syncthreads(); moe_weights(W, lds, in, ws, W.G > 64 ? MOE_EARLY : 0, NITEMS_MOE, W.gw, W.NGW, nullptr); } SEAM(6);
    float* const STP1 = (float*)(ws + WS_STP1); float* const STP2 = (float*)(ws + WS_STP2); const float* const SV = (const float*)(ws + WS_LNV); const float* const CVv = SV + 8704;
    LAS float* const PST = (LAS float*)(lds + PST_OFF); LAS float* const TBL = (LAS float*)(lds + STAT_OFF);
#define STAT_TABLE(S, stp) do { __syncthreads(); if (W.tid < 256) { f32x4 _a[11], _b[11]; int _n = 0; \
        _Pragma("unroll") for (int i = 0; i < 11; ++i) { pg8::Unit uu; if ((S).next(i, uu)) { _n = i + 1; const float* _p = (stp) + (size_t)(uu.pm * 256 + W.tid) * 8; _a[i] = *(const f32x4*)_p; _b[i] = *(const f32x4*)(_p + 4); } else { _a[i] = (f32x4){0.f, 0.f, 0.f, 0.f}; _b[i] = _a[i]; } } \
        _Pragma("unroll") for (int i = 0; i < 11; ++i) if (i < _n) { const float s = ((_a[i][0] + _a[i][2]) + _b[i][0]) + _b[i][2], q = ((_a[i][1] + _a[i][3]) + _b[i][1]) + _b[i][3]; const float mu = s * (1.0f / 1024.0f); \
            TBL[(i * 256 + W.tid) * 2] = mu; TBL[(i * 256 + W.tid) * 2 + 1] = rsqrtf(fmaxf(q * (1.0f / 1024.0f) - mu * mu, 0.f) + LN_EPS); } } __syncthreads(); } while (0)
    if (IN(7)) { pg8::DenseSched S{T_ / 256, 4, W.G, cblk, 1024, (const bf16*)(ws + WS_WOUT0)}; pg8::EpiRes16<false, true> E{B0, Zb, STP1, PST, TBL, nullptr, nullptr, ws + WS_A8}; pg8::gemm_phase(lds, MIX, 1024, S, E); } SEAM(7);
    if (IN(8)) { const int K8 = 512 + (hi >> 20); pg8::DenseSched S{T_ / 256, 22, W.G, cblk, K8, (const bf16*)(ws + WS_WFGU)}; STAT_TABLE(S, STP1); pg8::EpiSwigluLNi8 E{ACT, FF, TBL, SV + 17408, SV, CVv};
        pg8::gemm_phase<pg8::EpiSwigluLNi8, pg8::DenseSched, 2>(lds, (const bf16*)(ws + WS_A8), K8, S, E); } SEAM(8);
    if (IN(9)) { pg8::DenseSched S{T_ / 256, 4, W.G, cblk, FF, (const bf16*)(ws + WS_WFD)}; STAT_TABLE(S, STP1); pg8::EpiRes16<false, true> E{Zb, B0, STP2, PST, TBL, in[16], in[17], ws + WS_A8B}; pg8::gemm_phase(lds, ACT, FF, S, E); } SEAM(9);
    if (IN(10)) { const int K8 = 512 + (hi >> 20); pg8::DenseSched S{T_ / 256, 12, W.G, cblk, K8, (const bf16*)(ws + WS_WIN1)}; STAT_TABLE(S, STP2); pg8::EpiL1inLNi8 E{Zb, ACT, TBL, SV + 17408 + 5632, SV + 5632, CVv + 5632};
        pg8::gemm_phase<pg8::EpiL1inLNi8, pg8::DenseSched, 2>(lds, (const bf16*)(ws + WS_A8B), K8, S, E); } SEAM(10);
    if (IN(11)) { conv_phase(W, Zb, ACT, CV, in[24]); } SEAM(11);
    if (IN(12)) { pg8::DenseSched S{T_ / 256, 4, W.G, cblk, 1024, (const bf16*)(ws + WS_WOUT1)}; STAT_TABLE(S, STP2); pg8::EpiRes16<false> E{B0, Zb, STP1, PST, TBL, in[21], in[22]}; pg8::gemm_phase(lds, CV, 1024, S, E); } SEAM(12);
    if (IN(13)) { ln_router_phase(W, lds, Zb, STP1, (bf16*)out, (unsigned char*)B0, in[26], in[27], in[28], toke, tokp, wgcnt); } SEAM(13);
    if (IN(14)) { route_phase(W, lds, toke, tokp, wgcnt, perm, (float*)(ws + WS_SLOTP), ptabg); } SEAM(14);
#define MOE_TABLES() do { LAS int* ptl = (LAS int*)(lds + PTAB_OFF); __syncthreads(); if (W.tid < 280) ptl[W.tid] = ptabg[W.tid]; __syncthreads(); } while (0)
    if (IN(15)) { MOE_TABLES(); LAS int* ptl = (LAS int*)(lds + PTAB_OFF); LAS unsigned short* rtl = (LAS unsigned short*)(lds + RTAB_OFF);
        pg8::MoeUpSched S{ptl[0] + ptl[1], W.G, cblk, ws + WS_WMGU, ptl, rtl};
        if (W.tid < 256) { int rv[32];
#pragma unroll
            for (int i = 0; i < 32; ++i) { pg8::Unit uu; rv[i] = S.next(i, uu) ? perm[uu.pm * 256 + W.tid] : 0; }
#pragma unroll
            for (int i = 0; i < 32; ++i) rtl[i * 256 + W.tid] = (unsigned short)(rv[i] < 0 ? 0 : rv[i]); }
        __syncthreads(); pg8::EpiSwiglu8 E{(unsigned char*)ACTM, FFE}; pg8::gemm_phase<pg8::EpiSwiglu8, pg8::MoeUpSched, true>(lds, B0, 512 + (hi >> 20), S, E); } SEAM(15);
    if (IN(16)) { MOE_TABLES(); LAS int* ptl = (LAS int*)(lds + PTAB_OFF);
        pg8::MoeDownSched S{ptl[0] + ptl[1], 0, W.G, cblk, ws + WS_WMD, ptl}; pg8::EpiMoeDown E{out, (bf16*)(ws + WS_Y2), perm, (const float*)(ws + WS_SLOTP)}; pg8::gemm_phase<pg8::EpiMoeDown, pg8::MoeDownSched, true>(lds, ACTM, FFE / 2 + (hi >> 20), S, E); } SEAM(16);
    if (IN(17)) { MOE_TABLES(); LAS int* ptl = (LAS int*)(lds + PTAB_OFF); const int nP = ptl[0] + ptl[1], nlate = nP > 256 ? (nP - 256) * 4 : 0;
        if (cblk < nlate) { pg8::MoeDownSched S{nP, 1, W.G, cblk, ws + WS_WMD, ptl}; pg8::EpiMoeDown E{out, (bf16*)(ws + WS_Y2), perm, (const float*)(ws + WS_SLOTP)}; pg8::gemm_phase<pg8::EpiMoeDown, pg8::MoeDownSched, true>(lds, ACTM, FFE / 2 + (hi >> 20), S, E); }
        else final_ln_phase(W, out, (const bf16*)(ws + WS_Y2), in[32], in[33], toke, (cblk - nlate) * 8 + W.wave, (W.G - nlate) * 8, false); } SEAM(17);
    if (IN(18)) { final_ln_phase(W, out, (const bf16*)(ws + WS_Y2), in[32], in[33], toke, W.gw, W.NGW, true); }
#undef IN
#undef SEAM
}

extern "C" void kernel_launch(void* const* d_in, const int* in_sizes, int n_in, void* d_out, int out_size, void* d_ws, size_t ws_size, hipStream_t stream) {
    static int grid = 0;
    if (grid == 0) {
        if (n_in != 34 || out_size != T_ * D_ || ws_size < WS_END) { fprintf(stderr, "kernel_launch: unexpected problem (n_in %d, out %d, ws %zu)\n", n_in, out_size, ws_size); grid = -1; return; }
        int dev = 0, cus = 0, per_cu = 0;
        if (hipGetDevice(&dev) != hipSuccess || hipDeviceGetAttribute(&cus, hipDeviceAttributeMultiprocessorCount, dev) != hipSuccess) { grid = -1; return; }
        if (hipFuncSetAttribute((const void*)mk_fwd, hipFuncAttributeMaxDynamicSharedMemorySize, LDS_BYTES) != hipSuccess) { fprintf(stderr, "kernel_launch: hipFuncSetAttribute failed\n"); grid = -1; return; }
        if (hipOccupancyMaxActiveBlocksPerMultiprocessor(&per_cu, (const void*)mk_fwd, 512, LDS_BYTES) != hipSuccess || per_cu < 1) fprintf(stderr, "kernel_launch: occupancy query reports %d\n", per_cu);
        (void)hipGetLastError();
        grid = cus;
        if (grid != 256) { fprintf(stderr, "kernel_launch: built for 256 CUs, got %d\n", grid); grid = -1; return; }
    }
    if (grid < 0) return;
    (void)hipMemsetAsync((char*)d_ws + WS_CTL, 0, CTL_ZERO_BYTES, stream);
    Args a{};
    for (int i = 0; i < 34; ++i) a.in[i] = (const float*)d_in[i];
    a.out = (float*)d_out; a.ws = (unsigned char*)d_ws;
    if (MK_N_LAUNCHES == 1) { a.ph_lo = 0; a.ph_hi = NPHASE; hipLaunchKernelGGL(mk_fwd, dim3(grid), dim3(512), LDS_BYTES, stream, a); }
    else { for (int p = 0; p < PH_STOP; ++p) { a.ph_lo = p; a.ph_hi = p + 1; hipLaunchKernelGGL(mk_fwd, dim3(grid), dim3(512), LDS_BYTES, stream, a);
#ifdef DUP_PHASE
            if (p == DUP_PHASE) for (int r = 0; r < DUP_N; ++r) hipLaunchKernelGGL(mk_fwd, dim3(grid), dim3(512), LDS_BYTES, stream, a);
#endif
        }
#ifdef DUMP_OFF
        a.ph_lo = 100; a.ph_hi = 101; hipLaunchKernelGGL(mk_fwd, dim3(grid), dim3(512), LDS_BYTES, stream, a);
#endif
    }
}
```
